# Optimizing an MI355X kernel written in HIP

```python
import math
import jax
import jax.numpy as jnp
from jax import lax
import numpy as np

D_MODEL = 2048
BATCH = 8
SEQ = 2048
DEPTH = 1

GRID_W = 64
CTX_LEN = 256
NORM_EPS = 1e-6

RW_HEADS = 16
RW_HEAD_DIM = 64
RW_WIDTH = RW_HEADS * RW_HEAD_DIM
RW_DECAY_RANK = 96
RW_ICLR_RANK = 96
RW_GATE_RANK = 64
RW_GN_EPS = 64e-5
RW_COLS = 3 * RW_WIDTH + 2 * RW_DECAY_RANK + 2 * RW_ICLR_RANK + RW_GATE_RANK
RW_SPLITS = (RW_WIDTH, 2 * RW_WIDTH, 3 * RW_WIDTH, 3 * RW_WIDTH + 2 * RW_DECAY_RANK,
             3 * RW_WIDTH + 2 * RW_DECAY_RANK + 2 * RW_ICLR_RANK)

GDN_HEADS = 8
GDN_HEAD_DIM = 128
GDN_WIDTH = GDN_HEADS * GDN_HEAD_DIM
GDN_CONV = 5
GDN_CHUNK = 64
GDN_CONV_COLS = 3 * GDN_WIDTH
GDN_AB_COLS = 4 * GDN_HEADS

GATE_COLS = 2 * D_MODEL
IN_SPLITS = (RW_COLS, RW_COLS + GDN_CONV_COLS, RW_COLS + GDN_CONV_COLS + GDN_WIDTH,
             RW_COLS + GDN_CONV_COLS + GDN_WIDTH + GDN_AB_COLS)
N_IN = IN_SPLITS[-1] + GATE_COLS

FFN_HIDDEN = -(-8 * D_MODEL // (3 * 256)) * 256

kernel_name = 'hybrid_rwkv7_gdn_dit_block'


def rmsnorm(x, w):
    xf = x.astype(jnp.float32)
    y = xf * lax.rsqrt(jnp.mean(xf * xf, axis=-1, keepdims=True) + NORM_EPS)
    return (y * w.astype(jnp.float32)).astype(x.dtype)


def modulate(x, shift, scale):
    return x * (1.0 + scale) + shift


def l2norm(x):
    return x * lax.rsqrt(jnp.sum(x * x, axis=-1, keepdims=True) + NORM_EPS)


def grid_shift(p, rows):
    b, t, ch = p.shape
    g = p.reshape(b, rows, GRID_W, ch // 4, 4)
    left = jnp.pad(g[:, :, :-1, :, 0], ((0, 0), (0, 0), (1, 0), (0, 0)))
    right = jnp.pad(g[:, :, 1:, :, 1], ((0, 0), (0, 0), (0, 1), (0, 0)))
    up = jnp.pad(g[:, :-1, :, :, 2], ((0, 0), (1, 0), (0, 0), (0, 0)))
    down = jnp.pad(g[:, 1:, :, :, 3], ((0, 0), (0, 1), (0, 0), (0, 0)))
    return jnp.stack([left, right, up, down], axis=-1).reshape(b, t, ch)


def seq_shift(p):
    b, t, ch = p.shape
    g = p.reshape(b, t, ch // 2, 2)
    prev = jnp.pad(g[:, :-1, :, 0], ((0, 0), (1, 0), (0, 0)))
    nxt = jnp.pad(g[:, 1:, :, 1], ((0, 0), (0, 1), (0, 0)))
    return jnp.stack([prev, nxt], axis=-1).reshape(b, t, ch)


def depthwise_conv(x, w):
    return lax.conv_general_dilated(x, w[:, None, :], window_strides=(1,),
                                    padding=[(GDN_CONV // 2, GDN_CONV // 2)],
                                    dimension_numbers=('NWC', 'WIO', 'NWC'),
                                    feature_group_count=x.shape[-1])


def prefix_scan(scan_fn, ctx_in, lat_in, s0, reverse):
    flip = (lambda a: jnp.flip(a, axis=1)) if reverse else (lambda a: a)
    y_ctx, s_ctx = scan_fn(*[flip(a) for a in ctx_in], s0)
    y_lat, _ = scan_fn(*[flip(a) for a in lat_in], s_ctx)
    return flip(y_lat), flip(y_ctx)


def rwkv7_scan(r, w, k, v, kk, bb, s0):
    def step(s, inp):
        r_t, w_t, k_t, v_t, kk_t, b_t = inp
        sa = jnp.einsum('bhij,bhj->bhi', s, kk_t)
        s = s * w_t[:, :, None, :] - sa[..., None] * b_t[:, :, None, :] + v_t[..., None] * k_t[:, :, None, :]
        return s, jnp.einsum('bhij,bhj->bhi', s, r_t)
    xs = tuple(jnp.moveaxis(a, 1, 0) for a in (r, w, k, v, kk, bb))
    s_fin, y = lax.scan(step, s0, xs)
    return jnp.moveaxis(y, 0, 1), s_fin


def rwkv_features(p, p_shift, mu, w0, w2, a0, a2, g2, k_k, k_a):
    b, t, _ = p.shape
    xs = (p + (p_shift - p) * mu).astype(jnp.float32)
    r, k, v, wd, ad, gd = jnp.split(xs, RW_SPLITS, axis=-1)
    heads = lambda a: a.reshape(a.shape[:-1] + (RW_HEADS, RW_HEAD_DIM))
    lora_w = jnp.einsum('btdr,drc->btdc', jnp.tanh(wd.reshape(b, t, 2, RW_DECAY_RANK)), w2)
    w_log = -jax.nn.softplus(-(w0 + lora_w)) - 0.5
    decay = jnp.exp(-jnp.exp(w_log))
    iclr = jax.nn.sigmoid(a0 + jnp.einsum('btdr,drc->btdc', ad.reshape(b, t, 2, RW_ICLR_RANK), a2))
    gate = jax.nn.sigmoid(gd) @ g2
    kk = l2norm(heads(k * k_k))
    k_dir = heads(k[:, :, None, :] * (1.0 + (iclr - 1.0) * k_a))
    b_dir = kk[:, :, None] * heads(iclr)
    return heads(r), heads(v), gate, kk, heads(decay), k_dir, b_dir


def rwkv_dir_inputs(f, d):
    r, v, _, kk, decay, k_dir, b_dir = f
    return (r, decay[:, :, d], k_dir[:, :, d], v, kk, b_dir[:, :, d])


def rwkv_readout(y, f, r_k, ln_w, ln_b):
    r, v, gate, _, _, k_dir, _ = f
    b, t = y.shape[:2]
    mu = jnp.mean(y, axis=-1, keepdims=True)
    var = jnp.mean(jnp.square(y - mu), axis=-1, keepdims=True)
    yn = ((y - mu) * lax.rsqrt(var + RW_GN_EPS)).reshape(b, t, RW_WIDTH) * ln_w + ln_b
    k_bonus = jnp.mean(k_dir, axis=2)
    bonus = (jnp.sum(r * k_bonus * r_k, axis=-1, keepdims=True) * v).reshape(b, t, RW_WIDTH)
    return (yn + bonus) * gate


def gdn_chunked(q, k, v, g, beta, s0):
    b, t, h, dk = q.shape
    dv = v.shape[-1]
    n = t // GDN_CHUNK

    def chunks(a):
        a = a.reshape((b, n, GDN_CHUNK, h) + a.shape[3:])
        return jnp.moveaxis(a, (1, 3), (0, 2))

    qc, kc, vc = chunks(q * dk ** -0.5), chunks(k), chunks(v)
    bc = chunks(beta)
    gc = jnp.cumsum(chunks(g), axis=-1)
    idx = jnp.arange(GDN_CHUNK)
    incl = idx[:, None] >= idx[None, :]
    strict = idx[:, None] > idx[None, :]
    diff = gc[..., :, None] - gc[..., None, :]
    decay = jnp.where(incl, jnp.exp(jnp.where(incl, diff, 0.0)), 0.0)
    kb = kc * bc[..., None]
    lmat = jnp.where(strict, jnp.einsum('nbhik,nbhjk->nbhij', kb, kc) * decay, 0.0)
    rhs = jnp.concatenate([vc * bc[..., None], kb * jnp.exp(gc)[..., None]], axis=-1)
    sol = lax.linalg.triangular_solve(lmat, rhs, left_side=True, lower=True, unit_diagonal=True)
    u, wk = sol[..., :dv], sol[..., dv:]
    qk = jnp.where(incl, jnp.einsum('nbhik,nbhjk->nbhij', qc, kc) * decay, 0.0)
    q_dec = qc * jnp.exp(gc)[..., None]
    k_tail = kc * jnp.exp(gc[..., -1:] - gc)[..., None]
    g_last = jnp.exp(gc[..., -1])

    def step(s, inp):
        qk_i, u_i, w_i, qd_i, kt_i, gl_i = inp
        v_new = u_i - jnp.einsum('bhck,bhkv->bhcv', w_i, s)
        o = jnp.einsum('bhck,bhkv->bhcv', qd_i, s) + jnp.einsum('bhcj,bhjv->bhcv', qk_i, v_new)
        s = s * gl_i[..., None, None] + jnp.einsum('bhck,bhcv->bhkv', kt_i, v_new)
        return s, o

    s_fin, o = lax.scan(step, s0, (qk, u, wk, q_dec, k_tail, g_last))
    o = jnp.moveaxis(o, (0, 2), (1, 3)).reshape(b, t, h, dv)
    return o, s_fin


def gdn_features(p_conv, p_ab, conv_w, a_log, dt_bias):
    b, t, _ = p_conv.shape
    u = jax.nn.silu(depthwise_conv(p_conv, conv_w)).astype(jnp.float32)
    q, k, v = jnp.split(u, 3, axis=-1)
    heads = lambda a: a.reshape(b, t, GDN_HEADS, GDN_HEAD_DIM)
    ab = p_ab.astype(jnp.float32).reshape(b, t, 2, 2, GDN_HEADS)
    g = -jnp.exp(a_log.astype(jnp.float32)) * jax.nn.softplus(ab[:, :, 0] + dt_bias)
    beta = jax.nn.sigmoid(ab[:, :, 1])
    return l2norm(heads(q)), l2norm(heads(k)), heads(v), g, beta


def gdn_dir_inputs(f, d):
    q, k, v, g, beta = f
    return (q, k, v, g[:, :, d], beta[:, :, d])


def gdn_readout(o, z, norm_w):
    b, t = o.shape[:2]
    on = o * lax.rsqrt(jnp.mean(o * o, axis=-1, keepdims=True) + NORM_EPS) * norm_w
    return (on * jax.nn.silu(z.astype(jnp.float32)).reshape(o.shape)).reshape(b, t, GDN_WIDTH)


def gated_merge(o_a, o_b, gate_cols, p_a, p_b, w_out):
    g_a, g_b = jnp.split(gate_cols, 2, axis=-1)
    m = jax.nn.sigmoid(g_a) * (o_a @ p_a) + jax.nn.sigmoid(g_b) * (o_b @ p_b)
    return m @ w_out


def swiglu(h, w_gate_up, w_down):
    gate, up = jnp.split(h @ w_gate_up, 2, axis=-1)
    return (jax.nn.silu(gate) * up) @ w_down


def mix_tokens(h, hc, w_in, rw_mu, rw_w0, rw_w2, rw_a0, rw_a2, rw_g2, rw_k_k, rw_k_a, rw_r_k,
               rw_ln_w, rw_ln_b, gdn_conv_w, gdn_a_log, gdn_dt_bias, gdn_norm_w,
               merge_p_a, merge_p_b, w_out, need_ctx):
    rows = h.shape[1] // GRID_W
    bsz = h.shape[0]
    rw, cv, z, ab, gt = jnp.split(h @ w_in, IN_SPLITS, axis=-1)
    rw_c, cv_c, z_c, ab_c, gt_c = jnp.split(hc @ w_in, IN_SPLITS, axis=-1)

    fa = rwkv_features(rw, grid_shift(rw, rows), rw_mu, rw_w0, rw_w2, rw_a0, rw_a2, rw_g2, rw_k_k, rw_k_a)
    fa_c = rwkv_features(rw_c, seq_shift(rw_c), rw_mu, rw_w0, rw_w2, rw_a0, rw_a2, rw_g2, rw_k_k, rw_k_a)
    s0a = jnp.zeros((bsz, RW_HEADS, RW_HEAD_DIM, RW_HEAD_DIM), jnp.float32)
    out_a = [prefix_scan(rwkv7_scan, rwkv_dir_inputs(fa_c, d), rwkv_dir_inputs(fa, d), s0a, d == 1)
             for d in range(2)]
    o_a = rwkv_readout(out_a[0][0] + out_a[1][0], fa, rw_r_k, rw_ln_w, rw_ln_b).astype(h.dtype)

    fb = gdn_features(cv, ab, gdn_conv_w, gdn_a_log, gdn_dt_bias)
    fb_c = gdn_features(cv_c, ab_c, gdn_conv_w, gdn_a_log, gdn_dt_bias)
    s0b = jnp.zeros((bsz, GDN_HEADS, GDN_HEAD_DIM, GDN_HEAD_DIM), jnp.float32)
    out_b = [prefix_scan(gdn_chunked, gdn_dir_inputs(fb_c, d), gdn_dir_inputs(fb, d), s0b, d == 1)
             for d in range(2)]
    o_b = gdn_readout(out_b[0][0] + out_b[1][0], z, gdn_norm_w).astype(h.dtype)

    y = gated_merge(o_a, o_b, gt, merge_p_a, merge_p_b, w_out)
    if not need_ctx:
        return y, None
    o_a_c = rwkv_readout(out_a[0][1] + out_a[1][1], fa_c, rw_r_k, rw_ln_w, rw_ln_b).astype(hc.dtype)
    o_b_c = gdn_readout(out_b[0][1] + out_b[1][1], z_c, gdn_norm_w).astype(hc.dtype)
    return y, gated_merge(o_a_c, o_b_c, gt_c, merge_p_a, merge_p_b, w_out)


def setup_inputs(seed: int = 0) -> dict:
    key = jax.random.key(seed)
    ks = jax.random.split(key, 32)
    f32 = jnp.float32
    L, D = DEPTH, D_MODEL

    def nrm(k, shape, scale):
        return scale * jax.random.normal(k, shape, f32)

    dt = jnp.exp(jax.random.uniform(ks[21], (L, 2, GDN_HEADS), f32, math.log(1e-3), math.log(1e-1)))
    return {
        'x': nrm(ks[0], (BATCH, SEQ, D), 1.0),
        'c': nrm(ks[1], (BATCH, D), 1.0),
        'ctx': nrm(ks[2], (BATCH, CTX_LEN, D), 1.0),
        'c_ctx': nrm(ks[3], (D,), 1.0),
        'w_ada': nrm(ks[4], (L, D, 6 * D), 0.5 * D ** -0.5),
        'b_ada': nrm(ks[5], (L, 6 * D), 0.02),
        'norm1_w': 1.0 + nrm(ks[6], (L, D), 0.1),
        'w_in': nrm(ks[7], (L, D, N_IN), D ** -0.5),
        'rw_mu': jax.random.uniform(ks[8], (L, RW_COLS), f32),
        'rw_w0': jnp.linspace(-6.0, 2.0, RW_WIDTH, dtype=f32) + nrm(ks[9], (L, 2, RW_WIDTH), 0.1),
        'rw_w2': nrm(ks[10], (L, 2, RW_DECAY_RANK, RW_WIDTH), 0.5 * RW_DECAY_RANK ** -0.5),
        'rw_a0': nrm(ks[11], (L, 2, RW_WIDTH), 0.5),
        'rw_a2': nrm(ks[12], (L, 2, RW_ICLR_RANK, RW_WIDTH), RW_ICLR_RANK ** -0.5),
        'rw_g2': nrm(ks[13], (L, RW_GATE_RANK, RW_WIDTH), RW_GATE_RANK ** -0.5),
        'rw_k_k': 0.85 + nrm(ks[14], (L, RW_WIDTH), 0.1),
        'rw_k_a': 1.0 + nrm(ks[15], (L, RW_WIDTH), 0.1),
        'rw_r_k': nrm(ks[16], (L, RW_HEADS, RW_HEAD_DIM), 0.1),
        'rw_ln_w': 1.0 + nrm(ks[17], (L, RW_WIDTH), 0.1),
        'rw_ln_b': nrm(ks[18], (L, RW_WIDTH), 0.01),
        'gdn_conv_w': nrm(ks[19], (L, GDN_CONV, GDN_CONV_COLS), GDN_CONV ** -0.5),
        'gdn_a_log': jnp.log(jax.random.uniform(ks[20], (L, 2, GDN_HEADS), f32, 1.0, 16.0)),
        'gdn_dt_bias': dt + jnp.log(-jnp.expm1(-dt)),
        'gdn_norm_w': 1.0 + nrm(ks[22], (L, GDN_HEAD_DIM), 0.1),
        'merge_p_a': nrm(ks[23], (L, RW_WIDTH, D), RW_WIDTH ** -0.5),
        'merge_p_b': nrm(ks[24], (L, GDN_WIDTH, D), GDN_WIDTH ** -0.5),
        'w_out': nrm(ks[25], (L, D, D), D ** -0.5),
        'norm2_w': 1.0 + nrm(ks[26], (L, D), 0.1),
        'ffn_w_gate_up': nrm(ks[27], (L, D, 2 * FFN_HIDDEN), D ** -0.5),
        'ffn_w_down': nrm(ks[28], (L, FFN_HIDDEN, D), FFN_HIDDEN ** -0.5),
        'final_norm_w': 1.0 + nrm(ks[29], (D,), 0.1),
    }


def reference(x, c, ctx, c_ctx, w_ada, b_ada, norm1_w, w_in, rw_mu, rw_w0, rw_w2, rw_a0, rw_a2,
              rw_g2, rw_k_k, rw_k_a, rw_r_k, rw_ln_w, rw_ln_b, gdn_conv_w, gdn_a_log,
              gdn_dt_bias, gdn_norm_w, merge_p_a, merge_p_b, w_out, norm2_w, ffn_w_gate_up,
              ffn_w_down, final_norm_w):
    silu_c = jax.nn.silu(c)[:, None, :]
    silu_cc = jax.nn.silu(c_ctx)
    for layer in range(DEPTH):
        need_ctx = layer < DEPTH - 1
        mod = silu_c @ w_ada[layer] + b_ada[layer]
        mod_ctx = silu_cc @ w_ada[layer] + b_ada[layer]
        sh1, sc1, gt1, sh2, sc2, gt2 = jnp.split(mod, 6, axis=-1)
        csh1, csc1, cgt1, csh2, csc2, cgt2 = jnp.split(mod_ctx, 6, axis=-1)
        h = modulate(rmsnorm(x, norm1_w[layer]), sh1, sc1)
        hc = modulate(rmsnorm(ctx, norm1_w[layer]), csh1, csc1)
        y, yc = mix_tokens(h, hc, w_in[layer], rw_mu[layer], rw_w0[layer], rw_w2[layer],
                           rw_a0[layer], rw_a2[layer], rw_g2[layer], rw_k_k[layer], rw_k_a[layer],
                           rw_r_k[layer], rw_ln_w[layer], rw_ln_b[layer], gdn_conv_w[layer],
                           gdn_a_log[layer], gdn_dt_bias[layer], gdn_norm_w[layer],
                           merge_p_a[layer], merge_p_b[layer], w_out[layer], need_ctx)
        x = x + gt1 * y
        x = x + gt2 * swiglu(modulate(rmsnorm(x, norm2_w[layer]), sh2, sc2),
                             ffn_w_gate_up[layer], ffn_w_down[layer])
        if need_ctx:
            ctx = ctx + cgt1 * yc
            ctx = ctx + cgt2 * swiglu(modulate(rmsnorm(ctx, norm2_w[layer]), csh2, csc2),
                                      ffn_w_gate_up[layer], ffn_w_down[layer])
    return rmsnorm(x, final_norm_w)
```

```cpp
#include <hip/hip_runtime.h>
#include <hip/hip_cooperative_groups.h>
#include <cstdio>
#include <cstdint>
namespace cg = cooperative_groups;
namespace pg8 {
#define PG8_LAS __attribute__((address_space(3)))
typedef unsigned short bf16_t;
typedef short bf16x8 __attribute__((ext_vector_type(8)));
typedef float f32x4 __attribute__((ext_vector_type(4)));
typedef unsigned u32x4 __attribute__((ext_vector_type(4)));
constexpr int BM = 256, BK = 64, HALF = 128, HTB = HALF * BK * 2  , STAGE_BYTES = 8 * HTB, NXCD = 8, WGM = 8;

__host__ __device__ __forceinline__ int lds_byte(int r, int c) { const int st = (r >> 4) * 2 + (c >> 5), rr = r & 15, cc = c & 31, ob = rr * 64 + cc * 2; return st * 1024 + (ob ^ (((ob >> 9) & 1) << 5)); }
__host__ __device__ __forceinline__ void stage_rc(int b, int& R, int& C) { const int st = b / 1024, sb = b % 1024, swz = sb ^ (((sb >> 9) & 1) << 5); R = (st >> 1) * 16 + swz / 64; C = (st & 1) * 32 + (swz % 64) / 2; }
__host__ __device__ __forceinline__ int perm32(int rho) { const int n = rho >> 4, i = rho & 15; return 8 * (i >> 2) + 4 * n + (i & 3); }

struct Unit { int pm, pn; };
struct Gemm { const bf16_t* A; const bf16_t* Bt; int M, N, K; };

struct StaticOrder {
    int nM, nN, nwg, G, c;
    __host__ __device__ void init(int M, int N, int G_, int c_) { nM = M / BM; nN = N / BM; nwg = nM * nN; G = G_; c = c_; }
    __host__ __device__ bool next(int i, Unit& u) const {
        const long L = (long)i * G + c; if (L >= nwg) return false;
        int wgid = (int)L; { const int q = nwg / NXCD, r = nwg % NXCD, xcd = wgid % NXCD, off = wgid / NXCD; wgid = (xcd < r ? xcd * (q + 1) : r * (q + 1) + (xcd - r) * q) + off; }
        const int nig = WGM * nN, gid = wgid / nig, fm = gid * WGM, gsz = (nM - fm) < WGM ? (nM - fm) : WGM;
        u.pm = fm + ((wgid % nig) % gsz); u.pn = (wgid % nig) / gsz; return true;
    }
    __device__ __forceinline__ void a_ready(const Unit&) const {}
    __device__ __forceinline__ void done(const Unit&) const {}
};
__device__ __forceinline__ unsigned cvt_pk_bf16(float lo, float hi) { unsigned r; asm volatile("v_cvt_pk_bf16_f32 %0, %1, %2" : "=v"(r) : "v"(lo), "v"(hi)); return r; }
template <class Epi, class Sched, bool STAMP = false>
__device__ __forceinline__ void gemm_phase(PG8_LAS unsigned char* lds, const Gemm g, const Sched& S, const Epi& E, unsigned long long* stamps) {
    const int tid = threadIdx.x, wid = __builtin_amdgcn_readfirstlane(tid >> 6), lane = tid & 63, wr = wid >> 2, wc = wid & 3, fr = lane & 15, fq = lane >> 4;
    const int K = g.K, nt = K / BK;
    int ts_lo = 0, ts_hi = 0, nts = 0; const unsigned long long rt_entry = STAMP ? (unsigned long long)wall_clock64() : 0ull;
#define PG8_STAMP() do { if (STAMP && wid == 0 && nts < 64) { const unsigned long long _c = (unsigned long long)clock64(); \
        ts_lo = (lane == nts) ? (int)(unsigned)_c : ts_lo; ts_hi = (lane == nts) ? (int)(unsigned)(_c >> 32) : ts_hi; ++nts; } } while (0)
    PG8_STAMP();
    unsigned voffA[2], voffB[2];
#pragma unroll
    for (int i = 0; i < 2; ++i) { int R, C; stage_rc(tid * 16 + i * 8192, R, C); const int Rb = Epi::PERM ? ((R & ~31) + perm32(R & 31)) : R;
        voffA[i] = (unsigned)(R * K + C) * 2u; voffB[i] = (unsigned)(Rb * K + C) * 2u; }
    const size_t kstep = (size_t)(BK * 2);
    const size_t hstep = (size_t)HALF * K * 2;
    const size_t tstep = 2 * hstep;
    const unsigned ldsw = (unsigned)wid * 1024u;
    const int aoff = lds_byte(wr * 64 + fr, fq * 8), boff = lds_byte(wc * 32 + fr, fq * 8);
#define PG8_SA(b, h) (((b) * 2 + (h)) * HTB)
#define PG8_SB(b, h) ((4 + (b) * 2 + (h)) * HTB)
#define PG8_STAGE(bufoff, gbase, voff) do { _Pragma("unroll") for (int _i = 0; _i < 2; ++_i) \
        __builtin_amdgcn_global_load_lds((const unsigned*)((const char*)(gbase) + (voff)[_i]), (PG8_LAS unsigned*)(lds + (bufoff) + ldsw + _i * 8192), 16, 0, 0); } while (0)
#define PG8_LDA(dst, b, h) do { _Pragma("unroll") for (int m = 0; m < 4; ++m) _Pragma("unroll") for (int k = 0; k < 2; ++k) dst[m][k] = *(const PG8_LAS bf16x8*)(lds + PG8_SA(b, h) + aoff + m * 2048 + k * 1024); } while (0)
#define PG8_LDB(dst, b, h) do { _Pragma("unroll") for (int n = 0; n < 2; ++n) _Pragma("unroll") for (int k = 0; k < 2; ++k) dst[n][k] = *(const PG8_LAS bf16x8*)(lds + PG8_SB(b, h) + boff + n * 2048 + k * 1024); } while (0)
#define PG8_MMA(ai, bj, At, Bt) do { __builtin_amdgcn_s_setprio(1); _Pragma("unroll") for (int m = 0; m < 4; ++m) _Pragma("unroll") for (int n = 0; n < 2; ++n) _Pragma("unroll") for (int k = 0; k < 2; ++k) \
        acc[ai][bj][m][n] = __builtin_amdgcn_mfma_f32_16x16x32_bf16(Bt[n][k], At[m][k], acc[ai][bj][m][n], 0, 0, 0); __builtin_amdgcn_s_setprio(0); } while (0)
#define PG8_WAIT_V(n) asm volatile("s_waitcnt vmcnt(" #n ")" ::: "memory")
#define PG8_WAIT_L(n) asm volatile("s_waitcnt lgkmcnt(" #n ")" ::: "memory")
#define PG8_BAR __builtin_amdgcn_s_barrier()
#define PG8_SCHED __builtin_amdgcn_sched_barrier(0)
    Unit cur, nxt; int ui = 0;
    if (!S.next(0, cur)) return;
    f32x4 acc[2][2][4][2];
#pragma unroll
    for (int a = 0; a < 2; ++a)
#pragma unroll
        for (int b = 0; b < 2; ++b)
#pragma unroll
            for (int m = 0; m < 4; ++m)
#pragma unroll
                for (int n = 0; n < 2; ++n) acc[a][b][m][n] = (f32x4){0.f, 0.f, 0.f, 0.f};
    bf16x8 At[4][2], B0[2][2], B1[2][2];
    const char* cA = (const char*)g.A + (size_t)cur.pm * tstep; const char* cB = (const char*)g.Bt + (size_t)cur.pn * tstep;
    S.a_ready(cur);
    PG8_STAGE(PG8_SB(0, 0), cB, voffB); PG8_STAGE(PG8_SA(0, 0), cA, voffA); PG8_STAGE(PG8_SB(0, 1), cB + hstep, voffB); PG8_STAGE(PG8_SA(0, 1), cA + hstep, voffA);
    if (wr == 1) PG8_BAR;
    PG8_WAIT_V(4); PG8_BAR;
    PG8_STAGE(PG8_SB(1, 0), cB + kstep, voffB); PG8_STAGE(PG8_SA(1, 0), cA + kstep, voffA); PG8_STAGE(PG8_SB(1, 1), cB + hstep + kstep, voffB);
    PG8_WAIT_V(6); PG8_BAR;
    PG8_STAMP();
    for (;;) {
        const bool has_next = S.next(ui + 1, nxt);
        const char* nA = has_next ? (const char*)g.A + (size_t)nxt.pm * tstep : cA; const char* nB = has_next ? (const char*)g.Bt + (size_t)nxt.pn * tstep : cB;
        for (int t = 0; t < nt; t += 2) {
            const bool last = (t == nt - 2);
            const char* a1 = cA + (size_t)(t + 1) * kstep;
            const char* a2 = last ? nA : cA + (size_t)(t + 2) * kstep; const char* b2 = last ? nB : cB + (size_t)(t + 2) * kstep;
            const char* a3 = a2 + kstep; const char* b3 = b2 + kstep;
            if (last && has_next) S.a_ready(nxt);
            PG8_LDB(B0, 0, 0); PG8_SCHED; PG8_LDA(At, 0, 0); PG8_STAGE(PG8_SA(1, 1), a1 + hstep, voffA);
            PG8_WAIT_L(8); PG8_BAR; PG8_WAIT_L(0); PG8_MMA(0, 0, At, B0); PG8_BAR; PG8_SCHED;
            PG8_LDB(B1, 0, 1); PG8_STAGE(PG8_SB(0, 0), b2, voffB);
            PG8_BAR; PG8_WAIT_L(0); PG8_MMA(0, 1, At, B1); PG8_BAR;
            PG8_LDA(At, 0, 1); PG8_STAGE(PG8_SA(0, 0), a2, voffA);
            PG8_BAR; PG8_WAIT_L(0); PG8_MMA(1, 0, At, B0); PG8_BAR; PG8_SCHED;
            PG8_STAGE(PG8_SB(0, 1), b2 + hstep, voffB);
            PG8_WAIT_V(6); PG8_BAR; PG8_MMA(1, 1, At, B1); PG8_BAR;
            PG8_LDB(B0, 1, 0); PG8_SCHED; PG8_LDA(At, 1, 0); PG8_STAGE(PG8_SA(0, 1), a2 + hstep, voffA);
            PG8_WAIT_L(8); PG8_BAR; PG8_WAIT_L(0); PG8_MMA(0, 0, At, B0); PG8_BAR; PG8_SCHED;
            PG8_LDB(B1, 1, 1); PG8_STAGE(PG8_SB(1, 0), b3, voffB);
            PG8_BAR; PG8_WAIT_L(0); PG8_MMA(0, 1, At, B1); PG8_BAR;
            PG8_LDA(At, 1, 1); PG8_STAGE(PG8_SA(1, 0), a3, voffA);
            PG8_BAR; PG8_WAIT_L(0); PG8_MMA(1, 0, At, B0); PG8_BAR; PG8_SCHED;
            PG8_STAGE(PG8_SB(1, 1), b3 + hstep, voffB);
            PG8_WAIT_V(6); PG8_BAR; PG8_MMA(1, 1, At, B1); PG8_BAR;
        }
        PG8_STAMP();
        if constexpr (!Epi::AFTER_DRAIN) { E(acc, cur, wr, wc, fr, fq); S.done(cur); }
        PG8_STAMP();
        if (!has_next) break;
#pragma unroll
        for (int a = 0; a < 2; ++a)
#pragma unroll
            for (int b = 0; b < 2; ++b)
#pragma unroll
                for (int m = 0; m < 4; ++m)
#pragma unroll
                    for (int n = 0; n < 2; ++n) acc[a][b][m][n] = (f32x4){0.f, 0.f, 0.f, 0.f};
        cur = nxt; cA = nA; cB = nB; ++ui;
    }
    PG8_WAIT_V(0);
    if (wr == 0) PG8_BAR;
    PG8_BAR;
    if constexpr (Epi::AFTER_DRAIN) { E.fused(acc, cur, wr, wc, fr, fq, lds, wid, lane); S.done(cur); }
    PG8_STAMP();
    if (STAMP && wid == 0) { stamps[lane] = lane < nts ? (((unsigned long long)(unsigned)ts_hi << 32) | (unsigned)ts_lo) : 0ull;
        if (lane == 62) stamps[62] = rt_entry; if (lane == 63) stamps[63] = (unsigned long long)wall_clock64(); }
#undef PG8_STAMP
#undef PG8_SA
#undef PG8_SB
#undef PG8_STAGE
#undef PG8_LDA
#undef PG8_LDB
#undef PG8_MMA
#undef PG8_WAIT_V
#undef PG8_WAIT_L
#undef PG8_BAR
#undef PG8_SCHED
}
}

using pg8::bf16_t; using pg8::f32x4; using pg8::u32x4; using pg8::Unit; using pg8::cvt_pk_bf16;
#define LAS __attribute__((address_space(3)))

constexpr int D = 2048, NB = 8, TL = 2048, TC = 256, MLAT = NB * TL  , MCTX = NB * TC  , MALL = MLAT + MCTX  ;
constexpr int N1 = 6656, N2 = 5120, LD1 = N1, LD2 = N2, FFH = 5632, NADA = 6 * D;
constexpr int COL_CV = 3520, COL_AB = 6592;
constexpr int LDS_BYTES = 147456;
constexpr size_t MiB = 1048576;
constexpr size_t WS_A = 0;
constexpr size_t WS_B = WS_A + 46 * MiB;
constexpr size_t WS_X = WS_B + 16 * MiB;
constexpr size_t WS_D = WS_X + 234 * MiB;
constexpr size_t WS_F = WS_D + 160 * MiB;
constexpr size_t WS_M = WS_F + 32 * MiB;
constexpr size_t WS_END = WS_M + 3 * MiB;

struct Params { const float* in[30]; float* out; unsigned char* ws; int ph_lo, ph_hi, coop, pad; };

__device__ __forceinline__ float bf2f(bf16_t b) { return __uint_as_float(((unsigned)b) << 16); }
__device__ __forceinline__ bf16_t f2bf(float f) { unsigned u = __float_as_uint(f); u += 0x7FFFu + ((u >> 16) & 1u); return (bf16_t)(u >> 16); }
__device__ __forceinline__ unsigned pk2(float lo, float hi) { return (unsigned)f2bf(lo) | ((unsigned)f2bf(hi) << 16); }
__device__ __forceinline__ float sigm(float x) { return 1.f / (1.f + __expf(-x)); }
__device__ __forceinline__ float wave_sum(float v) {
#pragma unroll
    for (int o = 1; o < 64; o <<= 1) v += __shfl_xor(v, o);
    return v;
}
template <int CTRL> __device__ __forceinline__ float dppf(float x) { return __int_as_float(__builtin_amdgcn_update_dpp(0, __float_as_int(x), CTRL, 0xF, 0xF, true)); }
__device__ __forceinline__ float red8(float x) { x += dppf<0x141>(x); x += dppf<0xB1>(x); x += dppf<0x4E>(x); return x; }

struct EpiBf16Plain {
    static constexpr bool PERM = true, AFTER_DRAIN = false;
    bf16_t* O; int ldc;
    __device__ __forceinline__ void operator()(const f32x4 (&acc)[2][2][4][2], const Unit& u, int wr, int wc, int fr, int fq) const {
        const int row0 = u.pm * 256 + wr * 64 + fr, col0 = u.pn * 256 + wc * 32 + 8 * fq;
#pragma unroll
        for (int ai = 0; ai < 2; ++ai)
#pragma unroll
            for (int m = 0; m < 4; ++m) { bf16_t* rowp = O + (size_t)(row0 + ai * 128 + m * 16) * ldc + col0;
#pragma unroll
                for (int bj = 0; bj < 2; ++bj) { const f32x4 v0 = acc[ai][bj][m][0], v1 = acc[ai][bj][m][1];
                    u32x4 w; w.x = cvt_pk_bf16(v0[0], v0[1]); w.y = cvt_pk_bf16(v0[2], v0[3]); w.z = cvt_pk_bf16(v1[0], v1[1]); w.w = cvt_pk_bf16(v1[2], v1[3]);
                    *(u32x4*)(rowp + bj * 128) = w; } }
    }
};
template <bool SECOND> struct EpiGate {
    static constexpr bool PERM = true, AFTER_DRAIN = false;
    bf16_t* Mo; const bf16_t* G;
    __device__ __forceinline__ void operator()(const f32x4 (&acc)[2][2][4][2], const Unit& u, int wr, int wc, int fr, int fq) const {
        const int row0 = u.pm * 256 + wr * 64 + fr, col0 = u.pn * 256 + wc * 32 + 8 * fq;
#pragma unroll
        for (int ai = 0; ai < 2; ++ai)
#pragma unroll
            for (int m = 0; m < 4; ++m) { const size_t row = (size_t)(row0 + ai * 128 + m * 16);
#pragma unroll
                for (int bj = 0; bj < 2; ++bj) { const f32x4 v0 = acc[ai][bj][m][0], v1 = acc[ai][bj][m][1];
                    const int col = col0 + bj * 128;
                    const u32x4 g = *(const u32x4*)(G + row * LD2 + col);
                    float r[8];
                    r[0] = sigm(__uint_as_float(g.x << 16)) * v0[0]; r[1] = sigm(__uint_as_float(g.x & 0xffff0000u)) * v0[1];
                    r[2] = sigm(__uint_as_float(g.y << 16)) * v0[2]; r[3] = sigm(__uint_as_float(g.y & 0xffff0000u)) * v0[3];
                    r[4] = sigm(__uint_as_float(g.z << 16)) * v1[0]; r[5] = sigm(__uint_as_float(g.z & 0xffff0000u)) * v1[1];
                    r[6] = sigm(__uint_as_float(g.w << 16)) * v1[2]; r[7] = sigm(__uint_as_float(g.w & 0xffff0000u)) * v1[3];
                    u32x4* op = (u32x4*)(Mo + row * D + col);
                    if (SECOND) { const u32x4 o = *op;
                        r[0] += __uint_as_float(o.x << 16); r[1] += __uint_as_float(o.x & 0xffff0000u); r[2] += __uint_as_float(o.y << 16); r[3] += __uint_as_float(o.y & 0xffff0000u);
                        r[4] += __uint_as_float(o.z << 16); r[5] += __uint_as_float(o.z & 0xffff0000u); r[6] += __uint_as_float(o.w << 16); r[7] += __uint_as_float(o.w & 0xffff0000u); }
                    u32x4 w; w.x = cvt_pk_bf16(r[0], r[1]); w.y = cvt_pk_bf16(r[2], r[3]); w.z = cvt_pk_bf16(r[4], r[5]); w.w = cvt_pk_bf16(r[6], r[7]);
                    *op = w; } }
    }
};
struct EpiRes {
    static constexpr bool PERM = false, AFTER_DRAIN = false;
    float* out; const float* res; const float* gt;
    __device__ __forceinline__ void operator()(const f32x4 (&acc)[2][2][4][2], const Unit& u, int wr, int wc, int fr, int fq) const {
        const int row0 = u.pm * 256 + wr * 64 + fr, col0 = u.pn * 256 + wc * 32 + 4 * fq;
        const float* gtb = gt + (size_t)((u.pm * 256) >> 11) * NADA + col0;
        f32x4 gv[2][2];
#pragma unroll
        for (int bj = 0; bj < 2; ++bj)
#pragma unroll
            for (int n = 0; n < 2; ++n) gv[bj][n] = *(const f32x4*)(gtb + bj * 128 + n * 16);
#pragma unroll
        for (int ai = 0; ai < 2; ++ai)
#pragma unroll
            for (int m = 0; m < 4; ++m) { const size_t ro = (size_t)(row0 + ai * 128 + m * 16) * D + col0;
#pragma unroll
                for (int bj = 0; bj < 2; ++bj)
#pragma unroll
                    for (int n = 0; n < 2; ++n) { const f32x4 rv = *(const f32x4*)(res + ro + bj * 128 + n * 16);
                        *(f32x4*)(out + ro + bj * 128 + n * 16) = rv + gv[bj][n] * acc[ai][bj][m][n]; } }
    }
};
struct EpiSwiglu {
    static constexpr bool PERM = true, AFTER_DRAIN = false;
    bf16_t* O;
    __device__ __forceinline__ void operator()(const f32x4 (&acc)[2][2][4][2], const Unit& u, int wr, int wc, int fr, int fq) const {
        const int row0 = u.pm * 256 + wr * 64 + fr, col0 = u.pn * 128 + wc * 32 + 8 * fq;
#pragma unroll
        for (int ai = 0; ai < 2; ++ai)
#pragma unroll
            for (int m = 0; m < 4; ++m) { bf16_t* rowp = O + (size_t)(row0 + ai * 128 + m * 16) * FFH + col0;
                float r[8];
#pragma unroll
                for (int n = 0; n < 2; ++n)
#pragma unroll
                    for (int e = 0; e < 4; ++e) { const float g = acc[ai][0][m][n][e], up = acc[ai][1][m][n][e]; r[4 * n + e] = g * sigm(g) * up; }
                u32x4 w; w.x = cvt_pk_bf16(r[0], r[1]); w.y = cvt_pk_bf16(r[2], r[3]); w.z = cvt_pk_bf16(r[4], r[5]); w.w = cvt_pk_bf16(r[6], r[7]);
                *(u32x4*)rowp = w; }
    }
};

template <class Epi> __device__ __forceinline__ void run_gemm(unsigned char* smem, const bf16_t* A, const bf16_t* Bt, int M, int N, int K, const Epi& E) {
    pg8::Gemm g; g.A = A; g.Bt = Bt; g.M = M; g.N = N; g.K = K;
    pg8::StaticOrder S; S.init(M, N, (int)gridDim.x, (int)blockIdx.x);
    pg8::gemm_phase<Epi, pg8::StaticOrder, false>((PG8_LAS unsigned char*)smem, g, S, E, nullptr);
    __syncthreads();
}

__device__ __forceinline__ void transpose_item(const float* W, int K, int N, bf16_t* WT, int dst_row0, int src_col0, float* scr, int k0, int lane) {
    if (src_col0 >= 0) {
#pragma unroll 8
        for (int i = 0; i < 32; ++i) { const int kk = 2 * i + (lane >> 5); scr[kk * 33 + (lane & 31)] = W[(size_t)(k0 + kk) * N + src_col0 + (lane & 31)]; }
    } else {
#pragma unroll 8
        for (int i = 0; i < 32; ++i) { const int kk = 2 * i + (lane >> 5); scr[kk * 33 + (lane & 31)] = 0.f; }
    }
    asm volatile("s_waitcnt lgkmcnt(0)" ::: "memory");
    const int c = lane & 7;
#pragma unroll
    for (int j = 0; j < 4; ++j) { const int n = (lane >> 3) + 8 * j; const float* s = scr + (8 * c) * 33 + n;
        u32x4 o; o.x = pk2(s[0], s[33]); o.y = pk2(s[2 * 33], s[3 * 33]); o.z = pk2(s[4 * 33], s[5 * 33]); o.w = pk2(s[6 * 33], s[7 * 33]);
        *(u32x4*)(WT + (size_t)(dst_row0 + n) * K + k0 + 8 * c) = o; }
    asm volatile("s_waitcnt lgkmcnt(0)" ::: "memory");
}
__device__ __forceinline__ int win_src_col(int n0) {
    if (n0 < 6592) return n0;
    if (n0 < 6624) return 7616 + (n0 - 6592);
    if (n0 < 6656) return -1;
    const int j = n0 - 6656;
    return j < 1024 ? 6592 + j : 7648 + (j - 1024);
}

__device__ __forceinline__ void phase_prep(const Params& P, unsigned char* smem) {
    const int tid = threadIdx.x, lane = tid & 63, wave = tid >> 6;
    float* MOD = (float*)(P.ws + WS_M);
    if ((int)blockIdx.x < 192) {
        float* sT = (float*)smem;
        float* red = (float*)(smem + 98304);
        const float* c = P.in[1]; const float* cc = P.in[3];
        for (int idx = tid; idx < 9 * D; idx += 512) { const int m = idx >> 11, k = idx & 2047; const float v = m < 8 ? c[m * D + k] : cc[k]; sT[k * 12 + m] = v * sigm(v); }
        __syncthreads();
        const float* W = P.in[4]; const float* bias = P.in[5];
        for (int item = blockIdx.x; item < 192; item += gridDim.x) {
            const int n0 = item * 64, cl = tid & 15, kl = tid >> 4;
            float acc[9][4];
#pragma unroll
            for (int m = 0; m < 9; ++m)
#pragma unroll
                for (int e = 0; e < 4; ++e) acc[m][e] = 0.f;
#pragma unroll 4
            for (int kk = 0; kk < 64; ++kk) { const int k = kk * 32 + kl;
                const f32x4 w = *(const f32x4*)(W + (size_t)k * NADA + n0 + 4 * cl);
                const f32x4 s0 = *(const f32x4*)(sT + k * 12), s1 = *(const f32x4*)(sT + k * 12 + 4); const float s2 = sT[k * 12 + 8];
#pragma unroll
                for (int e = 0; e < 4; ++e) { acc[0][e] += s0[0] * w[e]; acc[1][e] += s0[1] * w[e]; acc[2][e] += s0[2] * w[e]; acc[3][e] += s0[3] * w[e];
                    acc[4][e] += s1[0] * w[e]; acc[5][e] += s1[1] * w[e]; acc[6][e] += s1[2] * w[e]; acc[7][e] += s1[3] * w[e]; acc[8][e] += s2 * w[e]; } }
#pragma unroll
            for (int m = 0; m < 9; ++m)
#pragma unroll
                for (int e = 0; e < 4; ++e) { float v = acc[m][e]; v += __shfl_xor(v, 16); v += __shfl_xor(v, 32); if ((lane >> 4) == 0) red[(wave * 9 + m) * 64 + 4 * cl + e] = v; }
            __syncthreads();
            for (int o = tid; o < 576; o += 512) { const int m = o >> 6, c2 = o & 63; float s = bias[n0 + c2];
#pragma unroll
                for (int w8 = 0; w8 < 8; ++w8) s += red[(w8 * 9 + m) * 64 + c2];
                MOD[m * NADA + n0 + c2] = s; }
            __syncthreads();
        }
    }
    __syncthreads();
    float* scr = (float*)(smem + wave * 8448);
    const int gw = blockIdx.x * 8 + wave, NGW = gridDim.x * 8;
    bf16_t* WT_IN = (bf16_t*)(P.ws + WS_A); bf16_t* WT_PA = (bf16_t*)(P.ws + WS_B); bf16_t* WT_PB = WT_PA + 2048 * 1024; bf16_t* WT_OUT = WT_PB + 2048 * 1024;
    constexpr int I_IN = 368 * 32, I_PA = 64 * 16, I_OUT = 64 * 32;
    for (int it = gw; it < I_IN + 2 * I_PA + I_OUT; it += NGW) {
        int r = it;
        if (r < I_IN) { const int nb = r % 368, kb = r / 368; transpose_item(P.in[7], 2048, 11744, WT_IN, nb * 32, win_src_col(nb * 32), scr, kb * 64, lane); continue; } r -= I_IN;
        if (r < I_PA) { const int nb = r % 64, kb = r / 64; transpose_item(P.in[23], 1024, 2048, WT_PA, nb * 32, nb * 32, scr, kb * 64, lane); continue; } r -= I_PA;
        if (r < I_PA) { const int nb = r % 64, kb = r / 64; transpose_item(P.in[24], 1024, 2048, WT_PB, nb * 32, nb * 32, scr, kb * 64, lane); continue; } r -= I_PA;
        { const int nb = r % 64, kb = r / 64; transpose_item(P.in[25], 2048, 2048, WT_OUT, nb * 32, nb * 32, scr, kb * 64, lane); }
    }
}
__device__ __forceinline__ void phase_ffn_weights(const Params& P, unsigned char* smem) {
    const int tid = threadIdx.x, lane = tid & 63, wave = tid >> 6;
    float* scr = (float*)(smem + wave * 8448);
    const int gw = blockIdx.x * 8 + wave, NGW = gridDim.x * 8;
    bf16_t* WT_GU = (bf16_t*)(P.ws + WS_A); bf16_t* WT_DN = (bf16_t*)(P.ws + WS_F);
    constexpr int I_GU = 352 * 32, I_DN = 64 * 88;
    for (int it = gw; it < I_GU + I_DN; it += NGW) {
        int r = it;
        if (r < I_GU) { const int nb = r % 352, kb = r / 352; const int n0 = nb * 32, pn = n0 >> 8, cq = n0 & 255; const int src = cq < 128 ? 128 * pn + cq : FFH + 128 * pn + (cq - 128);
            transpose_item(P.in[27], 2048, 2 * FFH, WT_GU, n0, src, scr, kb * 64, lane); continue; } r -= I_GU;
        { const int nb = r % 64, kb = r / 64; transpose_item(P.in[28], FFH, 2048, WT_DN, nb * 32, nb * 32, scr, kb * 64, lane); }
    }
}

__device__ __forceinline__ void norm_mod_row(const float* src, const float* nw, const float* sh, const float* sc, bf16_t* dst, int lane) {
    f32x4 v[8]; float ss = 0.f;
#pragma unroll
    for (int j = 0; j < 8; ++j) { v[j] = *(const f32x4*)(src + (j * 64 + lane) * 4); ss += v[j][0] * v[j][0] + v[j][1] * v[j][1] + v[j][2] * v[j][2] + v[j][3] * v[j][3]; }
    const float rstd = rsqrtf(wave_sum(ss) * (1.f / D) + 1e-6f);
#pragma unroll
    for (int j = 0; j < 8; ++j) { const int c = (j * 64 + lane) * 4; const f32x4 w = *(const f32x4*)(nw + c), a = *(const f32x4*)(sh + c), b = *(const f32x4*)(sc + c);
        float o[4];
#pragma unroll
        for (int e = 0; e < 4; ++e) o[e] = (v[j][e] * rstd * w[e]) * (1.f + b[e]) + a[e];
        uint2 pk; pk.x = pk2(o[0], o[1]); pk.y = pk2(o[2], o[3]); *(uint2*)(dst + c) = pk; }
}
__device__ __forceinline__ void phase_norm1(const Params& P) {
    const int lane = threadIdx.x & 63, gw = blockIdx.x * 8 + (threadIdx.x >> 6), NGW = gridDim.x * 8;
    const float* MOD = (const float*)(P.ws + WS_M); bf16_t* H = (bf16_t*)P.out;
    for (int row = gw; row < MALL; row += NGW) {
        const float* src = row < MLAT ? P.in[0] + (size_t)row * D : P.in[2] + (size_t)(row - MLAT) * D;
        const int mr = row < MLAT ? (row >> 11) : 8;
        norm_mod_row(src, P.in[6], MOD + mr * NADA, MOD + mr * NADA + D, H + (size_t)row * D, lane);
    }
}
__device__ __forceinline__ void phase_norm2(const Params& P) {
    const int lane = threadIdx.x & 63, gw = blockIdx.x * 8 + (threadIdx.x >> 6), NGW = gridDim.x * 8;
    const float* MOD = (const float*)(P.ws + WS_M); bf16_t* H2 = (bf16_t*)(P.ws + WS_D);
    for (int row = gw; row < MLAT; row += NGW) { const int mr = row >> 11;
        norm_mod_row(P.out + (size_t)row * D, P.in[26], MOD + mr * NADA + 3 * D, MOD + mr * NADA + 4 * D, H2 + (size_t)row * D, lane); }
}
__device__ __forceinline__ void phase_final_norm(const Params& P) {
    const int lane = threadIdx.x & 63, gw = blockIdx.x * 8 + (threadIdx.x >> 6), NGW = gridDim.x * 8;
    const float* nw = P.in[29];
    for (int row = gw; row < MLAT; row += NGW) { float* src = P.out + (size_t)row * D;
        f32x4 v[8]; float ss = 0.f;
#pragma unroll
        for (int j = 0; j < 8; ++j) { v[j] = *(const f32x4*)(src + (j * 64 + lane) * 4); ss += v[j][0] * v[j][0] + v[j][1] * v[j][1] + v[j][2] * v[j][2] + v[j][3] * v[j][3]; }
        const float rstd = rsqrtf(wave_sum(ss) * (1.f / D) + 1e-6f);
#pragma unroll
        for (int j = 0; j < 8; ++j) { const int c = (j * 64 + lane) * 4; const f32x4 w = *(const f32x4*)(nw + c); *(f32x4*)(src + c) = v[j] * rstd * w; }
    }
}

__device__ __forceinline__ float mixed_load(const bf16_t* P1, int row, int t, bool isctx, int col, const float* mu) {
    const float p = bf2f(P1[(size_t)row * LD1 + col]);
    int nrow; bool valid;
    if (isctx) { if (col & 1) { valid = t < TC - 1; nrow = row + 1; } else { valid = t > 0; nrow = row - 1; } }
    else { const int m = col & 3, x = t & 63, y = t >> 6;
        if (m == 0) { valid = x > 0; nrow = row - 1; } else if (m == 1) { valid = x < 63; nrow = row + 1; }
        else if (m == 2) { valid = y > 0; nrow = row - 64; } else { valid = y < 31; nrow = row + 64; } }
    const float ps = valid ? bf2f(P1[(size_t)nrow * LD1 + col]) : 0.f;
    return p + (ps - p) * mu[col];
}

constexpr int CH = 32, NCHUNK = (TC + TL) / CH;
constexpr int L_WR = 0, L_KD = 8192, L_V = 16384, L_W = 24576, L_BB = 32768, L_KK = 40960, L_THW = 49152, L_THA = 61440, L_SC = 73728;
constexpr int L_G = 74240, LG_K = L_G, LG_Q = L_G + 16384, LG_V = L_G + 32768, LG_SC = L_G + 40960, LG_RAW = L_G + 41472, LG_CW = L_G + 64512;

__device__ __forceinline__ void phase_scan(const Params& P, unsigned char* smem) {
    const int tid = threadIdx.x, lane = tid & 63, wave = tid >> 6;
    const bool is_rw = wave < 4;
    const int q = tid & 255;
    const bf16_t* P1 = (const bf16_t*)(P.ws + WS_X);
    bf16_t* YD = (bf16_t*)P.out;
    bf16_t* OD = YD + (size_t)2 * MLAT * 1024;
    float* SBON = (float*)(P.ws + WS_M + MiB);
    float* A_wr = (float*)(smem + L_WR); float* A_kd = (float*)(smem + L_KD); float* A_v = (float*)(smem + L_V); float* A_w = (float*)(smem + L_W);
    float* A_bb = (float*)(smem + L_BB); float* A_kk = (float*)(smem + L_KK); float* TH_w = (float*)(smem + L_THW); float* TH_a = (float*)(smem + L_THA); float* SC = (float*)(smem + L_SC);
    float* G_k = (float*)(smem + LG_K); float* G_q = (float*)(smem + LG_Q); float* G_v = (float*)(smem + LG_V); float* G_sc = (float*)(smem + LG_SC);
    bf16_t* G_raw = (bf16_t*)(smem + LG_RAW); float* G_cw = (float*)(smem + LG_CW);
    const float* mu = P.in[8];
    for (int it = blockIdx.x; it < 256; it += gridDim.x) {
        const int b = it >> 5, r5 = it & 31;
        const int h = r5 >> 1, d_rw = r5 & 1;
        const int hg = r5 >> 2, d_g = (r5 >> 1) & 1, half = r5 & 1;
        const int d = is_rw ? d_rw : d_g;
        float S[2][16];
#pragma unroll
        for (int r = 0; r < 2; ++r)
#pragma unroll
            for (int j = 0; j < 16; ++j) S[r][j] = 0.f;
        if (!is_rw) {
            for (int e = q; e < 5 * 320; e += 256) { const int j = e / 320, cc = e % 320;
                const int ccol = cc < 128 ? hg * 128 + cc : (cc < 256 ? 1024 + hg * 128 + (cc - 128) : 2048 + hg * 128 + half * 64 + (cc - 256));
                G_cw[j * 320 + cc] = P.in[19][j * 3072 + ccol]; }
        }
        for (int ch = 0; ch < NCHUNK; ++ch) {
            const bool isctx = ch < 8;
            const int sbase = isctx ? ch * CH : (ch - 8) * CH, Tlen = isctx ? TC : TL;
            const int rowbase = isctx ? MLAT + b * TC : b * TL;
            const int t0 = d == 0 ? sbase : Tlen - 1 - sbase, sgn = d == 0 ? 1 : -1;
            if (is_rw) {
                for (int e = q; e < CH * 384; e += 256) { const int i = e / 384, cc = e % 384; const int t = t0 + sgn * i, row = rowbase + t;
                    int col; float* dst;
                    if (cc < 64) { col = h * 64 + cc; dst = A_wr + i * 64 + cc; }
                    else if (cc < 128) { col = 1024 + h * 64 + (cc - 64); dst = A_kd + i * 64 + (cc - 64); }
                    else if (cc < 192) { col = 2048 + h * 64 + (cc - 128); dst = A_v + i * 64 + (cc - 128); }
                    else if (cc < 288) { col = 3072 + d * 96 + (cc - 192); dst = TH_w + i * 96 + (cc - 192); }
                    else { col = 3264 + d * 96 + (cc - 288); dst = TH_a + i * 96 + (cc - 288); }
                    float xs = mixed_load(P1, row, t, isctx, col, mu);
                    if (cc >= 192 && cc < 288) xs = tanhf(xs);
                    *dst = xs; }
            } else {
                const int lo = d == 0 ? sbase : Tlen - sbase - CH;
                for (int e = q; e < 36 * 320; e += 256) { const int wt = e / 320, cc = e % 320; const int t = lo - 2 + wt;
                    const int col = COL_CV + (cc < 128 ? hg * 128 + cc : (cc < 256 ? 1024 + hg * 128 + (cc - 128) : 2048 + hg * 128 + half * 64 + (cc - 256)));
                    G_raw[wt * 320 + cc] = (t >= 0 && t < Tlen) ? P1[(size_t)(rowbase + t) * LD1 + col] : (bf16_t)0; }
                if (q < CH) { const int t = t0 + sgn * q; const size_t ro = (size_t)(rowbase + t) * LD1 + COL_AB;
                    const float a_raw = bf2f(P1[ro + d * 8 + hg]), b_raw = bf2f(P1[ro + 16 + d * 8 + hg]);
                    const float xx = a_raw + P.in[21][d * 8 + hg]; const float sp = xx > 20.f ? xx : log1pf(__expf(xx));
                    const float g = -__expf(P.in[20][d * 8 + hg]) * sp;
                    G_sc[q * 4 + 0] = __expf(g); G_sc[q * 4 + 1] = sigm(b_raw); }
            }
            __syncthreads();
            if (is_rw) {
                const int c = q & 63, ig = q >> 6;
                float aw[8], aa[8];
#pragma unroll
                for (int n = 0; n < 8; ++n) { aw[n] = 0.f; aa[n] = 0.f; }
                const float* w2 = P.in[10] + (size_t)d * 96 * 1024 + h * 64 + c; const float* a2 = P.in[12] + (size_t)d * 96 * 1024 + h * 64 + c;
                for (int r4 = 0; r4 < 24; ++r4) {
                    float wv[4], av[4];
#pragma unroll
                    for (int e = 0; e < 4; ++e) { wv[e] = w2[(size_t)(4 * r4 + e) * 1024]; av[e] = a2[(size_t)(4 * r4 + e) * 1024]; }
#pragma unroll
                    for (int n = 0; n < 8; ++n) { const f32x4 tw = *(const f32x4*)(TH_w + (ig * 8 + n) * 96 + 4 * r4), ta = *(const f32x4*)(TH_a + (ig * 8 + n) * 96 + 4 * r4);
#pragma unroll
                        for (int e = 0; e < 4; ++e) { aw[n] += tw[e] * wv[e]; aa[n] += ta[e] * av[e]; } }
                }
                const float w0 = P.in[9][d * 1024 + h * 64 + c], a0 = P.in[11][d * 1024 + h * 64 + c];
#pragma unroll
                for (int n = 0; n < 8; ++n) { const int i = ig * 8 + n;
                    A_w[i * 64 + c] = __expf(-0.6065306597126334f * sigm(w0 + aw[n]));
                    A_bb[i * 64 + c] = sigm(a0 + aa[n]); }
            } else {
                for (int e = q; e < CH * 320; e += 256) { const int i = e / 320, cc = e % 320; const int wc0 = (d == 0 ? i : CH - 1 - i);
                    float acc = 0.f;
#pragma unroll
                    for (int j = 0; j < 5; ++j) acc += G_cw[j * 320 + cc] * bf2f(G_raw[(wc0 + j) * 320 + cc]);
                    const float u = acc * sigm(acc);
                    if (cc < 128) G_q[i * 128 + cc] = u; else if (cc < 256) G_k[i * 128 + (cc - 128)] = u; else G_v[i * 64 + (cc - 256)] = u; }
            }
            __syncthreads();
            if (is_rw) {
                const int c = q & 63, ig = q >> 6, hc = h * 64 + c;
                const float kkw = P.in[14][hc], kaw = P.in[15][hc], rkw = P.in[16][hc];
#pragma unroll 2
                for (int n = 0; n < 8; ++n) { const int i = ig * 8 + n;
                    const float xr = A_wr[i * 64 + c], xk = A_kd[i * 64 + c], w = A_w[i * 64 + c], ic = A_bb[i * 64 + c];
                    const float kkr = xk * kkw; const float ss = wave_sum(kkr * kkr); const float kk = kkr * rsqrtf(ss + 1e-6f);
                    const float kd = xk * (1.f + (ic - 1.f) * kaw), bb = kk * ic;
                    const float br = wave_sum(bb * xr), kr = wave_sum(kd * xr), sb = 0.5f * wave_sum(xr * kd * rkw);
                    A_kk[i * 64 + c] = kk; A_wr[i * 64 + c] = w * xr; A_kd[i * 64 + c] = kd; A_bb[i * 64 + c] = bb;
                    if (c == 0) { SC[i * 4 + 0] = br; SC[i * 4 + 1] = kr; if (!isctx) SBON[((size_t)d * MLAT + rowbase + t0 + sgn * i) * 16 + h] = sb; } }
            } else {
                const int wv = q >> 6;
#pragma unroll 2
                for (int n = 0; n < 8; ++n) { const int i = wv * 8 + n;
                    const float q0 = G_q[i * 128 + lane], q1 = G_q[i * 128 + 64 + lane], k0 = G_k[i * 128 + lane], k1 = G_k[i * 128 + 64 + lane];
                    const float rq = rsqrtf(wave_sum(q0 * q0 + q1 * q1) + 1e-6f) * 0.08838834764831845f, rk = rsqrtf(wave_sum(k0 * k0 + k1 * k1) + 1e-6f);
                    const float q0n = q0 * rq, q1n = q1 * rq, k0n = k0 * rk, k1n = k1 * rk;
                    G_q[i * 128 + lane] = q0n; G_q[i * 128 + 64 + lane] = q1n; G_k[i * 128 + lane] = k0n; G_k[i * 128 + 64 + lane] = k1n;
                    const float kq = wave_sum(q0n * k0n + q1n * k1n);
                    if (lane == 0) G_sc[i * 4 + 2] = kq; }
            }
            __syncthreads();
            if (is_rw) {
                const int cgp = q & 7, rgp = q >> 3, j0 = 8 * cgp;
                for (int i = 0; i < CH; ++i) {
                    float kk8[8], wr8[8], w8[8], bb8[8], kd8[8];
#pragma unroll
                    for (int e = 0; e < 2; ++e) { const f32x4 a = *(const f32x4*)(A_kk + i * 64 + j0 + 4 * e), b2 = *(const f32x4*)(A_wr + i * 64 + j0 + 4 * e), c2 = *(const f32x4*)(A_w + i * 64 + j0 + 4 * e),
                            d2 = *(const f32x4*)(A_bb + i * 64 + j0 + 4 * e), e2 = *(const f32x4*)(A_kd + i * 64 + j0 + 4 * e);
#pragma unroll
                        for (int x = 0; x < 4; ++x) { kk8[4 * e + x] = a[x]; wr8[4 * e + x] = b2[x]; w8[4 * e + x] = c2[x]; bb8[4 * e + x] = d2[x]; kd8[4 * e + x] = e2[x]; } }
                    const float2 v2 = *(const float2*)(A_v + i * 64 + 2 * rgp); const float2 sc = *(const float2*)(SC + i * 4);
                    float sa0 = 0.f, sa1 = 0.f, pp0 = 0.f, pp1 = 0.f;
#pragma unroll
                    for (int j = 0; j < 8; ++j) { sa0 += S[0][j] * kk8[j]; pp0 += S[0][j] * wr8[j]; sa1 += S[1][j] * kk8[j]; pp1 += S[1][j] * wr8[j]; }
                    sa0 = red8(sa0); sa1 = red8(sa1); pp0 = red8(pp0); pp1 = red8(pp1);
                    const float y0 = pp0 - sa0 * sc.x + v2.x * sc.y, y1 = pp1 - sa1 * sc.x + v2.y * sc.y;
#pragma unroll
                    for (int j = 0; j < 8; ++j) { S[0][j] = S[0][j] * w8[j] - sa0 * bb8[j] + v2.x * kd8[j]; S[1][j] = S[1][j] * w8[j] - sa1 * bb8[j] + v2.y * kd8[j]; }
                    if (!isctx && cgp == 0) *(unsigned*)(YD + ((size_t)d * MLAT + rowbase + t0 + sgn * i) * 1024 + h * 64 + 2 * rgp) = pk2(y0, y1);
                }
            } else {
                const int cgp = q & 7, rgp = q >> 3, j0 = 16 * cgp;
                for (int i = 0; i < CH; ++i) {
                    float k16[16], q16[16];
#pragma unroll
                    for (int e = 0; e < 4; ++e) { const f32x4 a = *(const f32x4*)(G_k + i * 128 + j0 + 4 * e), b2 = *(const f32x4*)(G_q + i * 128 + j0 + 4 * e);
#pragma unroll
                        for (int x = 0; x < 4; ++x) { k16[4 * e + x] = a[x]; q16[4 * e + x] = b2[x]; } }
                    const float2 v2 = *(const float2*)(G_v + i * 64 + 2 * rgp); const f32x4 sc = *(const f32x4*)(G_sc + i * 4);
                    float u0 = 0.f, u1 = 0.f, p0 = 0.f, p1 = 0.f;
#pragma unroll
                    for (int j = 0; j < 16; ++j) { u0 += S[0][j] * k16[j]; p0 += S[0][j] * q16[j]; u1 += S[1][j] * k16[j]; p1 += S[1][j] * q16[j]; }
                    u0 = red8(u0); u1 = red8(u1); p0 = red8(p0); p1 = red8(p1);
                    const float dl0 = sc[1] * (v2.x - sc[0] * u0), dl1 = sc[1] * (v2.y - sc[0] * u1);
                    const float o0 = sc[0] * p0 + dl0 * sc[2], o1 = sc[0] * p1 + dl1 * sc[2];
#pragma unroll
                    for (int j = 0; j < 16; ++j) { S[0][j] = sc[0] * S[0][j] + dl0 * k16[j]; S[1][j] = sc[0] * S[1][j] + dl1 * k16[j]; }
                    if (!isctx && cgp == 0) *(unsigned*)(OD + ((size_t)d * MLAT + rowbase + t0 + sgn * i) * 1024 + hg * 128 + half * 64 + 2 * rgp) = pk2(o0, o1);
                }
            }
            __syncthreads();
        }
    }
}

__device__ __forceinline__ void phase_readout(const Params& P, unsigned char* smem) {
    const int tid = threadIdx.x, lane = tid & 63, wave = tid >> 6;
    const bf16_t* P1 = (const bf16_t*)(P.ws + WS_X); const bf16_t* P2 = (const bf16_t*)(P.ws + WS_D);
    const bf16_t* YD = (const bf16_t*)P.out; const bf16_t* OD = YD + (size_t)2 * MLAT * 1024;
    const float* SBON = (const float*)(P.ws + WS_M + MiB);
    bf16_t* OA = (bf16_t*)(P.ws + WS_A); bf16_t* OB = (bf16_t*)(P.ws + WS_F);
    const float* mu = P.in[8];
    { const int gw = blockIdx.x * 8 + wave, NGW = gridDim.x * 8; const float* nw = P.in[22];
      for (int row = gw; row < MLAT; row += NGW) { const int c0 = lane * 16;
        const u32x4 a0 = *(const u32x4*)(OD + (size_t)row * 1024 + c0), a1 = *(const u32x4*)(OD + (size_t)row * 1024 + c0 + 8);
        const u32x4 b0 = *(const u32x4*)(OD + ((size_t)MLAT + row) * 1024 + c0), b1 = *(const u32x4*)(OD + ((size_t)MLAT + row) * 1024 + c0 + 8);
        const u32x4 z0 = *(const u32x4*)(P2 + (size_t)row * LD2 + c0), z1 = *(const u32x4*)(P2 + (size_t)row * LD2 + c0 + 8);
        float o[16], z[16];
#pragma unroll
        for (int e = 0; e < 4; ++e) { o[2 * e] = __uint_as_float(a0[e] << 16) + __uint_as_float(b0[e] << 16); o[2 * e + 1] = __uint_as_float(a0[e] & 0xffff0000u) + __uint_as_float(b0[e] & 0xffff0000u);
            o[8 + 2 * e] = __uint_as_float(a1[e] << 16) + __uint_as_float(b1[e] << 16); o[8 + 2 * e + 1] = __uint_as_float(a1[e] & 0xffff0000u) + __uint_as_float(b1[e] & 0xffff0000u);
            z[2 * e] = __uint_as_float(z0[e] << 16); z[2 * e + 1] = __uint_as_float(z0[e] & 0xffff0000u); z[8 + 2 * e] = __uint_as_float(z1[e] << 16); z[8 + 2 * e + 1] = __uint_as_float(z1[e] & 0xffff0000u); }
        float ss = 0.f;
#pragma unroll
        for (int e = 0; e < 16; ++e) ss += o[e] * o[e];
        ss = red8(ss);
        const float rs = rsqrtf(ss * (1.f / 128.f) + 1e-6f);
        float r[16];
#pragma unroll
        for (int e = 0; e < 16; ++e) r[e] = o[e] * rs * nw[(c0 + e) & 127] * (z[e] * sigm(z[e]));
        u32x4 w0, w1;
#pragma unroll
        for (int e = 0; e < 4; ++e) { w0[e] = pk2(r[2 * e], r[2 * e + 1]); w1[e] = pk2(r[8 + 2 * e], r[8 + 2 * e + 1]); }
        *(u32x4*)(OB + (size_t)row * 1024 + c0) = w0; *(u32x4*)(OB + (size_t)row * 1024 + c0 + 8) = w1; } }
    float* sigT = (float*)smem;
    const float* g2 = P.in[13]; const float* lnw = P.in[17]; const float* lnb = P.in[18];
    for (int item = blockIdx.x; item < MLAT / 16; item += gridDim.x) {
        const int row0 = item * 16;
        __syncthreads();
        for (int e = tid; e < 1024; e += 512) { const int tt = e >> 6, r = e & 63; const int row = row0 + tt;
            sigT[r * 16 + tt] = sigm(mixed_load(P1, row, row & 2047, false, 3456 + r, mu)); }
        __syncthreads();
        float g[2][16];
#pragma unroll
        for (int x = 0; x < 2; ++x)
#pragma unroll
            for (int tt = 0; tt < 16; ++tt) g[x][tt] = 0.f;
        for (int r = 0; r < 64; ++r) { const float ga = g2[r * 1024 + tid], gb = g2[r * 1024 + 512 + tid];
#pragma unroll
            for (int t4 = 0; t4 < 4; ++t4) { const f32x4 s = *(const f32x4*)(sigT + r * 16 + 4 * t4);
#pragma unroll
                for (int e = 0; e < 4; ++e) { g[0][4 * t4 + e] += s[e] * ga; g[1][4 * t4 + e] += s[e] * gb; } } }
#pragma unroll
        for (int x = 0; x < 2; ++x) { const int c = tid + 512 * x, hd = c >> 6; const float lw = lnw[c], lb = lnb[c];
#pragma unroll
            for (int tt = 0; tt < 16; ++tt) { const int row = row0 + tt;
                const float y = bf2f(YD[(size_t)row * 1024 + c]) + bf2f(YD[((size_t)MLAT + row) * 1024 + c]);
                const float m = wave_sum(y) * (1.f / 64.f); const float dv = y - m; const float var = wave_sum(dv * dv) * (1.f / 64.f);
                const float yn = dv * rsqrtf(var + 64e-5f) * lw + lb;
                const float sb = SBON[(size_t)row * 16 + hd] + SBON[((size_t)MLAT + row) * 16 + hd];
                const float xv = mixed_load(P1, row, row & 2047, false, 2048 + c, mu);
                OA[(size_t)row * 1024 + c] = f2bf((yn + sb * xv) * g[x][tt]); } }
    }
}

__global__ void __launch_bounds__(512, 2) fwd_mega(Params P) {
    extern __shared__ __attribute__((aligned(16))) unsigned char smem[];
    cg::grid_group grid = cg::this_grid();
    bf16_t* WT_IN = (bf16_t*)(P.ws + WS_A); bf16_t* WT_PA = (bf16_t*)(P.ws + WS_B); bf16_t* WT_PB = WT_PA + 2048 * 1024; bf16_t* WT_OUT = WT_PB + 2048 * 1024;
    bf16_t* P1 = (bf16_t*)(P.ws + WS_X); bf16_t* P2 = (bf16_t*)(P.ws + WS_D); bf16_t* H = (bf16_t*)P.out;
    bf16_t* OA = (bf16_t*)(P.ws + WS_A); bf16_t* OB = (bf16_t*)(P.ws + WS_F); bf16_t* MBUF = (bf16_t*)(P.ws + WS_X); bf16_t* A3 = (bf16_t*)(P.ws + WS_X);
    bf16_t* H2 = (bf16_t*)(P.ws + WS_D); bf16_t* WT_GU = (bf16_t*)(P.ws + WS_A); bf16_t* WT_DN = (bf16_t*)(P.ws + WS_F);
    const float* MOD = (const float*)(P.ws + WS_M);
#define PHASE(n) if (P.ph_lo <= (n) && (n) < P.ph_hi)
#define SEAM(n) do { if (P.coop && P.ph_lo <= (n) && (n) + 1 < P.ph_hi) grid.sync(); } while (0)
    PHASE(0) { phase_prep(P, smem); } SEAM(0);
    PHASE(1) { phase_norm1(P); } SEAM(1);
    PHASE(2) { EpiBf16Plain e1{P1, LD1}; run_gemm(smem, H, WT_IN, MALL, N1, D, e1);
               EpiBf16Plain e2{P2, LD2}; run_gemm(smem, H, WT_IN + (size_t)N1 * D, MLAT, N2, D, e2); } SEAM(2);
    PHASE(3) { phase_scan(P, smem); } SEAM(3);
    PHASE(4) { phase_readout(P, smem); } SEAM(4);
    PHASE(5) { EpiGate<false> ea{MBUF, P2 + 1024}; run_gemm(smem, OA, WT_PA, MLAT, D, 1024, ea);
               EpiGate<true> eb{MBUF, P2 + 1024 + 2048}; run_gemm(smem, OB, WT_PB, MLAT, D, 1024, eb); } SEAM(5);
    PHASE(6) { EpiRes e{P.out, P.in[0], MOD + 2 * D}; run_gemm(smem, MBUF, WT_OUT, MLAT, D, D, e); } SEAM(6);
    PHASE(7) { phase_norm2(P); phase_ffn_weights(P, smem); } SEAM(7);
    PHASE(8) { EpiSwiglu e{A3}; run_gemm(smem, H2, WT_GU, MLAT, 2 * FFH, D, e); } SEAM(8);
    PHASE(9) { EpiRes e{P.out, P.out, MOD + 5 * D}; run_gemm(smem, A3, WT_DN, MLAT, D, FFH, e); } SEAM(9);
    PHASE(10) { phase_final_norm(P); }
}

#ifndef N_LAUNCH_PER_PHASE
#define N_LAUNCH_PER_PHASE 0
#endif
extern "C" void kernel_launch(void* const* d_in, const int* in_sizes, int n_in, void* d_out, int out_size, void* d_ws, size_t ws_size, hipStream_t stream) {
    static int grid = 0;
    if (grid == 0) {
        if (n_in != 30 || out_size != MLAT * D || ws_size < WS_END) { fprintf(stderr, "kernel_launch: unexpected shapes: n_in %d out %d ws %zu (need %zu)\n", n_in, out_size, ws_size, (size_t)WS_END); grid = -1; return; }
        int dev = 0, cus = 0, per_cu = 0;
        if (hipGetDevice(&dev) != hipSuccess || hipDeviceGetAttribute(&cus, hipDeviceAttributeMultiprocessorCount, dev) != hipSuccess) { grid = -1; return; }
        if (hipFuncSetAttribute((const void*)fwd_mega, hipFuncAttributeMaxDynamicSharedMemorySize, LDS_BYTES) != hipSuccess) { fprintf(stderr, "kernel_launch: hipFuncSetAttribute failed\n"); grid = -1; return; }
        if (hipOccupancyMaxActiveBlocksPerMultiprocessor(&per_cu, (const void*)fwd_mega, 512, LDS_BYTES) != hipSuccess || per_cu < 1) { fprintf(stderr, "kernel_launch: occupancy query gives %d\n", per_cu); grid = -1; return; }
        grid = cus * per_cu; if (grid > 256) grid = 256;
    }
    if (grid < 0) return;
    Params p{};
    for (int i = 0; i < 30; ++i) p.in[i] = (const float*)d_in[i];
    p.out = (float*)d_out; p.ws = (unsigned char*)d_ws;
#if N_LAUNCH_PER_PHASE
    for (int ph = 0; ph < 11; ++ph) { p.ph_lo = ph; p.ph_hi = ph + 1; p.coop = 0; hipLaunchKernelGGL(fwd_mega, dim3(grid), dim3(512), LDS_BYTES, stream, p); }
#else
    p.ph_lo = 0; p.ph_hi = 11; p.coop = 1;
    void* args[] = {&p};
    hipError_t e = hipLaunchCooperativeKernel((const void*)fwd_mega, dim3(grid), dim3(512), args, LDS_BYTES, stream);
    if (e != hipSuccess) fprintf(stderr, "cooperative launch failed: %s (grid %d)\n", hipGetErrorString(e), grid);
#endif
}
```

```cpp
#include <hip/hip_runtime.h>
#include <hip/hip_cooperative_groups.h>
#include <cstdio>
#include <cstdint>
namespace cg = cooperative_groups;
namespace pg8 {
#define PG8_LAS __attribute__((address_space(3)))
typedef unsigned short bf16_t;
typedef short bf16x8 __attribute__((ext_vector_type(8)));
typedef float f32x4 __attribute__((ext_vector_type(4)));
typedef unsigned u32x4 __attribute__((ext_vector_type(4)));
constexpr int BM = 256, BK = 64, HALF = 128, HTB = HALF * BK * 2  , STAGE_BYTES = 8 * HTB, NXCD = 8, WGM = 8;

__host__ __device__ __forceinline__ int lds_byte(int r, int c) { const int st = (r >> 4) * 2 + (c >> 5), rr = r & 15, cc = c & 31, ob = rr * 64 + cc * 2; return st * 1024 + (ob ^ (((ob >> 9) & 1) << 5)); }
__host__ __device__ __forceinline__ void stage_rc(int b, int& R, int& C) { const int st = b / 1024, sb = b % 1024, swz = sb ^ (((sb >> 9) & 1) << 5); R = (st >> 1) * 16 + swz / 64; C = (st & 1) * 32 + (swz % 64) / 2; }
__host__ __device__ __forceinline__ int perm32(int rho) { const int n = rho >> 4, i = rho & 15; return 8 * (i >> 2) + 4 * n + (i & 3); }

struct Unit { int pm, pn; };
struct Gemm { const bf16_t* A; const bf16_t* Bt; int M, N, K; int ablk; };

struct StaticOrder {
    int nM, nN, nwg, G, c;
    __host__ __device__ void init(int M, int N, int G_, int c_) { nM = M / BM; nN = N / BM; nwg = nM * nN; G = G_; c = c_; }
    __host__ __device__ bool next(int i, Unit& u) const {
        const long L = (long)i * G + c; if (L >= nwg) return false;
        int wgid = (int)L; { const int q = nwg / NXCD, r = nwg % NXCD, xcd = wgid % NXCD, off = wgid / NXCD; wgid = (xcd < r ? xcd * (q + 1) : r * (q + 1) + (xcd - r) * q) + off; }
        const int nig = WGM * nN, gid = wgid / nig, fm = gid * WGM, gsz = (nM - fm) < WGM ? (nM - fm) : WGM;
        u.pm = fm + ((wgid % nig) % gsz); u.pn = (wgid % nig) / gsz; return true;
    }
    __device__ __forceinline__ void a_ready(const Unit&) const {}
    __device__ __forceinline__ void done(const Unit&) const {}
};
__device__ __forceinline__ unsigned cvt_pk_bf16(float lo, float hi) { unsigned r; asm volatile("v_cvt_pk_bf16_f32 %0, %1, %2" : "=v"(r) : "v"(lo), "v"(hi)); return r; }
template <class Epi, class Sched, bool STAMP = false>
__device__ __forceinline__ void gemm_phase(PG8_LAS unsigned char* lds, const Gemm g, const Sched& S, const Epi& E, unsigned long long* stamps) {
    const int tid = threadIdx.x, wid = __builtin_amdgcn_readfirstlane(tid >> 6), lane = tid & 63, wr = wid >> 2, wc = wid & 3, fr = lane & 15, fq = lane >> 4;
    const int K = g.K, nt = K / BK;
    int ts_lo = 0, ts_hi = 0, nts = 0; const unsigned long long rt_entry = STAMP ? (unsigned long long)wall_clock64() : 0ull;
#define PG8_STAMP() do { if (STAMP && wid == 0 && nts < 64) { const unsigned long long _c = (unsigned long long)clock64(); \
        ts_lo = (lane == nts) ? (int)(unsigned)_c : ts_lo; ts_hi = (lane == nts) ? (int)(unsigned)(_c >> 32) : ts_hi; ++nts; } } while (0)
    PG8_STAMP();
    unsigned voffA[2], voffB[2];
#pragma unroll
    for (int i = 0; i < 2; ++i) { int R, C; stage_rc(tid * 16 + i * 8192, R, C); const int Rb = Epi::PERM ? ((R & ~31) + perm32(R & 31)) : R;
        voffA[i] = g.ablk ? (unsigned)(R * BK + C) * 2u : (unsigned)(R * K + C) * 2u; voffB[i] = (unsigned)(Rb * K + C) * 2u; }
    const size_t kstep = (size_t)(BK * 2);
    const size_t kstepA = g.ablk ? (size_t)HTB : kstep;
    const size_t hstep = (size_t)HALF * K * 2;
    const size_t tstep = 2 * hstep;
    const unsigned ldsw = (unsigned)wid * 1024u;
    const int aoff = lds_byte(wr * 64 + fr, fq * 8), boff = lds_byte(wc * 32 + fr, fq * 8);
#define PG8_SA(b, h) (((b) * 2 + (h)) * HTB)
#define PG8_SB(b, h) ((4 + (b) * 2 + (h)) * HTB)
#define PG8_STAGE(bufoff, gbase, voff) do { _Pragma("unroll") for (int _i = 0; _i < 2; ++_i) \
        __builtin_amdgcn_global_load_lds((const unsigned*)((const char*)(gbase) + (voff)[_i]), (PG8_LAS unsigned*)(lds + (bufoff) + ldsw + _i * 8192), 16, 0, 0); } while (0)
#define PG8_LDA(dst, b, h) do { _Pragma("unroll") for (int m = 0; m < 4; ++m) _Pragma("unroll") for (int k = 0; k < 2; ++k) dst[m][k] = *(const PG8_LAS bf16x8*)(lds + PG8_SA(b, h) + aoff + m * 2048 + k * 1024); } while (0)
#define PG8_LDB(dst, b, h) do { _Pragma("unroll") for (int n = 0; n < 2; ++n) _Pragma("unroll") for (int k = 0; k < 2; ++k) dst[n][k] = *(const PG8_LAS bf16x8*)(lds + PG8_SB(b, h) + boff + n * 2048 + k * 1024); } while (0)
#define PG8_MMA(ai, bj, At, Bt) do { __builtin_amdgcn_s_setprio(1); _Pragma("unroll") for (int m = 0; m < 4; ++m) _Pragma("unroll") for (int n = 0; n < 2; ++n) _Pragma("unroll") for (int k = 0; k < 2; ++k) \
        acc[ai][bj][m][n] = __builtin_amdgcn_mfma_f32_16x16x32_bf16(Bt[n][k], At[m][k], acc[ai][bj][m][n], 0, 0, 0); __builtin_amdgcn_s_setprio(0); } while (0)
#define PG8_WAIT_V(n) asm volatile("s_waitcnt vmcnt(" #n ")" ::: "memory")
#define PG8_WAIT_L(n) asm volatile("s_waitcnt lgkmcnt(" #n ")" ::: "memory")
#define PG8_BAR __builtin_amdgcn_s_barrier()
#define PG8_SCHED __builtin_amdgcn_sched_barrier(0)
    Unit cur, nxt; int ui = 0;
    if (!S.next(0, cur)) return;
    f32x4 acc[2][2][4][2];
#pragma unroll
    for (int a = 0; a < 2; ++a)
#pragma unroll
        for (int b = 0; b < 2; ++b)
#pragma unroll
            for (int m = 0; m < 4; ++m)
#pragma unroll
                for (int n = 0; n < 2; ++n) acc[a][b][m][n] = (f32x4){0.f, 0.f, 0.f, 0.f};
    bf16x8 At[4][2], B0[2][2], B1[2][2];
    const char* cA = (const char*)g.A + (size_t)cur.pm * tstep; const char* cB = (const char*)g.Bt + (size_t)cur.pn * tstep;
    S.a_ready(cur);
    PG8_STAGE(PG8_SB(0, 0), cB, voffB); PG8_STAGE(PG8_SA(0, 0), cA, voffA); PG8_STAGE(PG8_SB(0, 1), cB + hstep, voffB); PG8_STAGE(PG8_SA(0, 1), cA + hstep, voffA);
    if (wr == 1) PG8_BAR;
    PG8_WAIT_V(4); PG8_BAR;
    PG8_STAGE(PG8_SB(1, 0), cB + kstep, voffB); PG8_STAGE(PG8_SA(1, 0), cA + kstepA, voffA); PG8_STAGE(PG8_SB(1, 1), cB + hstep + kstep, voffB);
    PG8_WAIT_V(6); PG8_BAR;
    PG8_STAMP();
    for (;;) {
        const bool has_next = S.next(ui + 1, nxt);
        const char* nA = has_next ? (const char*)g.A + (size_t)nxt.pm * tstep : cA; const char* nB = has_next ? (const char*)g.Bt + (size_t)nxt.pn * tstep : cB;
        for (int t = 0; t < nt; t += 2) {
            const bool last = (t == nt - 2);
            const char* a1 = cA + (size_t)(t + 1) * kstepA;
            const char* a2 = last ? nA : cA + (size_t)(t + 2) * kstepA; const char* b2 = last ? nB : cB + (size_t)(t + 2) * kstep;
            const char* a3 = a2 + kstepA; const char* b3 = b2 + kstep;
            if (last && has_next) S.a_ready(nxt);
            PG8_LDB(B0, 0, 0); PG8_SCHED; PG8_LDA(At, 0, 0); PG8_STAGE(PG8_SA(1, 1), a1 + hstep, voffA);
            PG8_WAIT_L(8); PG8_BAR; PG8_WAIT_L(0); PG8_MMA(0, 0, At, B0); PG8_BAR; PG8_SCHED;
            PG8_LDB(B1, 0, 1); PG8_STAGE(PG8_SB(0, 0), b2, voffB);
            PG8_BAR; PG8_WAIT_L(0); PG8_MMA(0, 1, At, B1); PG8_BAR;
            PG8_LDA(At, 0, 1); PG8_STAGE(PG8_SA(0, 0), a2, voffA);
            PG8_BAR; PG8_WAIT_L(0); PG8_MMA(1, 0, At, B0); PG8_BAR; PG8_SCHED;
            PG8_STAGE(PG8_SB(0, 1), b2 + hstep, voffB);
            PG8_WAIT_V(6); PG8_BAR; PG8_MMA(1, 1, At, B1); PG8_BAR;
            PG8_LDB(B0, 1, 0); PG8_SCHED; PG8_LDA(At, 1, 0); PG8_STAGE(PG8_SA(0, 1), a2 + hstep, voffA);
            PG8_WAIT_L(8); PG8_BAR; PG8_WAIT_L(0); PG8_MMA(0, 0, At, B0); PG8_BAR; PG8_SCHED;
            PG8_LDB(B1, 1, 1); PG8_STAGE(PG8_SB(1, 0), b3, voffB);
            PG8_BAR; PG8_WAIT_L(0); PG8_MMA(0, 1, At, B1); PG8_BAR;
            PG8_LDA(At, 1, 1); PG8_STAGE(PG8_SA(1, 0), a3, voffA);
            PG8_BAR; PG8_WAIT_L(0); PG8_MMA(1, 0, At, B0); PG8_BAR; PG8_SCHED;
            PG8_STAGE(PG8_SB(1, 1), b3 + hstep, voffB);
            PG8_WAIT_V(6); PG8_BAR; PG8_MMA(1, 1, At, B1); PG8_BAR;
        }
        PG8_STAMP();
        if constexpr (!Epi::AFTER_DRAIN) { E(acc, cur, wr, wc, fr, fq); S.done(cur); }
        PG8_STAMP();
        if (!has_next) break;
#pragma unroll
        for (int a = 0; a < 2; ++a)
#pragma unroll
            for (int b = 0; b < 2; ++b)
#pragma unroll
                for (int m = 0; m < 4; ++m)
#pragma unroll
                    for (int n = 0; n < 2; ++n) acc[a][b][m][n] = (f32x4){0.f, 0.f, 0.f, 0.f};
        cur = nxt; cA = nA; cB = nB; ++ui;
    }
    PG8_WAIT_V(0);
    if (wr == 0) PG8_BAR;
    PG8_BAR;
    if constexpr (Epi::AFTER_DRAIN) { E.fused(acc, cur, wr, wc, fr, fq, lds, wid, lane); S.done(cur); }
    PG8_STAMP();
    if (STAMP && wid == 0) { stamps[lane] = lane < nts ? (((unsigned long long)(unsigned)ts_hi << 32) | (unsigned)ts_lo) : 0ull;
        if (lane == 62) stamps[62] = rt_entry; if (lane == 63) stamps[63] = (unsigned long long)wall_clock64(); }
#undef PG8_STAMP
#undef PG8_SA
#undef PG8_SB
#undef PG8_STAGE
#undef PG8_LDA
#undef PG8_LDB
#undef PG8_MMA
#undef PG8_WAIT_V
#undef PG8_WAIT_L
#undef PG8_BAR
#undef PG8_SCHED
}
}

using pg8::bf16_t; using pg8::f32x4; using pg8::u32x4; using pg8::Unit; using pg8::cvt_pk_bf16;
#define LAS __attribute__((address_space(3)))

constexpr int D = 2048, NB = 8, TL = 2048, TC = 256, MLAT = NB * TL  , MCTX = NB * TC  , MALL = MLAT + MCTX  ;
constexpr int N1 = 6656, N2 = 5120, LD1 = N1, LD2 = N2, FFH = 5632, NADA = 6 * D;
constexpr int COL_CV = 3520, COL_AB = 6592;
constexpr int LDS_BYTES = 147456;
constexpr size_t MiB = 1048576;
constexpr size_t WS_A = 0;
constexpr size_t WS_B = WS_A + 46 * MiB;
constexpr size_t WS_X = WS_B + 16 * MiB;
constexpr size_t WS_D = WS_X + 234 * MiB;
constexpr size_t WS_F = WS_D + 160 * MiB;
constexpr size_t WS_M = WS_F + 32 * MiB;
constexpr size_t WS_END = WS_M + 3 * MiB;

struct Params { const float* in[30]; float* out; unsigned char* ws; int ph_lo, ph_hi, coop, pad; };

__device__ __forceinline__ float bf2f(bf16_t b) { return __uint_as_float(((unsigned)b) << 16); }
typedef __bf16 bf16x2_t __attribute__((ext_vector_type(2)));
typedef float f32x2_t __attribute__((ext_vector_type(2)));
__device__ __forceinline__ unsigned pk2(float lo, float hi) { const f32x2_t v = {lo, hi}; return __builtin_bit_cast(unsigned, __builtin_convertvector(v, bf16x2_t)); }
__device__ __forceinline__ bf16_t f2bf(float f) { return (bf16_t)(pk2(f, 0.f) & 0xffffu); }
__device__ __forceinline__ float sigm(float x) { return __builtin_amdgcn_rcpf(1.f + __expf(-x)); }
__device__ __forceinline__ float tanh_fast(float x) { return 1.f - 2.f * __builtin_amdgcn_rcpf(1.f + __expf(2.f * x)); }
__device__ __forceinline__ float wave_sum(float v) {
#pragma unroll
    for (int o = 1; o < 64; o <<= 1) v += __shfl_xor(v, o);
    return v;
}
template <int CTRL> __device__ __forceinline__ float dppf(float x) { return __int_as_float(__builtin_amdgcn_update_dpp(0, __float_as_int(x), CTRL, 0xF, 0xF, true)); }
__device__ __forceinline__ float red8(float x) { x += dppf<0x141>(x); x += dppf<0xB1>(x); x += dppf<0x4E>(x); return x; }

struct EpiBf16Plain {
    static constexpr bool PERM = true, AFTER_DRAIN = false;
    bf16_t* O; int ldc;
    __device__ __forceinline__ void operator()(const f32x4 (&acc)[2][2][4][2], const Unit& u, int wr, int wc, int fr, int fq) const {
        const int row0 = u.pm * 256 + wr * 64 + fr, col0 = u.pn * 256 + wc * 32 + 8 * fq;
#pragma unroll
        for (int ai = 0; ai < 2; ++ai)
#pragma unroll
            for (int m = 0; m < 4; ++m) { bf16_t* rowp = O + (size_t)(row0 + ai * 128 + m * 16) * ldc + col0;
#pragma unroll
                for (int bj = 0; bj < 2; ++bj) { const f32x4 v0 = acc[ai][bj][m][0], v1 = acc[ai][bj][m][1];
                    u32x4 w; w.x = pk2(v0[0], v0[1]); w.y = pk2(v0[2], v0[3]); w.z = pk2(v1[0], v1[1]); w.w = pk2(v1[2], v1[3]);
                    *(u32x4*)(rowp + bj * 128) = w; } }
    }
};
template <bool SECOND> struct EpiGate {
    static constexpr bool PERM = true, AFTER_DRAIN = false;
    bf16_t* Mo; const bf16_t* G;
    __device__ __forceinline__ void operator()(const f32x4 (&acc)[2][2][4][2], const Unit& u, int wr, int wc, int fr, int fq) const {
        const int row0 = u.pm * 256 + wr * 64 + fr, col0 = u.pn * 256 + wc * 32 + 8 * fq;
#pragma unroll
        for (int ai = 0; ai < 2; ++ai)
#pragma unroll
            for (int m = 0; m < 4; ++m) { const size_t row = (size_t)(row0 + ai * 128 + m * 16);
#pragma unroll
                for (int bj = 0; bj < 2; ++bj) { const f32x4 v0 = acc[ai][bj][m][0], v1 = acc[ai][bj][m][1];
                    const int col = col0 + bj * 128;
                    const u32x4 g = *(const u32x4*)(G + row * LD2 + col);
                    float r[8];
                    r[0] = sigm(__uint_as_float(g.x << 16)) * v0[0]; r[1] = sigm(__uint_as_float(g.x & 0xffff0000u)) * v0[1];
                    r[2] = sigm(__uint_as_float(g.y << 16)) * v0[2]; r[3] = sigm(__uint_as_float(g.y & 0xffff0000u)) * v0[3];
                    r[4] = sigm(__uint_as_float(g.z << 16)) * v1[0]; r[5] = sigm(__uint_as_float(g.z & 0xffff0000u)) * v1[1];
                    r[6] = sigm(__uint_as_float(g.w << 16)) * v1[2]; r[7] = sigm(__uint_as_float(g.w & 0xffff0000u)) * v1[3];
                    u32x4* op = (u32x4*)(Mo + row * D + col);
                    if (SECOND) { const u32x4 o = *op;
                        r[0] += __uint_as_float(o.x << 16); r[1] += __uint_as_float(o.x & 0xffff0000u); r[2] += __uint_as_float(o.y << 16); r[3] += __uint_as_float(o.y & 0xffff0000u);
                        r[4] += __uint_as_float(o.z << 16); r[5] += __uint_as_float(o.z & 0xffff0000u); r[6] += __uint_as_float(o.w << 16); r[7] += __uint_as_float(o.w & 0xffff0000u); }
                    u32x4 w; w.x = pk2(r[0], r[1]); w.y = pk2(r[2], r[3]); w.z = pk2(r[4], r[5]); w.w = pk2(r[6], r[7]);
                    *op = w; } }
    }
};
struct EpiRes {
    static constexpr bool PERM = false, AFTER_DRAIN = false;
    float* out; const float* res; const float* gt;
    __device__ __forceinline__ void operator()(const f32x4 (&acc)[2][2][4][2], const Unit& u, int wr, int wc, int fr, int fq) const {
        const int row0 = u.pm * 256 + wr * 64 + fr, col0 = u.pn * 256 + wc * 32 + 4 * fq;
        const float* gtb = gt + (size_t)((u.pm * 256) >> 11) * NADA + col0;
        f32x4 gv[2][2];
#pragma unroll
        for (int bj = 0; bj < 2; ++bj)
#pragma unroll
            for (int n = 0; n < 2; ++n) gv[bj][n] = *(const f32x4*)(gtb + bj * 128 + n * 16);
#pragma unroll
        for (int ai = 0; ai < 2; ++ai)
#pragma unroll
            for (int m = 0; m < 4; ++m) { const size_t ro = (size_t)(row0 + ai * 128 + m * 16) * D + col0;
#pragma unroll
                for (int bj = 0; bj < 2; ++bj)
#pragma unroll
                    for (int n = 0; n < 2; ++n) { const f32x4 rv = *(const f32x4*)(res + ro + bj * 128 + n * 16);
                        *(f32x4*)(out + ro + bj * 128 + n * 16) = rv + gv[bj][n] * acc[ai][bj][m][n]; } }
    }
};
struct EpiSwiglu {
    static constexpr bool PERM = true, AFTER_DRAIN = false;
    bf16_t* O;
    __device__ __forceinline__ void operator()(const f32x4 (&acc)[2][2][4][2], const Unit& u, int wr, int wc, int fr, int fq) const {
        const int row0 = u.pm * 256 + wr * 64 + fr, col0 = u.pn * 128 + wc * 32 + 8 * fq;
#pragma unroll
        for (int ai = 0; ai < 2; ++ai)
#pragma unroll
            for (int m = 0; m < 4; ++m) { bf16_t* rowp = O + ((size_t)(u.pm * 2 + ai) * (FFH / 64) + 2 * u.pn + (wc >> 1)) * 8192 + (wr * 64 + m * 16 + fr) * 64 + 32 * (wc & 1) + 8 * fq;
                float r[8];
#pragma unroll
                for (int n = 0; n < 2; ++n)
#pragma unroll
                    for (int e = 0; e < 4; ++e) { const float g = acc[ai][0][m][n][e], up = acc[ai][1][m][n][e]; r[4 * n + e] = g * sigm(g) * up; }
                u32x4 w; w.x = pk2(r[0], r[1]); w.y = pk2(r[2], r[3]); w.z = pk2(r[4], r[5]); w.w = pk2(r[6], r[7]);
                *(u32x4*)rowp = w; }
    }
};

template <class Epi> __device__ __forceinline__ void run_gemm(unsigned char* smem, const bf16_t* A, const bf16_t* Bt, int M, int N, int K, const Epi& E, int ablk = 0) {
    pg8::Gemm g; g.A = A; g.Bt = Bt; g.M = M; g.N = N; g.K = K; g.ablk = ablk;
    pg8::StaticOrder S; S.init(M, N, (int)gridDim.x, (int)blockIdx.x);
    pg8::gemm_phase<Epi, pg8::StaticOrder, false>((PG8_LAS unsigned char*)smem, g, S, E, nullptr);
    __syncthreads();
}

__device__ __forceinline__ void transpose_item(const float* W, int K, int N, bf16_t* WT, int dst_row0, int src_col0, float* scr, int k0, int lane) {
    if (src_col0 >= 0) {
#pragma unroll 8
        for (int i = 0; i < 32; ++i) { const int kk = 2 * i + (lane >> 5); scr[kk * 33 + (lane & 31)] = W[(size_t)(k0 + kk) * N + src_col0 + (lane & 31)]; }
    } else {
#pragma unroll 8
        for (int i = 0; i < 32; ++i) { const int kk = 2 * i + (lane >> 5); scr[kk * 33 + (lane & 31)] = 0.f; }
    }
    asm volatile("s_waitcnt lgkmcnt(0)" ::: "memory");
    const int c = lane & 7;
#pragma unroll
    for (int j = 0; j < 4; ++j) { const int n = (lane >> 3) + 8 * j; const float* s = scr + (8 * c) * 33 + n;
        u32x4 o; o.x = pk2(s[0], s[33]); o.y = pk2(s[2 * 33], s[3 * 33]); o.z = pk2(s[4 * 33], s[5 * 33]); o.w = pk2(s[6 * 33], s[7 * 33]);
        *(u32x4*)(WT + (size_t)(dst_row0 + n) * K + k0 + 8 * c) = o; }
    asm volatile("s_waitcnt lgkmcnt(0)" ::: "memory");
}
__device__ __forceinline__ int win_src_col(int n0) {
    if (n0 < 6592) return n0;
    if (n0 < 6624) return 7616 + (n0 - 6592);
    if (n0 < 6656) return -1;
    const int j = n0 - 6656;
    return j < 1024 ? 6592 + j : 7648 + (j - 1024);
}

__device__ __forceinline__ void phase_prep(const Params& P, unsigned char* smem) {
    const int tid = threadIdx.x, lane = tid & 63, wave = tid >> 6;
    float* MOD = (float*)(P.ws + WS_M);
    if ((int)blockIdx.x < 192) {
        float* sT = (float*)smem;
        float* red = (float*)(smem + 98304);
        const float* c = P.in[1]; const float* cc = P.in[3];
        for (int idx = tid; idx < 9 * D; idx += 512) { const int m = idx >> 11, k = idx & 2047; const float v = m < 8 ? c[m * D + k] : cc[k]; sT[k * 12 + m] = v * sigm(v); }
        __syncthreads();
        const float* W = P.in[4]; const float* bias = P.in[5];
        for (int item = blockIdx.x; item < 192; item += gridDim.x) {
            const int n0 = item * 64, cl = tid & 15, kl = tid >> 4;
            float acc[9][4];
#pragma unroll
            for (int m = 0; m < 9; ++m)
#pragma unroll
                for (int e = 0; e < 4; ++e) acc[m][e] = 0.f;
#pragma unroll 4
            for (int kk = 0; kk < 64; ++kk) { const int k = kk * 32 + kl;
                const f32x4 w = *(const f32x4*)(W + (size_t)k * NADA + n0 + 4 * cl);
                const f32x4 s0 = *(const f32x4*)(sT + k * 12), s1 = *(const f32x4*)(sT + k * 12 + 4); const float s2 = sT[k * 12 + 8];
#pragma unroll
                for (int e = 0; e < 4; ++e) { acc[0][e] += s0[0] * w[e]; acc[1][e] += s0[1] * w[e]; acc[2][e] += s0[2] * w[e]; acc[3][e] += s0[3] * w[e];
                    acc[4][e] += s1[0] * w[e]; acc[5][e] += s1[1] * w[e]; acc[6][e] += s1[2] * w[e]; acc[7][e] += s1[3] * w[e]; acc[8][e] += s2 * w[e]; } }
#pragma unroll
            for (int m = 0; m < 9; ++m)
#pragma unroll
                for (int e = 0; e < 4; ++e) { float v = acc[m][e]; v += __shfl_xor(v, 16); v += __shfl_xor(v, 32); if ((lane >> 4) == 0) red[(wave * 9 + m) * 64 + 4 * cl + e] = v; }
            __syncthreads();
            for (int o = tid; o < 576; o += 512) { const int m = o >> 6, c2 = o & 63; float s = bias[n0 + c2];
#pragma unroll
                for (int w8 = 0; w8 < 8; ++w8) s += red[(w8 * 9 + m) * 64 + c2];
                MOD[m * NADA + n0 + c2] = s; }
            __syncthreads();
        }
    }
    __syncthreads();
    { bf16_t* G2T = (bf16_t*)(P.ws + WS_M + MiB / 2); const float* g2 = P.in[13];
      for (int s = blockIdx.x * 512 + tid; s < 1024 * 32; s += gridDim.x * 512) { const int n = s >> 5, k8 = s & 31; u32x4 w = {0u, 0u, 0u, 0u};
          if (k8 < 8) { const float* gp = g2 + (size_t)(8 * k8) * 1024 + n; w.x = pk2(gp[0], gp[1024]); w.y = pk2(gp[2048], gp[3072]); w.z = pk2(gp[4096], gp[5120]); w.w = pk2(gp[6144], gp[7168]); }
          *(u32x4*)(G2T + (size_t)n * 256 + 8 * k8) = w; } }
    float* scr = (float*)(smem + wave * 8448);
    const int gw = blockIdx.x * 8 + wave, NGW = gridDim.x * 8;
    bf16_t* WT_IN = (bf16_t*)(P.ws + WS_A); bf16_t* WT_PA = (bf16_t*)(P.ws + WS_B); bf16_t* WT_PB = WT_PA + 2048 * 1024; bf16_t* WT_OUT = WT_PB + 2048 * 1024;
    constexpr int I_IN = 368 * 32, I_PA = 64 * 16, I_OUT = 64 * 32;
    for (int it = gw; it < I_IN + 2 * I_PA + I_OUT; it += NGW) {
        int r = it;
        if (r < I_IN) { const int nb = r % 368, kb = r / 368; transpose_item(P.in[7], 2048, 11744, WT_IN, nb * 32, win_src_col(nb * 32), scr, kb * 64, lane); continue; } r -= I_IN;
        if (r < I_PA) { const int nb = r % 64, kb = r / 64; transpose_item(P.in[23], 1024, 2048, WT_PA, nb * 32, nb * 32, scr, kb * 64, lane); continue; } r -= I_PA;
        if (r < I_PA) { const int nb = r % 64, kb = r / 64; transpose_item(P.in[24], 1024, 2048, WT_PB, nb * 32, nb * 32, scr, kb * 64, lane); continue; } r -= I_PA;
        { const int nb = r % 64, kb = r / 64; transpose_item(P.in[25], 2048, 2048, WT_OUT, nb * 32, nb * 32, scr, kb * 64, lane); }
    }
}
__device__ __forceinline__ void phase_ffn_weights(const Params& P, unsigned char* smem) {
    const int tid = threadIdx.x, lane = tid & 63, wave = tid >> 6;
    float* scr = (float*)(smem + wave * 8448);
    const int gw = blockIdx.x * 8 + wave, NGW = gridDim.x * 8;
    bf16_t* WT_GU = (bf16_t*)(P.ws + WS_A); bf16_t* WT_DN = (bf16_t*)(P.ws + WS_F);
    constexpr int I_GU = 352 * 32, I_DN = 64 * 88;
    for (int it = gw; it < I_GU + I_DN; it += NGW) {
        int r = it;
        if (r < I_GU) { const int nb = r % 352, kb = r / 352; const int n0 = nb * 32, pn = n0 >> 8, cq = n0 & 255; const int src = cq < 128 ? 128 * pn + cq : FFH + 128 * pn + (cq - 128);
            transpose_item(P.in[27], 2048, 2 * FFH, WT_GU, n0, src, scr, kb * 64, lane); continue; } r -= I_GU;
        { const int nb = r % 64, kb = r / 64; transpose_item(P.in[28], FFH, 2048, WT_DN, nb * 32, nb * 32, scr, kb * 64, lane); }
    }
}

__device__ __forceinline__ void norm_mod_row(const float* src, const float* nw, const float* sh, const float* sc, bf16_t* dst, int lane) {
    f32x4 v[8]; float ss = 0.f;
#pragma unroll
    for (int j = 0; j < 8; ++j) { v[j] = *(const f32x4*)(src + (j * 64 + lane) * 4); ss += v[j][0] * v[j][0] + v[j][1] * v[j][1] + v[j][2] * v[j][2] + v[j][3] * v[j][3]; }
    const float rstd = rsqrtf(wave_sum(ss) * (1.f / D) + 1e-6f);
#pragma unroll
    for (int j = 0; j < 8; ++j) { const int c = (j * 64 + lane) * 4; const f32x4 w = *(const f32x4*)(nw + c), a = *(const f32x4*)(sh + c), b = *(const f32x4*)(sc + c);
        float o[4];
#pragma unroll
        for (int e = 0; e < 4; ++e) o[e] = (v[j][e] * rstd * w[e]) * (1.f + b[e]) + a[e];
        uint2 pk; pk.x = pk2(o[0], o[1]); pk.y = pk2(o[2], o[3]); *(uint2*)(dst + c) = pk; }
}
__device__ __forceinline__ void phase_norm1(const Params& P) {
    const int lane = threadIdx.x & 63, gw = blockIdx.x * 8 + (threadIdx.x >> 6), NGW = gridDim.x * 8;
    const float* MOD = (const float*)(P.ws + WS_M); bf16_t* H = (bf16_t*)P.out;
    for (int row = gw; row < MALL; row += NGW) {
        const float* src = row < MLAT ? P.in[0] + (size_t)row * D : P.in[2] + (size_t)(row - MLAT) * D;
        const int mr = row < MLAT ? (row >> 11) : 8;
        norm_mod_row(src, P.in[6], MOD + mr * NADA, MOD + mr * NADA + D, H + (size_t)row * D, lane);
    }
}
__device__ __forceinline__ void phase_norm2(const Params& P) {
    const int lane = threadIdx.x & 63, gw = blockIdx.x * 8 + (threadIdx.x >> 6), NGW = gridDim.x * 8;
    const float* MOD = (const float*)(P.ws + WS_M); bf16_t* H2 = (bf16_t*)(P.ws + WS_D);
    for (int row = gw; row < MLAT; row += NGW) { const int mr = row >> 11;
        norm_mod_row(P.out + (size_t)row * D, P.in[26], MOD + mr * NADA + 3 * D, MOD + mr * NADA + 4 * D, H2 + (size_t)row * D, lane); }
}
__device__ __forceinline__ void phase_final_norm(const Params& P) {
    const int lane = threadIdx.x & 63, gw = blockIdx.x * 8 + (threadIdx.x >> 6), NGW = gridDim.x * 8;
    const float* nw = P.in[29];
    for (int row = gw; row < MLAT; row += NGW) { float* src = P.out + (size_t)row * D;
        f32x4 v[8]; float ss = 0.f;
#pragma unroll
        for (int j = 0; j < 8; ++j) { v[j] = *(const f32x4*)(src + (j * 64 + lane) * 4); ss += v[j][0] * v[j][0] + v[j][1] * v[j][1] + v[j][2] * v[j][2] + v[j][3] * v[j][3]; }
        const float rstd = rsqrtf(wave_sum(ss) * (1.f / D) + 1e-6f);
#pragma unroll
        for (int j = 0; j < 8; ++j) { const int c = (j * 64 + lane) * 4; const f32x4 w = *(const f32x4*)(nw + c); *(f32x4*)(src + c) = v[j] * rstd * w; }
    }
}

__device__ __forceinline__ float mixed_load(const bf16_t* P1, int row, int t, bool isctx, int col, const float* mu) {
    const float p = bf2f(P1[(size_t)row * LD1 + col]);
    int nrow; bool valid;
    if (isctx) { if (col & 1) { valid = t < TC - 1; nrow = row + 1; } else { valid = t > 0; nrow = row - 1; } }
    else { const int m = col & 3, x = t & 63, y = t >> 6;
        if (m == 0) { valid = x > 0; nrow = row - 1; } else if (m == 1) { valid = x < 63; nrow = row + 1; }
        else if (m == 2) { valid = y > 0; nrow = row - 64; } else { valid = y < 31; nrow = row + 64; } }
    const float ps = valid ? bf2f(P1[(size_t)nrow * LD1 + col]) : 0.f;
    return p + (ps - p) * mu[col];
}


__device__ __forceinline__ void tri_inv_part1(const float* LM, bf16_t* TM, bf16_t* T11T, int blk, int lane) {
    constexpr int LDLc = 36, LDCc = 40;
    { const int c = lane & 15, o = 16 * blk; float t[16];
        const float* Lb = LM + o * LDLc + o;
#pragma unroll
        for (int i = 0; i < 16; ++i) { float a4[4] = {(i == c) ? 1.f : 0.f, 0.f, 0.f, 0.f};
#pragma unroll
            for (int j4 = 0; j4 < (i + 3) / 4; ++j4) { const f32x4 l = *(const f32x4*)(Lb + i * LDLc + 4 * j4);
#pragma unroll
                for (int x = 0; x < 4; ++x) if (4 * j4 + x < i) a4[x] -= l[x] * t[4 * j4 + x]; }
            t[i] = (a4[0] + a4[1]) + (a4[2] + a4[3]); }
        if (lane < 16) {
#pragma unroll
            for (int i = 0; i < 16; ++i) TM[(o + i) * LDCc + o + c] = f2bf(t[i]);
            if (blk == 0) { u32x4 w0, w1;
#pragma unroll
                for (int e = 0; e < 4; ++e) { w0[e] = pk2(t[2 * e], t[2 * e + 1]); w1[e] = pk2(t[8 + 2 * e], t[8 + 2 * e + 1]); }
                *(u32x4*)(T11T + c * 16) = w0; *(u32x4*)(T11T + c * 16 + 8) = w1; } }
        else if (lane < 32 && blk == 0) { const u32x4 zz = {0u, 0u, 0u, 0u}; *(u32x4*)(TM + c * LDCc + 16) = zz; *(u32x4*)(TM + c * LDCc + 24) = zz; } }
}
__device__ __forceinline__ void tri_inv_part2(const float* LM, bf16_t* TM, const bf16_t* T11T, bf16_t* XT, int lane) {
    constexpr int LDLc = 36, LDCc = 40;
    typedef short s16x8_ __attribute__((ext_vector_type(8)));
    const int fr = lane & 15, fq = lane >> 4;
    s16x8_ a = {0, 0, 0, 0, 0, 0, 0, 0}, b = {0, 0, 0, 0, 0, 0, 0, 0};
    if (fq < 2) { const f32x4 l0 = *(const f32x4*)(LM + (16 + fr) * LDLc + 8 * fq), l1 = *(const f32x4*)(LM + (16 + fr) * LDLc + 8 * fq + 4);
        u32x4 w; w.x = pk2(l0[0], l0[1]); w.y = pk2(l0[2], l0[3]); w.z = pk2(l1[0], l1[1]); w.w = pk2(l1[2], l1[3]);
        a = __builtin_bit_cast(s16x8_, w); b = *(const s16x8_*)(T11T + fr * 16 + 8 * fq); }
    const f32x4 X = __builtin_amdgcn_mfma_f32_16x16x32_bf16(a, b, ((f32x4){0.f, 0.f, 0.f, 0.f}), 0, 0, 0);
    { uint2 o; o.x = pk2(X[0], X[1]); o.y = pk2(X[2], X[3]); *(uint2*)(XT + fr * 16 + fq * 4) = o; }
    asm volatile("s_waitcnt lgkmcnt(0)" ::: "memory");
    s16x8_ a2 = {0, 0, 0, 0, 0, 0, 0, 0}, b2 = {0, 0, 0, 0, 0, 0, 0, 0};
    if (fq < 2) { a2 = *(const s16x8_*)(XT + fr * 16 + 8 * fq); b2 = *(const s16x8_*)(TM + (16 + fr) * LDCc + 16 + 8 * fq); }
    const f32x4 O = __builtin_amdgcn_mfma_f32_16x16x32_bf16(a2, b2, ((f32x4){0.f, 0.f, 0.f, 0.f}), 0, 0, 0);
    { uint2 o; o.x = pk2(-O[0], -O[1]); o.y = pk2(-O[2], -O[3]); *(uint2*)(TM + (16 + fr) * LDCc + fq * 4) = o; }
}
constexpr int CH = 32, NCHUNK = (TC + TL) / CH;
typedef short s16x8 __attribute__((ext_vector_type(8)));
__device__ __forceinline__ float red16(float x) { x += dppf<0x140>(x); x += dppf<0x141>(x); x += dppf<0xB1>(x); x += dppf<0x4E>(x); return x; }
#define TROW(r) ((r) * LDC + ((r) >> 3) * 8)
#define MFMA16(a, b, c) __builtin_amdgcn_mfma_f32_16x16x32_bf16((a), (b), (c), 0, 0, 0)

constexpr int L_WR = 0, L_KD = 8192, L_V = 16384, L_W = 24576, L_BB = 32768, L_KK = 40960, L_THW = 49152  , L_THA = 55296, L_SC = 61440  , L_PRM = 61952  ;
__device__ __forceinline__ void phase_rwkv(const Params& P, unsigned char* smem) {
    const int tid = threadIdx.x;
    const bf16_t* P1 = (const bf16_t*)(P.ws + WS_X);
    bf16_t* YD = (bf16_t*)P.out;
    float* SBON = (float*)(P.ws + WS_M + MiB);
    float* A_wr = (float*)(smem + L_WR); float* A_kd = (float*)(smem + L_KD); float* A_v = (float*)(smem + L_V); float* A_w = (float*)(smem + L_W);
    float* A_bb = (float*)(smem + L_BB); float* A_kk = (float*)(smem + L_KK); bf16_t* TH_w = (bf16_t*)(smem + L_THW); bf16_t* TH_a = (bf16_t*)(smem + L_THA); float* SC = (float*)(smem + L_SC);
    float* PRM = (float*)(smem + L_PRM);
    const float* mu = P.in[8];
    for (int it = blockIdx.x; it < 256; it += gridDim.x) {
        const int b = it >> 5, h = (it >> 1) & 15, d = it & 1;
        float S[8];
#pragma unroll
        for (int j = 0; j < 8; ++j) S[j] = 0.f;
        s16x8 Bw[3], Ba[3];
        __syncthreads();
        { const int lane = tid & 63, wave = tid >> 6; const int cB = h * 64 + 16 * (wave & 3) + (lane & 15);
#pragma unroll
          for (int ks = 0; ks < 3; ++ks)
#pragma unroll
            for (int j = 0; j < 8; ++j) { const int k = ks * 32 + (lane >> 4) * 8 + j;
                Bw[ks][j] = (short)f2bf(P.in[10][((size_t)d * 96 + k) * 1024 + cB]); Ba[ks][j] = (short)f2bf(P.in[12][((size_t)d * 96 + k) * 1024 + cB]); }
          if (tid < 64) { PRM[tid] = P.in[14][h * 64 + tid]; PRM[64 + tid] = P.in[15][h * 64 + tid]; PRM[128 + tid] = P.in[16][h * 64 + tid]; } }
        const float w0c = P.in[9][d * 1024 + h * 64 + 16 * ((tid >> 6) & 3) + (tid & 15)], a0c = P.in[11][d * 1024 + h * 64 + 16 * ((tid >> 6) & 3) + (tid & 15)];
        unsigned pre[3][12];
        auto prefetch = [&](int ch) {
            const bool isctx = ch < 8;
            const int sbase = isctx ? ch * CH : (ch - 8) * CH, Tlen = isctx ? TC : TL;
            const int rowbase = isctx ? MLAT + b * TC : b * TL;
            const int t0 = d == 0 ? sbase : Tlen - 1 - sbase, sgn = d == 0 ? 1 : -1;
            const u32x4 zz = {0u, 0u, 0u, 0u};
            int qv = tid; asm volatile("" : "+v"(qv));
#pragma unroll
            for (int n = 0; n < 3; ++n) { const int s = qv + 512 * n, i = s / 48, cv = s % 48; const int t = t0 + sgn * i;
                const int col = cv < 8 ? h * 64 + 8 * cv : (cv < 16 ? 1024 + h * 64 + 8 * (cv - 8) : (cv < 24 ? 2048 + h * 64 + 8 * (cv - 16) : (cv < 36 ? 3072 + d * 96 + 8 * (cv - 24) : 3264 + d * 96 + 8 * (cv - 36))));
                const bf16_t* pp = P1 + (size_t)(rowbase + t) * LD1 + col;
                { const u32x4 pv_ = *(const u32x4*)pp; pre[n][0] = pv_.x; pre[n][1] = pv_.y; pre[n][2] = pv_.z; pre[n][3] = pv_.w; }
                const unsigned* pw = (const unsigned*)pp; constexpr int LW = LD1 / 2;
                if (isctx) { const bool vl = t > 0, vr = t < TC - 1;
                    const u32x4 L = vl ? *(const u32x4*)(pp - LD1) : zz, R = vr ? *(const u32x4*)(pp + LD1) : zz;
                    pre[n][4] = L.x; pre[n][5] = L.y; pre[n][6] = L.z; pre[n][7] = L.w; pre[n][8] = R.x; pre[n][9] = R.y; pre[n][10] = R.z; pre[n][11] = R.w; }
                else { const int x = t & 63, y = t >> 6; const bool vl = x > 0, vr = x < 63, vu = y > 0, vd = y < 31;
                    pre[n][4] = vl ? pw[-LW + 0] : 0u; pre[n][5] = vl ? pw[-LW + 2] : 0u; pre[n][6] = vr ? pw[LW + 0] : 0u; pre[n][7] = vr ? pw[LW + 2] : 0u;
                    pre[n][8] = vu ? pw[-64 * LW + 1] : 0u; pre[n][9] = vu ? pw[-64 * LW + 3] : 0u; pre[n][10] = vd ? pw[64 * LW + 1] : 0u; pre[n][11] = vd ? pw[64 * LW + 3] : 0u; } }
        };
        prefetch(0);
        for (int ch = 0; ch < NCHUNK; ++ch) {
            int qo = tid; asm volatile("" : "+v"(qo));
            const int lane_o = qo & 63, wave_o = qo >> 6;
            const bool isctx = ch < 8;
            const int sbase = isctx ? ch * CH : (ch - 8) * CH, Tlen = isctx ? TC : TL;
            const int rowbase = isctx ? MLAT + b * TC : b * TL;
            const int t0 = d == 0 ? sbase : Tlen - 1 - sbase, sgn = d == 0 ? 1 : -1;
#pragma unroll
            for (int n = 0; n < 3; ++n) { const int s = qo + 512 * n, i = s / 48, cv = s % 48;
                const int col = cv < 8 ? h * 64 + 8 * cv : (cv < 16 ? 1024 + h * 64 + 8 * (cv - 8) : (cv < 24 ? 2048 + h * 64 + 8 * (cv - 16) : (cv < 36 ? 3072 + d * 96 + 8 * (cv - 24) : 3264 + d * 96 + 8 * (cv - 36))));
                const f32x4 m0 = *(const f32x4*)(mu + col), m1 = *(const f32x4*)(mu + col + 4);
                float xs[8];
#pragma unroll
                for (int e = 0; e < 8; ++e) { const float p = __uint_as_float((e & 1) ? (pre[n][e >> 1] & 0xffff0000u) : (pre[n][e >> 1] << 16));
                    unsigned wv_; const bool hi = (e & 1);
                    if (isctx) wv_ = (e & 1) ? pre[n][8 + (e >> 1)] : pre[n][4 + (e >> 1)];
                    else wv_ = pre[n][4 + 2 * (e & 3) + (e >> 2)];
                    const float ps = __uint_as_float(hi ? (wv_ & 0xffff0000u) : (wv_ << 16));
                    xs[e] = p + (ps - p) * (e < 4 ? m0[e & 3] : m1[e & 3]); }
                if (cv < 24) { float* dst = (cv < 8 ? A_wr + i * 64 + 8 * cv : (cv < 16 ? A_kd + i * 64 + 8 * (cv - 8) : A_v + i * 64 + 8 * (cv - 16)));
                    *(f32x4*)dst = (f32x4){xs[0], xs[1], xs[2], xs[3]}; *(f32x4*)(dst + 4) = (f32x4){xs[4], xs[5], xs[6], xs[7]}; }
                else if (cv < 36) { u32x4 w; w.x = pk2(tanhf(xs[0]), tanhf(xs[1])); w.y = pk2(tanhf(xs[2]), tanhf(xs[3])); w.z = pk2(tanhf(xs[4]), tanhf(xs[5])); w.w = pk2(tanhf(xs[6]), tanhf(xs[7]));
                    *(u32x4*)(TH_w + i * 96 + 8 * (cv - 24)) = w; }
                else { u32x4 w; w.x = pk2(xs[0], xs[1]); w.y = pk2(xs[2], xs[3]); w.z = pk2(xs[4], xs[5]); w.w = pk2(xs[6], xs[7]);
                    *(u32x4*)(TH_a + i * 96 + 8 * (cv - 36)) = w; } }
            __syncthreads();
            { const int rt = wave_o >> 2, c = 16 * (wave_o & 3) + (lane_o & 15);
              f32x4 cw = {0.f, 0.f, 0.f, 0.f}, ca = {0.f, 0.f, 0.f, 0.f};
#pragma unroll
              for (int ks = 0; ks < 3; ++ks) { const int off = (rt * 16 + (lane_o & 15)) * 96 + ks * 32 + (lane_o >> 4) * 8;
                  const s16x8 fa = *(const s16x8*)(TH_w + off), fb = *(const s16x8*)(TH_a + off);
                  cw = MFMA16(fa, Bw[ks], cw); ca = MFMA16(fb, Ba[ks], ca); }
#pragma unroll
              for (int j = 0; j < 4; ++j) { const int i = rt * 16 + (lane_o >> 4) * 4 + j;
                  A_w[i * 64 + c] = __expf(-0.6065306597126334f * sigm(w0c + cw[j])); A_bb[i * 64 + c] = sigm(a0c + ca[j]); } }
            __syncthreads();
            if (qo < 256) {
                const int i = qo >> 3, cgp = qo & 7, j0 = 8 * cgp; float xr[8], xk[8], w[8], ic[8], kkw[8], kaw[8], rkw[8];
#pragma unroll
                for (int e = 0; e < 2; ++e) { const f32x4 a = *(const f32x4*)(A_wr + i * 64 + j0 + 4 * e), b2 = *(const f32x4*)(A_kd + i * 64 + j0 + 4 * e), c2 = *(const f32x4*)(A_w + i * 64 + j0 + 4 * e),
                        d2 = *(const f32x4*)(A_bb + i * 64 + j0 + 4 * e), e2 = *(const f32x4*)(PRM + j0 + 4 * e), f2 = *(const f32x4*)(PRM + 64 + j0 + 4 * e), g2 = *(const f32x4*)(PRM + 128 + j0 + 4 * e);
#pragma unroll
                    for (int x = 0; x < 4; ++x) { xr[4 * e + x] = a[x]; xk[4 * e + x] = b2[x]; w[4 * e + x] = c2[x]; ic[4 * e + x] = d2[x]; kkw[4 * e + x] = e2[x]; kaw[4 * e + x] = f2[x]; rkw[4 * e + x] = g2[x]; } }
                float ss = 0.f;
#pragma unroll
                for (int e = 0; e < 8; ++e) { const float kr_ = xk[e] * kkw[e]; ss += kr_ * kr_; }
                ss = red8(ss); const float rn = rsqrtf(ss + 1e-6f);
                float kk[8], kd[8], bb[8], br = 0.f, kr = 0.f, sb = 0.f;
#pragma unroll
                for (int e = 0; e < 8; ++e) { kk[e] = xk[e] * kkw[e] * rn; kd[e] = xk[e] * (1.f + (ic[e] - 1.f) * kaw[e]); bb[e] = kk[e] * ic[e];
                    br += bb[e] * xr[e]; kr += kd[e] * xr[e]; sb += xr[e] * kd[e] * rkw[e]; }
                br = red8(br); kr = red8(kr); sb = 0.5f * red8(sb);
#pragma unroll
                for (int e = 0; e < 2; ++e) {
                    *(f32x4*)(A_kk + i * 64 + j0 + 4 * e) = (f32x4){kk[4 * e], kk[4 * e + 1], kk[4 * e + 2], kk[4 * e + 3]};
                    *(f32x4*)(A_wr + i * 64 + j0 + 4 * e) = (f32x4){w[4 * e] * xr[4 * e], w[4 * e + 1] * xr[4 * e + 1], w[4 * e + 2] * xr[4 * e + 2], w[4 * e + 3] * xr[4 * e + 3]};
                    *(f32x4*)(A_kd + i * 64 + j0 + 4 * e) = (f32x4){kd[4 * e], kd[4 * e + 1], kd[4 * e + 2], kd[4 * e + 3]};
                    *(f32x4*)(A_bb + i * 64 + j0 + 4 * e) = (f32x4){bb[4 * e], bb[4 * e + 1], bb[4 * e + 2], bb[4 * e + 3]}; }
                if (cgp == 0) { SC[i * 4 + 0] = br; SC[i * 4 + 1] = kr; if (!isctx) SBON[((size_t)d * MLAT + rowbase + t0 + sgn * i) * 16 + h] = sb; }
            }
            __syncthreads();
            if (ch + 1 < NCHUNK) prefetch(ch + 1);
            { const int cgp = qo & 7, row = qo >> 3, j0 = 8 * cgp;
              bf16_t* yp = YD + ((size_t)d * MLAT + rowbase + t0) * 1024 + h * 64 + row;
              for (int i = 0; i < CH; ++i) {
                  float kk8[8], wr8[8], w8[8], bb8[8], kd8[8];
#pragma unroll
                  for (int e = 0; e < 2; ++e) { const f32x4 a = *(const f32x4*)(A_kk + i * 64 + j0 + 4 * e), b2 = *(const f32x4*)(A_wr + i * 64 + j0 + 4 * e), c2 = *(const f32x4*)(A_w + i * 64 + j0 + 4 * e),
                          d2 = *(const f32x4*)(A_bb + i * 64 + j0 + 4 * e), e2 = *(const f32x4*)(A_kd + i * 64 + j0 + 4 * e);
#pragma unroll
                      for (int x = 0; x < 4; ++x) { kk8[4 * e + x] = a[x]; wr8[4 * e + x] = b2[x]; w8[4 * e + x] = c2[x]; bb8[4 * e + x] = d2[x]; kd8[4 * e + x] = e2[x]; } }
                  const float v = A_v[i * 64 + row]; const float2 sc = *(const float2*)(SC + i * 4);
                  float sa = 0.f, pp = 0.f;
#pragma unroll
                  for (int j = 0; j < 8; ++j) { sa += S[j] * kk8[j]; pp += S[j] * wr8[j]; }
                  sa = red8(sa); pp = red8(pp);
                  const float y = pp - sa * sc.x + v * sc.y;
#pragma unroll
                  for (int j = 0; j < 8; ++j) S[j] = S[j] * w8[j] - sa * bb8[j] + v * kd8[j];
                  if (!isctx && cgp == 0) yp[(ptrdiff_t)sgn * i * 1024] = f2bf(y);
              } }
            __syncthreads();
        }
    }
}

constexpr int LDK = 136, LDC = 40, LDL = 36;
constexpr int G_RAW = 0, G_CW = 23040, G_SC = 29440, G_UQ = 29952, G_WK = 29952, G_VNT = 38656, G_UK = 46336, G_TM = 46336, G_QKM = 48896, G_LM = 51456, G_UV = 62720,
              G_KA = 70912, G_QA = 79616, G_QD = 88320, G_KGT = 97024, G_KTT = 107520, G_VT = 118016, G_ST = 123264, G_GC = 140672, G_T11T = 140928, G_XT = 141440;
__device__ __forceinline__ void phase_gdn(const Params& P, unsigned char* smem) {
    const int tid = threadIdx.x;
    const bf16_t* P1 = (const bf16_t*)(P.ws + WS_X);
    bf16_t* OD = (bf16_t*)P.out + (size_t)2 * MLAT * 1024;
    bf16_t* RAW = (bf16_t*)(smem + G_RAW); float* CW = (float*)(smem + G_CW); float* GSC = (float*)(smem + G_SC); float* UQ = (float*)(smem + G_UQ); float* UK = (float*)(smem + G_UK); float* UV = (float*)(smem + G_UV);
    bf16_t* WK = (bf16_t*)(smem + G_WK); bf16_t* VNT = (bf16_t*)(smem + G_VNT); bf16_t* TM = (bf16_t*)(smem + G_TM); bf16_t* QKM = (bf16_t*)(smem + G_QKM); float* LM = (float*)(smem + G_LM);
    bf16_t* KA = (bf16_t*)(smem + G_KA); bf16_t* QA = (bf16_t*)(smem + G_QA); bf16_t* QD = (bf16_t*)(smem + G_QD); bf16_t* KGT = (bf16_t*)(smem + G_KGT); bf16_t* KTT = (bf16_t*)(smem + G_KTT);
    bf16_t* VT = (bf16_t*)(smem + G_VT); bf16_t* ST = (bf16_t*)(smem + G_ST); float* GC = (float*)(smem + G_GC);
    for (int it = blockIdx.x; it < 256; it += gridDim.x) {
        const int b = it >> 5, hg = (it >> 2) & 7, d = (it >> 1) & 1, half = it & 1;
        f32x4 sacc[4];
#pragma unroll
        for (int nt = 0; nt < 4; ++nt) sacc[nt] = (f32x4){0.f, 0.f, 0.f, 0.f};
        __syncthreads();
        float cwr[5][8];
        { const int cv = tid % 40; const int ccol = cv < 16 ? hg * 128 + 8 * cv : (cv < 32 ? 1024 + hg * 128 + 8 * (cv - 16) : 2048 + hg * 128 + half * 64 + 8 * (cv - 32));
#pragma unroll
          for (int j = 0; j < 5; ++j) { const f32x4 c0 = *(const f32x4*)(P.in[19] + j * 3072 + ccol), c1 = *(const f32x4*)(P.in[19] + j * 3072 + ccol + 4);
#pragma unroll
              for (int x = 0; x < 4; ++x) { cwr[j][x] = c0[x]; cwr[j][4 + x] = c1[x]; } } }
        for (int e = tid; e < 64 * LDK / 2; e += 512) ((unsigned*)ST)[e] = 0u;
        const float alog = -__expf(P.in[20][d * 8 + hg]), dtb = P.in[21][d * 8 + hg];
        unsigned pre[3][4]; unsigned pab = 0;
        auto prefetch = [&](int ch) {
            const bool isctx = ch < 8;
            const int sbase = isctx ? ch * CH : (ch - 8) * CH, Tlen = isctx ? TC : TL;
            const int rowbase = isctx ? MLAT + b * TC : b * TL;
            const int t0 = d == 0 ? sbase : Tlen - 1 - sbase, sgn = d == 0 ? 1 : -1;
            const int lo = d == 0 ? sbase : Tlen - sbase - CH;
            const u32x4 zz = {0u, 0u, 0u, 0u};
            int qv = tid; asm volatile("" : "+v"(qv));
#pragma unroll
            for (int n = 0; n < 3; ++n) { const int s = qv + 512 * n, wt = s / 40, cv = s % 40; const int t = lo - 2 + wt;
                const int col = COL_CV + (cv < 16 ? hg * 128 + 8 * cv : (cv < 32 ? 1024 + hg * 128 + 8 * (cv - 16) : 2048 + hg * 128 + half * 64 + 8 * (cv - 32)));
                const u32x4 gv_ = (s < 1440 && t >= 0 && t < Tlen) ? *(const u32x4*)(P1 + (size_t)(rowbase + t) * LD1 + col) : zz; pre[n][0] = gv_.x; pre[n][1] = gv_.y; pre[n][2] = gv_.z; pre[n][3] = gv_.w; }
            if (qv < CH) { const int t = t0 + sgn * qv; const bf16_t* ro = P1 + (size_t)(rowbase + t) * LD1 + COL_AB;
                pab = (unsigned)ro[d * 8 + hg] | ((unsigned)ro[16 + d * 8 + hg] << 16); }
        };
        auto consumeA = [&]() {
            int qa = tid; asm volatile("" : "+v"(qa));
#pragma unroll
            for (int n = 0; n < 3; ++n) { const int s = qa + 512 * n; if (s < 1440) *(u32x4*)(RAW + s * 8) = (u32x4){pre[n][0], pre[n][1], pre[n][2], pre[n][3]}; }
            if (qa < CH) { const float a_raw = __uint_as_float(pab << 16), b_raw = __uint_as_float(pab & 0xffff0000u);
                const float xx = a_raw + dtb; const float sp = xx > 20.f ? xx : __logf(1.f + __expf(xx));
                GSC[qa * 4 + 0] = alog * sp; GSC[qa * 4 + 1] = sigm(b_raw); }
        };
        prefetch(0);
        consumeA();
        __syncthreads();
        for (int ch = 0; ch < NCHUNK; ++ch) {
            int qo = tid; asm volatile("" : "+v"(qo));
            const int lane = qo & 63, wave = qo >> 6, fr = lane & 15, fq = lane >> 4;
            const bool isctx = ch < 8;
            const int sbase = isctx ? ch * CH : (ch - 8) * CH, Tlen = isctx ? TC : TL;
            const int rowbase = isctx ? MLAT + b * TC : b * TL;
            const int t0 = d == 0 ? sbase : Tlen - 1 - sbase, sgn = d == 0 ? 1 : -1;
            if (ch + 1 < NCHUNK) prefetch(ch + 1);
            if (qo < 480) { const int cv = qo % 40, tg = qo / 40; const int ntok = tg < 8 ? 3 : 2, tok0 = tg < 8 ? 3 * tg : 24 + 2 * (tg - 8);
                u32x4 raw[7];
#pragma unroll
                for (int r = 0; r < 7; ++r) { const int rr = tok0 + r < 36 ? tok0 + r : 35; raw[r] = *(const u32x4*)(RAW + rr * 320 + 8 * cv); }
#pragma unroll
                for (int o = 0; o < 3; ++o) if (o < ntok) { float acc[8];
#pragma unroll
                    for (int e = 0; e < 8; ++e) { float a_ = 0.f;
#pragma unroll
                        for (int j = 0; j < 5; ++j) { const unsigned w_ = raw[o + j][e >> 1]; a_ += cwr[j][e] * __uint_as_float((e & 1) ? (w_ & 0xffff0000u) : (w_ << 16)); }
                        acc[e] = a_ * sigm(a_); }
                    const int wt_ = tok0 + o, i = (d == 0 ? wt_ : CH - 1 - wt_);
                    float* dst = cv < 16 ? UQ + i * 128 + 8 * cv : (cv < 32 ? UK + i * 128 + 8 * (cv - 16) : UV + i * 64 + 8 * (cv - 32));
                    *(f32x4*)dst = (f32x4){acc[0], acc[1], acc[2], acc[3]}; *(f32x4*)(dst + 4) = (f32x4){acc[4], acc[5], acc[6], acc[7]}; } }
            if (wave == 7) { float g = lane < CH ? GSC[lane * 4] : 0.f;
#pragma unroll
                for (int o = 1; o < 32; o <<= 1) { const float t = __shfl_up(g, o); if (lane >= o) g += t; }
                if (lane < CH) GC[lane] = g; }
            __syncthreads();
            { const int i = qo >> 4, cg = qo & 15, j0 = 8 * cg;
              float qv8[8], kv8[8];
#pragma unroll
              for (int e = 0; e < 2; ++e) { const f32x4 a = *(const f32x4*)(UQ + i * 128 + j0 + 4 * e), b2 = *(const f32x4*)(UK + i * 128 + j0 + 4 * e);
#pragma unroll
                  for (int x = 0; x < 4; ++x) { qv8[4 * e + x] = a[x]; kv8[4 * e + x] = b2[x]; } }
              float sq = 0.f, sk = 0.f;
#pragma unroll
              for (int e = 0; e < 8; ++e) { sq += qv8[e] * qv8[e]; sk += kv8[e] * kv8[e]; }
              sq = red16(sq); sk = red16(sk);
              const float rq = rsqrtf(sq + 1e-6f) * 0.08838834764831845f, rk = rsqrtf(sk + 1e-6f);
              const float gci = GC[i], gcl = GC[CH - 1], beta = GSC[i * 4 + 1];
              const float eg = __expf(gci), et = __expf(gcl - gci), bg = beta * eg;
              float vv[8];
              if (cg < 8) { const f32x4 a = *(const f32x4*)(UV + i * 64 + j0), b2 = *(const f32x4*)(UV + i * 64 + j0 + 4);
#pragma unroll
                  for (int x = 0; x < 4; ++x) { vv[x] = a[x]; vv[4 + x] = b2[x]; } }
#pragma unroll
              for (int e = 0; e < 8; ++e) { qv8[e] *= rq; kv8[e] *= rk; }
              u32x4 w;
              w.x = pk2(kv8[0], kv8[1]); w.y = pk2(kv8[2], kv8[3]); w.z = pk2(kv8[4], kv8[5]); w.w = pk2(kv8[6], kv8[7]); *(u32x4*)(KA + i * LDK + j0) = w;
              w.x = pk2(qv8[0], qv8[1]); w.y = pk2(qv8[2], qv8[3]); w.z = pk2(qv8[4], qv8[5]); w.w = pk2(qv8[6], qv8[7]); *(u32x4*)(QA + i * LDK + j0) = w;
              w.x = pk2(qv8[0] * eg, qv8[1] * eg); w.y = pk2(qv8[2] * eg, qv8[3] * eg); w.z = pk2(qv8[4] * eg, qv8[5] * eg); w.w = pk2(qv8[6] * eg, qv8[7] * eg); *(u32x4*)(QD + i * LDK + j0) = w;
#pragma unroll
              for (int e = 0; e < 8; ++e) { KGT[TROW(j0 + e) + i] = f2bf(kv8[e] * bg); KTT[TROW(j0 + e) + i] = f2bf(kv8[e] * et); }
              if (cg < 8) {
#pragma unroll
                  for (int e = 0; e < 8; ++e) VT[TROW(j0 + e) + i] = f2bf(vv[e] * beta); } }
            __syncthreads();
            { const int mt = (wave >> 1) & 1, nt = wave & 1; const bf16_t* Am = wave < 4 ? KA : QA;
              f32x4 acc = {0.f, 0.f, 0.f, 0.f};
#pragma unroll
              for (int ks = 0; ks < 4; ++ks) { const s16x8 a = *(const s16x8*)(KA + (nt * 16 + fr) * LDK + ks * 32 + fq * 8), bb = *(const s16x8*)(Am + (mt * 16 + fr) * LDK + ks * 32 + fq * 8);
                  acc = MFMA16(a, bb, acc); }
              const int i = mt * 16 + fr; const float gci = GC[i], bi = GSC[i * 4 + 1];
              const f32x4 gcj = *(const f32x4*)(GC + nt * 16 + fq * 4);
              float lv[4];
#pragma unroll
              for (int r = 0; r < 4; ++r) { const int j = nt * 16 + fq * 4 + r; const float dec = __expf(fminf(gci - gcj[r], 0.f));
                  lv[r] = wave < 4 ? ((i > j) ? bi * acc[r] * dec : 0.f) : ((i >= j) ? acc[r] * dec : 0.f); }
              if (wave < 4) *(f32x4*)(LM + i * LDL + nt * 16 + fq * 4) = (f32x4){lv[0], lv[1], lv[2], lv[3]};
              else { uint2 o; o.x = pk2(lv[0], lv[1]); o.y = pk2(lv[2], lv[3]); *(uint2*)(QKM + i * LDC + nt * 16 + fq * 4) = o; } }
            if (wave == 0 || wave == 3) { asm volatile("s_waitcnt lgkmcnt(0)" ::: "memory"); tri_inv_part1(LM, TM, (bf16_t*)(smem + G_T11T), wave == 0 ? 0 : 1, lane); }
            __syncthreads();
            if (wave == 0) tri_inv_part2(LM, TM, (const bf16_t*)(smem + G_T11T), (bf16_t*)(smem + G_XT), lane);
            __syncthreads();
            const int mtu = wave >> 2, ntu = wave & 3;
            f32x4 vacc;
            { const s16x8 a = *(const s16x8*)(TM + (mtu * 16 + fr) * LDC + fq * 8), bb = *(const s16x8*)(VT + TROW(ntu * 16 + fr) + fq * 8);
              vacc = MFMA16(a, bb, ((f32x4){0.f, 0.f, 0.f, 0.f}));
#pragma unroll
              for (int x = 0; x < 2; ++x) { const int tt = 2 * wave + x, mtk = tt >> 1, ntk = tt & 1;
                  const s16x8 a2 = *(const s16x8*)(KGT + TROW(mtk * 16 + fr) + fq * 8), b2 = *(const s16x8*)(TM + (ntk * 16 + fr) * LDC + fq * 8);
                  const f32x4 r = MFMA16(a2, b2, ((f32x4){0.f, 0.f, 0.f, 0.f}));
                  uint2 o; o.x = pk2(-r[0], -r[1]); o.y = pk2(-r[2], -r[3]);
                  *(uint2*)(WK + (ntk * 16 + fr) * LDK + mtk * 16 + fq * 4) = o; } }
            __syncthreads();
            f32x4 oacc = {0.f, 0.f, 0.f, 0.f};
#pragma unroll
            for (int ks = 0; ks < 4; ++ks) { const s16x8 bs = *(const s16x8*)(ST + (ntu * 16 + fr) * LDK + ks * 32 + fq * 8);
                const s16x8 aw = *(const s16x8*)(WK + (mtu * 16 + fr) * LDK + ks * 32 + fq * 8), aq = *(const s16x8*)(QD + (mtu * 16 + fr) * LDK + ks * 32 + fq * 8);
                vacc = MFMA16(aw, bs, vacc); oacc = MFMA16(aq, bs, oacc); }
            { uint2 o; o.x = pk2(vacc[0], vacc[1]); o.y = pk2(vacc[2], vacc[3]); *(uint2*)(VNT + (ntu * 16 + fr) * LDC + mtu * 16 + fq * 4) = o; }
            __syncthreads();
            { const s16x8 a = *(const s16x8*)(QKM + (mtu * 16 + fr) * LDC + fq * 8), bb = *(const s16x8*)(VNT + (ntu * 16 + fr) * LDC + fq * 8);
              oacc = MFMA16(a, bb, oacc);
              if (!isctx) { bf16_t* op = OD + ((size_t)d * MLAT + rowbase + t0) * 1024 + hg * 128 + half * 64 + ntu * 16 + fr;
#pragma unroll
                  for (int r = 0; r < 4; ++r) op[(ptrdiff_t)sgn * (mtu * 16 + fq * 4 + r) * 1024] = f2bf(oacc[r]); }
              const float gl = __expf(GC[CH - 1]);
              const s16x8 ak = *(const s16x8*)(KTT + TROW(wave * 16 + fr) + fq * 8);
#pragma unroll
              for (int nt = 0; nt < 4; ++nt) { const s16x8 bv = *(const s16x8*)(VNT + (nt * 16 + fr) * LDC + fq * 8);
                  sacc[nt] = MFMA16(ak, bv, sacc[nt] * gl);
                  uint2 o; o.x = pk2(sacc[nt][0], sacc[nt][1]); o.y = pk2(sacc[nt][2], sacc[nt][3]);
                  *(uint2*)(ST + (nt * 16 + fr) * LDK + wave * 16 + fq * 4) = o; } }
            if (ch + 1 < NCHUNK) consumeA();
            __syncthreads();
        }
    }
}

constexpr int LK2 = 72;
constexpr int R_WR = 0, R_KD = 8192, R_W = 16384, R_BB = 24576, R_LM = 0, R_TM = 4608, R_AKM = 7168, R_RKM = 9728, R_RBM = 12288, R_WM = 14848, R_X1T = 19456, R_NUT = 24576,
              R_V = 32768, R_THW = 40960, R_THA = 47104, R_GAM = 53248, R_PRM = 61440, R_AT = 62464, R_RT = 67072, R_KT = 71680, R_BT = 76288,
              R_ATT = 80896, R_KTT = 86144, R_BTT = 91392, R_VT = 96640, R_ST = 101888, R_T11T = 111104, R_XT = 111616;
__device__ __forceinline__ void phase_rwkv_chunked(const Params& P, unsigned char* smem) {
    const int tid = threadIdx.x;
    const bf16_t* P1 = (const bf16_t*)(P.ws + WS_X);
    bf16_t* YD = (bf16_t*)P.out;
    float* SBON = (float*)(P.ws + WS_M + MiB);
    float* A_wr = (float*)(smem + R_WR); float* A_kd = (float*)(smem + R_KD); float* A_w = (float*)(smem + R_W); float* A_bb = (float*)(smem + R_BB); float* A_v = (float*)(smem + R_V);
    bf16_t* TH_w = (bf16_t*)(smem + R_THW); bf16_t* TH_a = (bf16_t*)(smem + R_THA); float* GAM = (float*)(smem + R_GAM); float* PRM = (float*)(smem + R_PRM);
    float* LM = (float*)(smem + R_LM); bf16_t* TM = (bf16_t*)(smem + R_TM); bf16_t* AKM = (bf16_t*)(smem + R_AKM); bf16_t* RKM = (bf16_t*)(smem + R_RKM); bf16_t* RBM = (bf16_t*)(smem + R_RBM);
    bf16_t* WM = (bf16_t*)(smem + R_WM); bf16_t* X1T = (bf16_t*)(smem + R_X1T); bf16_t* NUT = (bf16_t*)(smem + R_NUT);
    bf16_t* AT = (bf16_t*)(smem + R_AT); bf16_t* RT = (bf16_t*)(smem + R_RT); bf16_t* KT = (bf16_t*)(smem + R_KT); bf16_t* BT = (bf16_t*)(smem + R_BT);
    bf16_t* ATT = (bf16_t*)(smem + R_ATT); bf16_t* KTT = (bf16_t*)(smem + R_KTT); bf16_t* BTT = (bf16_t*)(smem + R_BTT); bf16_t* VT = (bf16_t*)(smem + R_VT); bf16_t* ST = (bf16_t*)(smem + R_ST);
    const float* mu = P.in[8];
    for (int it = blockIdx.x; it < 256; it += gridDim.x) {
        const int b = it >> 5, h = (it >> 1) & 15, d = it & 1;
        f32x4 sacc[2];
        sacc[0] = (f32x4){0.f, 0.f, 0.f, 0.f}; sacc[1] = (f32x4){0.f, 0.f, 0.f, 0.f};
        s16x8 Bw[3], Ba[3];
        __syncthreads();
        { const int lane = tid & 63, wave = tid >> 6; const int cB = h * 64 + 16 * (wave & 3) + (lane & 15);
#pragma unroll
          for (int ks = 0; ks < 3; ++ks)
#pragma unroll
            for (int j = 0; j < 8; ++j) { const int k = ks * 32 + (lane >> 4) * 8 + j;
                Bw[ks][j] = (short)f2bf(P.in[10][((size_t)d * 96 + k) * 1024 + cB]); Ba[ks][j] = (short)f2bf(P.in[12][((size_t)d * 96 + k) * 1024 + cB]); }
          if (tid < 64) { PRM[tid] = P.in[14][h * 64 + tid]; PRM[64 + tid] = P.in[15][h * 64 + tid]; PRM[128 + tid] = P.in[16][h * 64 + tid]; }
          for (int e = tid; e < 64 * LK2 / 2; e += 512) ((unsigned*)ST)[e] = 0u; }
        const float w0c = P.in[9][d * 1024 + h * 64 + 16 * ((tid >> 6) & 3) + (tid & 15)], a0c = P.in[11][d * 1024 + h * 64 + 16 * ((tid >> 6) & 3) + (tid & 15)];
        unsigned pre[3][12];
        auto prefetch = [&](int ch) {
            const bool isctx = ch < 8;
            const int sbase = isctx ? ch * CH : (ch - 8) * CH, Tlen = isctx ? TC : TL;
            const int rowbase = isctx ? MLAT + b * TC : b * TL;
            const int t0 = d == 0 ? sbase : Tlen - 1 - sbase, sgn = d == 0 ? 1 : -1;
            const u32x4 zz = {0u, 0u, 0u, 0u};
            int qv = tid; asm volatile("" : "+v"(qv));
#pragma unroll
            for (int n = 0; n < 3; ++n) { const int ws = n * 8 + (qv >> 6), ln_ = qv & 63; const int L_ = (ws < 12 ? ws : (ws < 18 ? ws - 12 : ws - 18)) * 64 + ln_;
                const int i = ws < 12 ? L_ / 24 : L_ / 12, cv = ws < 12 ? L_ % 24 : (ws < 18 ? 24 + L_ % 12 : 36 + L_ % 12); const int t = t0 + sgn * i;
                const int col = cv < 8 ? h * 64 + 8 * cv : (cv < 16 ? 1024 + h * 64 + 8 * (cv - 8) : (cv < 24 ? 2048 + h * 64 + 8 * (cv - 16) : (cv < 36 ? 3072 + d * 96 + 8 * (cv - 24) : 3264 + d * 96 + 8 * (cv - 36))));
                const bf16_t* pp = P1 + (size_t)(rowbase + t) * LD1 + col;
                { const u32x4 pv_ = *(const u32x4*)pp; pre[n][0] = pv_.x; pre[n][1] = pv_.y; pre[n][2] = pv_.z; pre[n][3] = pv_.w; }
                const unsigned* pw = (const unsigned*)pp; constexpr int LW = LD1 / 2;
                if (isctx) { const bool vl = t > 0, vr = t < TC - 1;
                    const u32x4 L = vl ? *(const u32x4*)(pp - LD1) : zz, R = vr ? *(const u32x4*)(pp + LD1) : zz;
                    pre[n][4] = L.x; pre[n][5] = L.y; pre[n][6] = L.z; pre[n][7] = L.w; pre[n][8] = R.x; pre[n][9] = R.y; pre[n][10] = R.z; pre[n][11] = R.w; }
                else { const int x = t & 63, y = t >> 6; const bool vl = x > 0, vr = x < 63, vu = y > 0, vd = y < 31;
                    pre[n][4] = vl ? pw[-LW + 0] : 0u; pre[n][5] = vl ? pw[-LW + 2] : 0u; pre[n][6] = vr ? pw[LW + 0] : 0u; pre[n][7] = vr ? pw[LW + 2] : 0u;
                    pre[n][8] = vu ? pw[-64 * LW + 1] : 0u; pre[n][9] = vu ? pw[-64 * LW + 3] : 0u; pre[n][10] = vd ? pw[64 * LW + 1] : 0u; pre[n][11] = vd ? pw[64 * LW + 3] : 0u; } }
        };
        prefetch(0);
        for (int ch = 0; ch < NCHUNK; ++ch) {
            int qo = tid; asm volatile("" : "+v"(qo));
            const int lane = qo & 63, wave = qo >> 6, fr = lane & 15, fq = lane >> 4;
            const bool isctx = ch < 8;
            const int sbase = isctx ? ch * CH : (ch - 8) * CH, Tlen = isctx ? TC : TL;
            const int rowbase = isctx ? MLAT + b * TC : b * TL;
            const int t0 = d == 0 ? sbase : Tlen - 1 - sbase, sgn = d == 0 ? 1 : -1;
#pragma unroll
            for (int n = 0; n < 3; ++n) { const int ws = n * 8 + wave; const int L_ = (ws < 12 ? ws : (ws < 18 ? ws - 12 : ws - 18)) * 64 + lane;
                const int i = ws < 12 ? L_ / 24 : L_ / 12, cv = ws < 12 ? L_ % 24 : (ws < 18 ? 24 + L_ % 12 : 36 + L_ % 12);
                const int col = cv < 8 ? h * 64 + 8 * cv : (cv < 16 ? 1024 + h * 64 + 8 * (cv - 8) : (cv < 24 ? 2048 + h * 64 + 8 * (cv - 16) : (cv < 36 ? 3072 + d * 96 + 8 * (cv - 24) : 3264 + d * 96 + 8 * (cv - 36))));
                const f32x4 m0 = *(const f32x4*)(mu + col), m1 = *(const f32x4*)(mu + col + 4);
                float xs[8];
#pragma unroll
                for (int e = 0; e < 8; ++e) { const float p = __uint_as_float((e & 1) ? (pre[n][e >> 1] & 0xffff0000u) : (pre[n][e >> 1] << 16));
                    unsigned wv_; const bool hi = (e & 1);
                    if (isctx) wv_ = (e & 1) ? pre[n][8 + (e >> 1)] : pre[n][4 + (e >> 1)];
                    else wv_ = pre[n][4 + 2 * (e & 3) + (e >> 2)];
                    const float ps = __uint_as_float(hi ? (wv_ & 0xffff0000u) : (wv_ << 16));
                    xs[e] = p + (ps - p) * (e < 4 ? m0[e & 3] : m1[e & 3]); }
                if (cv < 24) { float* dst = (cv < 8 ? A_wr + i * 64 + 8 * cv : (cv < 16 ? A_kd + i * 64 + 8 * (cv - 8) : A_v + i * 64 + 8 * (cv - 16)));
                    *(f32x4*)dst = (f32x4){xs[0], xs[1], xs[2], xs[3]}; *(f32x4*)(dst + 4) = (f32x4){xs[4], xs[5], xs[6], xs[7]}; }
                else if (cv < 36) { u32x4 w; w.x = pk2(tanh_fast(xs[0]), tanh_fast(xs[1])); w.y = pk2(tanh_fast(xs[2]), tanh_fast(xs[3])); w.z = pk2(tanh_fast(xs[4]), tanh_fast(xs[5])); w.w = pk2(tanh_fast(xs[6]), tanh_fast(xs[7]));
                    *(u32x4*)(TH_w + i * 96 + 8 * (cv - 24)) = w; }
                else { u32x4 w; w.x = pk2(xs[0], xs[1]); w.y = pk2(xs[2], xs[3]); w.z = pk2(xs[4], xs[5]); w.w = pk2(xs[6], xs[7]);
                    *(u32x4*)(TH_a + i * 96 + 8 * (cv - 36)) = w; } }
            __syncthreads();
            if (ch + 1 < NCHUNK) prefetch(ch + 1);
            if (wave < 4) { const int c = 16 * wave + fr;
              float wv[2][4];
#pragma unroll
              for (int rt = 0; rt < 2; ++rt) { f32x4 cw = {0.f, 0.f, 0.f, 0.f}, ca = {0.f, 0.f, 0.f, 0.f};
#pragma unroll
                  for (int ks = 0; ks < 3; ++ks) { const int off = (rt * 16 + fr) * 96 + ks * 32 + fq * 8;
                      const s16x8 fa = *(const s16x8*)(TH_w + off), fb = *(const s16x8*)(TH_a + off);
                      cw = MFMA16(fa, Bw[ks], cw); ca = MFMA16(fb, Ba[ks], ca); }
#pragma unroll
                  for (int j = 0; j < 4; ++j) { const int i = rt * 16 + fq * 4 + j;
                      wv[rt][j] = __expf(-0.6065306597126334f * sigm(w0c + cw[j])); A_bb[i * 64 + c] = sigm(a0c + ca[j]); } }
              float tot[2];
#pragma unroll
              for (int rt = 0; rt < 2; ++rt) { wv[rt][1] *= wv[rt][0]; wv[rt][2] *= wv[rt][1]; wv[rt][3] *= wv[rt][2];
                  float sx = wv[rt][3]; float u1 = __shfl_up(sx, 16); if (fq >= 1) sx *= u1; float u2 = __shfl_up(sx, 32); if (fq >= 2) sx *= u2;
                  float ex = __shfl_up(sx, 16); if (fq == 0) ex = 1.f;
                  tot[rt] = __shfl(sx, 48 + fr);
                  const float base = ex * (rt == 1 ? tot[0] : 1.f);
#pragma unroll
                  for (int j = 0; j < 4; ++j) GAM[(rt * 16 + fq * 4 + j) * 64 + c] = base * wv[rt][j]; } }
            __syncthreads();
            { const int i = qo >> 4, cg = qo & 15, j0 = 4 * cg;
              const f32x4 xr = *(const f32x4*)(A_wr + i * 64 + j0), xk = *(const f32x4*)(A_kd + i * 64 + j0), ic = *(const f32x4*)(A_bb + i * 64 + j0), xv = *(const f32x4*)(A_v + i * 64 + j0);
              const f32x4 kkw = *(const f32x4*)(PRM + j0), kaw = *(const f32x4*)(PRM + 64 + j0), rkw = *(const f32x4*)(PRM + 128 + j0);
              const f32x4 gi = *(const f32x4*)(GAM + i * 64 + j0), gl = *(const f32x4*)(GAM + 31 * 64 + j0);
              f32x4 gp = {1.f, 1.f, 1.f, 1.f}; if (i > 0) gp = *(const f32x4*)(GAM + (i - 1) * 64 + j0);
              const f32x4 kkr = xk * kkw;
              const float ss = red16(kkr[0] * kkr[0] + kkr[1] * kkr[1] + kkr[2] * kkr[2] + kkr[3] * kkr[3]);
              const f32x4 kk = kkr * rsqrtf(ss + 1e-6f);
              f32x4 kd, bb, at, rt_, kt, bt, ktl, btl; float sbp = 0.f;
#pragma unroll
              for (int e = 0; e < 4; ++e) { kd[e] = xk[e] * (1.f + (ic[e] - 1.f) * kaw[e]); bb[e] = kk[e] * ic[e]; sbp += xr[e] * kd[e] * rkw[e];
                  const float ig = __builtin_amdgcn_rcpf(gi[e]); at[e] = kk[e] * gp[e]; rt_[e] = xr[e] * gi[e]; kt[e] = kd[e] * ig; bt[e] = bb[e] * ig; ktl[e] = kt[e] * gl[e]; btl[e] = bt[e] * gl[e]; }
              const float sb = 0.5f * red16(sbp);
              if (cg == 0 && !isctx) SBON[((size_t)d * MLAT + rowbase + t0 + sgn * i) * 16 + h] = sb;
              uint2 o;
              o.x = pk2(at[0], at[1]); o.y = pk2(at[2], at[3]); *(uint2*)(AT + i * LK2 + j0) = o;
              o.x = pk2(rt_[0], rt_[1]); o.y = pk2(rt_[2], rt_[3]); *(uint2*)(RT + i * LK2 + j0) = o;
              o.x = pk2(kt[0], kt[1]); o.y = pk2(kt[2], kt[3]); *(uint2*)(KT + i * LK2 + j0) = o;
              o.x = pk2(bt[0], bt[1]); o.y = pk2(bt[2], bt[3]); *(uint2*)(BT + i * LK2 + j0) = o;
#pragma unroll
              for (int e = 0; e < 4; ++e) { ATT[TROW(j0 + e) + i] = f2bf(at[e]); KTT[TROW(j0 + e) + i] = f2bf(ktl[e]); BTT[TROW(j0 + e) + i] = f2bf(btl[e]); VT[TROW(j0 + e) + i] = f2bf(xv[e]); } }
            __syncthreads();
#pragma unroll
            for (int x = 0; x < 2; ++x) { const int t = 2 * wave + x, m = t >> 2, mt = (t >> 1) & 1, nt = t & 1;
                const bf16_t* Am = m < 2 ? AT : RT; const bf16_t* Bm = (m == 0 || m == 3) ? BT : KT;
                f32x4 acc = {0.f, 0.f, 0.f, 0.f};
#pragma unroll
                for (int ks = 0; ks < 2; ++ks) { const s16x8 a = *(const s16x8*)(Bm + (nt * 16 + fr) * LK2 + ks * 32 + fq * 8), bb2 = *(const s16x8*)(Am + (mt * 16 + fr) * LK2 + ks * 32 + fq * 8);
                    acc = MFMA16(a, bb2, acc); }
                const int i = mt * 16 + fr; float lv[4];
#pragma unroll
                for (int r = 0; r < 4; ++r) { const int j = nt * 16 + fq * 4 + r; lv[r] = (m < 2 ? (i > j) : (i >= j)) ? acc[r] : 0.f; }
                if (m == 0) *(f32x4*)(LM + i * LDL + nt * 16 + fq * 4) = (f32x4){lv[0], lv[1], lv[2], lv[3]};
                else { bf16_t* dstm = m == 1 ? AKM : (m == 2 ? RKM : RBM); uint2 o; o.x = pk2(lv[0], lv[1]); o.y = pk2(lv[2], lv[3]); *(uint2*)(dstm + i * LDC + nt * 16 + fq * 4) = o; } }
            if (wave < 2) { asm volatile("s_waitcnt lgkmcnt(0)" ::: "memory"); tri_inv_part1(LM, TM, (bf16_t*)(smem + R_T11T), wave, lane); }
            __syncthreads();
            if (wave == 0) tri_inv_part2(LM, TM, (const bf16_t*)(smem + R_T11T), (bf16_t*)(smem + R_XT), lane);
            else {
                const int ntile = (wave == 1) ? 2 : 1;
                for (int q2 = 0; q2 < ntile; ++q2) { const int tl = (q2 == 0) ? wave : 0; const int mt = tl >> 2, nt = tl & 3;
                    const s16x8 a = *(const s16x8*)(AKM + (mt * 16 + fr) * LDC + fq * 8), bb2 = *(const s16x8*)(VT + TROW(nt * 16 + fr) + fq * 8);
                    const f32x4 r = MFMA16(a, bb2, ((f32x4){0.f, 0.f, 0.f, 0.f}));
                    uint2 o; o.x = pk2(r[0], r[1]); o.y = pk2(r[2], r[3]); *(uint2*)(X1T + (nt * 16 + fr) * LDC + mt * 16 + fq * 4) = o; }
            }
            __syncthreads();
            const int mtu = wave >> 2, ntu = wave & 3;
            f32x4 uacc;
            { const s16x8 a = *(const s16x8*)(TM + (mtu * 16 + fr) * LDC + fq * 8), bb2 = *(const s16x8*)(X1T + (ntu * 16 + fr) * LDC + fq * 8);
              uacc = MFMA16(a, bb2, ((f32x4){0.f, 0.f, 0.f, 0.f}));
              const int kt_ = wave >> 1, it_ = wave & 1;
              const s16x8 a2 = *(const s16x8*)(ATT + TROW(kt_ * 16 + fr) + fq * 8), b2 = *(const s16x8*)(TM + (it_ * 16 + fr) * LDC + fq * 8);
              const f32x4 r = MFMA16(a2, b2, ((f32x4){0.f, 0.f, 0.f, 0.f}));
              uint2 o; o.x = pk2(r[0], r[1]); o.y = pk2(r[2], r[3]); *(uint2*)(WM + (it_ * 16 + fr) * LK2 + kt_ * 16 + fq * 4) = o; }
            __syncthreads();
            f32x4 yacc = {0.f, 0.f, 0.f, 0.f};
#pragma unroll
            for (int ks = 0; ks < 2; ++ks) { const s16x8 bs = *(const s16x8*)(ST + (ntu * 16 + fr) * LK2 + ks * 32 + fq * 8);
                const s16x8 aw = *(const s16x8*)(WM + (mtu * 16 + fr) * LK2 + ks * 32 + fq * 8), ar = *(const s16x8*)(RT + (mtu * 16 + fr) * LK2 + ks * 32 + fq * 8);
                uacc = MFMA16(aw, bs, uacc); yacc = MFMA16(ar, bs, yacc); }
            { const s16x8 a = *(const s16x8*)(RKM + (mtu * 16 + fr) * LDC + fq * 8), bb2 = *(const s16x8*)(VT + TROW(ntu * 16 + fr) + fq * 8);
              yacc = MFMA16(a, bb2, yacc);
              uint2 o; o.x = pk2(-uacc[0], -uacc[1]); o.y = pk2(-uacc[2], -uacc[3]); *(uint2*)(NUT + (ntu * 16 + fr) * LDC + mtu * 16 + fq * 4) = o; }
            __syncthreads();
            { const s16x8 a = *(const s16x8*)(RBM + (mtu * 16 + fr) * LDC + fq * 8), bb2 = *(const s16x8*)(NUT + (ntu * 16 + fr) * LDC + fq * 8);
              yacc = MFMA16(a, bb2, yacc);
              if (!isctx) { bf16_t* yp = YD + ((size_t)d * MLAT + rowbase + t0) * 1024 + h * 64 + ntu * 16 + fr;
#pragma unroll
                  for (int r = 0; r < 4; ++r) yp[(ptrdiff_t)sgn * (mtu * 16 + fq * 4 + r) * 1024] = f2bf(yacc[r]); }
              const int kt_ = wave >> 1;
              const f32x4 gl = *(const f32x4*)(GAM + 31 * 64 + kt_ * 16 + fq * 4);
              const s16x8 ak = *(const s16x8*)(KTT + TROW(kt_ * 16 + fr) + fq * 8), ab = *(const s16x8*)(BTT + TROW(kt_ * 16 + fr) + fq * 8);
#pragma unroll
              for (int x = 0; x < 2; ++x) { const int vt = 2 * (wave & 1) + x;
                  const s16x8 bv = *(const s16x8*)(VT + TROW(vt * 16 + fr) + fq * 8), bu = *(const s16x8*)(NUT + (vt * 16 + fr) * LDC + fq * 8);
                  sacc[x] = MFMA16(ak, bv, sacc[x] * gl); sacc[x] = MFMA16(ab, bu, sacc[x]);
                  uint2 o; o.x = pk2(sacc[x][0], sacc[x][1]); o.y = pk2(sacc[x][2], sacc[x][3]);
                  *(uint2*)(ST + (vt * 16 + fr) * LK2 + kt_ * 16 + fq * 4) = o; } }
            __syncthreads();
        }
    }
}


__device__ __forceinline__ void mix8_lat(const bf16_t* P1, int row, int col0, const float* mu, float (&xs)[8]) {
    const int t = row & (TL - 1), x = t & 63, y = t >> 6; const bool vl = x > 0, vr = x < 63, vu = y > 0, vd = y < 31;
    const bf16_t* pp = P1 + (size_t)row * LD1 + col0; const unsigned* pw = (const unsigned*)pp; constexpr int LW = LD1 / 2;
    const u32x4 pv = *(const u32x4*)pp;
    unsigned nb[8];
    nb[0] = vl ? pw[-LW + 0] : 0u; nb[1] = vl ? pw[-LW + 2] : 0u; nb[2] = vr ? pw[LW + 0] : 0u; nb[3] = vr ? pw[LW + 2] : 0u;
    nb[4] = vu ? pw[-64 * LW + 1] : 0u; nb[5] = vu ? pw[-64 * LW + 3] : 0u; nb[6] = vd ? pw[64 * LW + 1] : 0u; nb[7] = vd ? pw[64 * LW + 3] : 0u;
    const f32x4 m0 = *(const f32x4*)(mu + col0), m1 = *(const f32x4*)(mu + col0 + 4);
#pragma unroll
    for (int e = 0; e < 8; ++e) { const float p = __uint_as_float((e & 1) ? (pv[e >> 1] & 0xffff0000u) : (pv[e >> 1] << 16));
        const unsigned w_ = nb[2 * (e & 3) + (e >> 2)]; const float ps = __uint_as_float((e & 1) ? (w_ & 0xffff0000u) : (w_ << 16));
        xs[e] = p + (ps - p) * (e < 4 ? m0[e & 3] : m1[e & 3]); }
}
__device__ __forceinline__ void phase_sg(const Params& P) {
    const bf16_t* P1 = (const bf16_t*)(P.ws + WS_X); bf16_t* SG = (bf16_t*)(P.ws + WS_A + 32 * MiB);
    const int gt = blockIdx.x * 512 + threadIdx.x, NT = gridDim.x * 512;
    for (int s = gt; s < MLAT * 32; s += NT) { const int row = s >> 5, k8 = s & 31;
        u32x4 w = {0u, 0u, 0u, 0u};
        if (k8 < 8) { float xs[8]; mix8_lat(P1, row, 3456 + 8 * k8, P.in[8], xs);
            w.x = pk2(sigm(xs[0]), sigm(xs[1])); w.y = pk2(sigm(xs[2]), sigm(xs[3])); w.z = pk2(sigm(xs[4]), sigm(xs[5])); w.w = pk2(sigm(xs[6]), sigm(xs[7])); }
        *(u32x4*)(SG + (size_t)row * 256 + 8 * k8) = w; }
}
__device__ __forceinline__ void phase_readout_rwkv(const Params& P) {
    const bf16_t* P1 = (const bf16_t*)(P.ws + WS_X); const bf16_t* YD = (const bf16_t*)P.out; const float* SBON = (const float*)(P.ws + WS_M + MiB);
    bf16_t* OA = (bf16_t*)(P.ws + WS_A);
    const float* lnw = P.in[17]; const float* lnb = P.in[18];
    const int gt = blockIdx.x * 512 + threadIdx.x, NT = gridDim.x * 512;
    for (int s = gt; s < MLAT * 128; s += NT) { const int row = s >> 7, cv = s & 127, c0 = 8 * cv, hd = cv >> 3;
        const u32x4 y0 = *(const u32x4*)(YD + (size_t)row * 1024 + c0), y1 = *(const u32x4*)(YD + ((size_t)MLAT + row) * 1024 + c0), gg = *(const u32x4*)(OA + (size_t)row * 1024 + c0);
        float xv[8]; mix8_lat(P1, row, 2048 + c0, P.in[8], xv);
        const float sb = SBON[(size_t)row * 16 + hd] + SBON[((size_t)MLAT + row) * 16 + hd];
        const f32x4 w0 = *(const f32x4*)(lnw + c0), w1 = *(const f32x4*)(lnw + c0 + 4), b0 = *(const f32x4*)(lnb + c0), b1 = *(const f32x4*)(lnb + c0 + 4);
        float y[8], sum = 0.f;
#pragma unroll
        for (int e = 0; e < 8; ++e) { const unsigned a_ = y0[e >> 1], b_ = y1[e >> 1];
            y[e] = __uint_as_float((e & 1) ? (a_ & 0xffff0000u) : (a_ << 16)) + __uint_as_float((e & 1) ? (b_ & 0xffff0000u) : (b_ << 16)); sum += y[e]; }
        const float m = red8(sum) * (1.f / 64.f); float vs = 0.f;
#pragma unroll
        for (int e = 0; e < 8; ++e) { y[e] -= m; vs += y[e] * y[e]; }
        const float rs = rsqrtf(red8(vs) * (1.f / 64.f) + 64e-5f);
        float o[8];
#pragma unroll
        for (int e = 0; e < 8; ++e) { const unsigned g_ = gg[e >> 1]; const float gate = __uint_as_float((e & 1) ? (g_ & 0xffff0000u) : (g_ << 16));
            o[e] = (y[e] * rs * (e < 4 ? w0[e & 3] : w1[e & 3]) + (e < 4 ? b0[e & 3] : b1[e & 3]) + sb * xv[e]) * gate; }
        u32x4 w; w.x = pk2(o[0], o[1]); w.y = pk2(o[2], o[3]); w.z = pk2(o[4], o[5]); w.w = pk2(o[6], o[7]);
        *(u32x4*)(OA + (size_t)row * 1024 + c0) = w; }
}
__device__ __forceinline__ void phase_readout(const Params& P, unsigned char* smem) {
    const int tid = threadIdx.x, lane = tid & 63, wave = tid >> 6;
    const bf16_t* P1 = (const bf16_t*)(P.ws + WS_X); const bf16_t* P2 = (const bf16_t*)(P.ws + WS_D);
    const bf16_t* YD = (const bf16_t*)P.out; const bf16_t* OD = YD + (size_t)2 * MLAT * 1024;
    const float* SBON = (const float*)(P.ws + WS_M + MiB);
    bf16_t* OA = (bf16_t*)(P.ws + WS_A); bf16_t* OB = (bf16_t*)(P.ws + WS_F);
    const float* mu = P.in[8];
    { const int gw = blockIdx.x * 8 + wave, NGW = gridDim.x * 8; const float* nw = P.in[22];
      for (int row = gw; row < MLAT; row += NGW) { const int c0 = lane * 16;
        const u32x4 a0 = *(const u32x4*)(OD + (size_t)row * 1024 + c0), a1 = *(const u32x4*)(OD + (size_t)row * 1024 + c0 + 8);
        const u32x4 b0 = *(const u32x4*)(OD + ((size_t)MLAT + row) * 1024 + c0), b1 = *(const u32x4*)(OD + ((size_t)MLAT + row) * 1024 + c0 + 8);
        const u32x4 z0 = *(const u32x4*)(P2 + (size_t)row * LD2 + c0), z1 = *(const u32x4*)(P2 + (size_t)row * LD2 + c0 + 8);
        float o[16], z[16];
#pragma unroll
        for (int e = 0; e < 4; ++e) { o[2 * e] = __uint_as_float(a0[e] << 16) + __uint_as_float(b0[e] << 16); o[2 * e + 1] = __uint_as_float(a0[e] & 0xffff0000u) + __uint_as_float(b0[e] & 0xffff0000u);
            o[8 + 2 * e] = __uint_as_float(a1[e] << 16) + __uint_as_float(b1[e] << 16); o[8 + 2 * e + 1] = __uint_as_float(a1[e] & 0xffff0000u) + __uint_as_float(b1[e] & 0xffff0000u);
            z[2 * e] = __uint_as_float(z0[e] << 16); z[2 * e + 1] = __uint_as_float(z0[e] & 0xffff0000u); z[8 + 2 * e] = __uint_as_float(z1[e] << 16); z[8 + 2 * e + 1] = __uint_as_float(z1[e] & 0xffff0000u); }
        float ss = 0.f;
#pragma unroll
        for (int e = 0; e < 16; ++e) ss += o[e] * o[e];
        ss = red8(ss);
        const float rs = rsqrtf(ss * (1.f / 128.f) + 1e-6f);
        float r[16];
#pragma unroll
        for (int e = 0; e < 16; ++e) r[e] = o[e] * rs * nw[(c0 + e) & 127] * (z[e] * sigm(z[e]));
        u32x4 w0, w1;
#pragma unroll
        for (int e = 0; e < 4; ++e) { w0[e] = pk2(r[2 * e], r[2 * e + 1]); w1[e] = pk2(r[8 + 2 * e], r[8 + 2 * e + 1]); }
        *(u32x4*)(OB + (size_t)row * 1024 + c0) = w0; *(u32x4*)(OB + (size_t)row * 1024 + c0 + 8) = w1; } }
}

__global__ void __launch_bounds__(512, 2) fwd_mega(Params P) {
    extern __shared__ __attribute__((aligned(16))) unsigned char smem[];
    cg::grid_group grid = cg::this_grid();
    bf16_t* WT_IN = (bf16_t*)(P.ws + WS_A); bf16_t* WT_PA = (bf16_t*)(P.ws + WS_B); bf16_t* WT_PB = WT_PA + 2048 * 1024; bf16_t* WT_OUT = WT_PB + 2048 * 1024;
    bf16_t* P1 = (bf16_t*)(P.ws + WS_X); bf16_t* P2 = (bf16_t*)(P.ws + WS_D); bf16_t* H = (bf16_t*)P.out;
    bf16_t* OA = (bf16_t*)(P.ws + WS_A); bf16_t* OB = (bf16_t*)(P.ws + WS_F); bf16_t* MBUF = (bf16_t*)(P.ws + WS_X); bf16_t* A3 = (bf16_t*)(P.ws + WS_X);
    bf16_t* H2 = (bf16_t*)(P.ws + WS_D); bf16_t* WT_GU = (bf16_t*)(P.ws + WS_A); bf16_t* WT_DN = (bf16_t*)(P.ws + WS_F);
    const float* MOD = (const float*)(P.ws + WS_M);
#define PHASE(n) if (P.ph_lo <= (n) && (n) < P.ph_hi)
#define SEAM(n) do { if (P.coop && P.ph_lo <= (n) && (n) + 1 < P.ph_hi) grid.sync(); } while (0)
    PHASE(0) { phase_prep(P, smem); } SEAM(0);
    PHASE(1) { phase_norm1(P); } SEAM(1);
    PHASE(2) { EpiBf16Plain e1{P1, LD1}; run_gemm(smem, H, WT_IN, MALL, N1, D, e1);
               EpiBf16Plain e2{P2, LD2}; run_gemm(smem, H, WT_IN + (size_t)N1 * D, MLAT, N2, D, e2); } SEAM(2);
    PHASE(3) { phase_sg(P); phase_rwkv_chunked(P, smem); }
    PHASE(4) { phase_gdn(P, smem); } SEAM(4);
    PHASE(5) { EpiBf16Plain eg{OA, 1024}; run_gemm(smem, (const bf16_t*)(P.ws + WS_A + 32 * MiB), (const bf16_t*)(P.ws + WS_M + MiB / 2), MLAT, 1024, 256, eg); phase_readout(P, smem); } SEAM(5);
    PHASE(6) { phase_readout_rwkv(P); } SEAM(6);
    PHASE(7) { EpiGate<false> ea{MBUF, P2 + 1024}; run_gemm(smem, OA, WT_PA, MLAT, D, 1024, ea);
               EpiGate<true> eb{MBUF, P2 + 1024 + 2048}; run_gemm(smem, OB, WT_PB, MLAT, D, 1024, eb); } SEAM(7);
    PHASE(8) { EpiRes e{P.out, P.in[0], MOD + 2 * D}; run_gemm(smem, MBUF, WT_OUT, MLAT, D, D, e); } SEAM(8);
    PHASE(9) { phase_norm2(P); phase_ffn_weights(P, smem); } SEAM(9);
    PHASE(10) { EpiSwiglu e{A3}; run_gemm(smem, H2, WT_GU, MLAT, 2 * FFH, D, e); } SEAM(10);
    PHASE(11) { EpiRes e{P.out, P.out, MOD + 5 * D}; run_gemm(smem, A3, WT_DN, MLAT, D, FFH, e, 1); } SEAM(11);
    PHASE(12) { phase_final_norm(P); }
}

#ifndef N_LAUNCH_PER_PHASE
#define N_LAUNCH_PER_PHASE 0
#endif
#ifndef PROBE_SEQ
#define PROBE_SEQ {0,1,2,3,4,5,6,7,8,9,10,11,12}
#endif
extern "C" void kernel_launch(void* const* d_in, const int* in_sizes, int n_in, void* d_out, int out_size, void* d_ws, size_t ws_size, hipStream_t stream) {
    static int grid = 0;
    if (grid == 0) {
        if (n_in != 30 || out_size != MLAT * D || ws_size < WS_END) { fprintf(stderr, "kernel_launch: unexpected shapes: n_in %d out %d ws %zu (need %zu)\n", n_in, out_size, ws_size, (size_t)WS_END); grid = -1; return; }
        int dev = 0, cus = 0, per_cu = 0;
        if (hipGetDevice(&dev) != hipSuccess || hipDeviceGetAttribute(&cus, hipDeviceAttributeMultiprocessorCount, dev) != hipSuccess) { grid = -1; return; }
        if (hipFuncSetAttribute((const void*)fwd_mega, hipFuncAttributeMaxDynamicSharedMemorySize, LDS_BYTES) != hipSuccess) { fprintf(stderr, "kernel_launch: hipFuncSetAttribute failed\n"); grid = -1; return; }
        if (hipOccupancyMaxActiveBlocksPerMultiprocessor(&per_cu, (const void*)fwd_mega, 512, LDS_BYTES) != hipSuccess || per_cu < 1) { fprintf(stderr, "kernel_launch: occupancy query gives %d\n", per_cu); grid = -1; return; }
        grid = cus * per_cu; if (grid > 256) grid = 256;
    }
    if (grid < 0) return;
    Params p{};
    for (int i = 0; i < 30; ++i) p.in[i] = (const float*)d_in[i];
    p.out = (float*)d_out; p.ws = (unsigned char*)d_ws;
#if N_LAUNCH_PER_PHASE
    { const int seq[] = PROBE_SEQ; for (int si = 0; si < (int)(sizeof(seq) / sizeof(int)); ++si) { const int ph = seq[si]; p.ph_lo = ph; p.ph_hi = ph + 1; p.coop = 0; hipLaunchKernelGGL(fwd_mega, dim3(grid), dim3(512), LDS_BYTES, stream, p); } }
#else
    p.ph_lo = 0; p.ph_hi = 13; p.coop = 1;
    void* args[] = {&p};
    hipError_t e = hipLaunchCooperativeKernel((const void*)fwd_mega, dim3(grid), dim3(512), args, LDS_BYTES, stream);
    if (e != hipSuccess) fprintf(stderr, "cooperative launch failed: %s (grid %d)\n", hipGetErrorString(e), grid);
#endif
}
```

```cpp
#include <hip/hip_runtime.h>
#include <hip/hip_cooperative_groups.h>
#include <cstdio>
#include <cstdint>
namespace cg = cooperative_groups;
namespace pg8 {
#define PG8_LAS __attribute__((address_space(3)))
typedef unsigned short bf16_t;
typedef short bf16x8 __attribute__((ext_vector_type(8)));
typedef float f32x4 __attribute__((ext_vector_type(4)));
typedef unsigned u32x4 __attribute__((ext_vector_type(4)));
constexpr int BM = 256, BK = 64, HALF = 128, HTB = HALF * BK * 2  , STAGE_BYTES = 8 * HTB, NXCD = 8, WGM = 8;

__host__ __device__ __forceinline__ int lds_byte(int r, int c) { const int st = (r >> 4) * 2 + (c >> 5), rr = r & 15, cc = c & 31, ob = rr * 64 + cc * 2; return st * 1024 + (ob ^ (((ob >> 9) & 1) << 5)); }
__host__ __device__ __forceinline__ void stage_rc(int b, int& R, int& C) { const int st = b / 1024, sb = b % 1024, swz = sb ^ (((sb >> 9) & 1) << 5); R = (st >> 1) * 16 + swz / 64; C = (st & 1) * 32 + (swz % 64) / 2; }
__host__ __device__ __forceinline__ int perm32(int rho) { const int n = rho >> 4, i = rho & 15; return 8 * (i >> 2) + 4 * n + (i & 3); }

struct Unit { int pm, pn; };
struct Gemm { const bf16_t* A; const bf16_t* Bt; int M, N, K; };

struct StaticOrder {
    int nM, nN, nwg, G, c;
    __host__ __device__ void init(int M, int N, int G_, int c_) { nM = M / BM; nN = N / BM; nwg = nM * nN; G = G_; c = c_; }
    __host__ __device__ bool next(int i, Unit& u) const {
        const long L = (long)i * G + c; if (L >= nwg) return false;
        int wgid = (int)L; { const int q = nwg / NXCD, r = nwg % NXCD, xcd = wgid % NXCD, off = wgid / NXCD; wgid = (xcd < r ? xcd * (q + 1) : r * (q + 1) + (xcd - r) * q) + off; }
        const int nig = WGM * nN, gid = wgid / nig, fm = gid * WGM, gsz = (nM - fm) < WGM ? (nM - fm) : WGM;
        u.pm = fm + ((wgid % nig) % gsz); u.pn = (wgid % nig) / gsz; return true;
    }
    __device__ __forceinline__ void a_ready(const Unit&) const {}
    __device__ __forceinline__ void done(const Unit&) const {}
};
__device__ __forceinline__ unsigned cvt_pk_bf16(float lo, float hi) { unsigned r; asm volatile("v_cvt_pk_bf16_f32 %0, %1, %2" : "=v"(r) : "v"(lo), "v"(hi)); return r; }
template <class Epi, class Sched, bool STAMP = false>
__device__ __forceinline__ void gemm_phase(PG8_LAS unsigned char* lds, const Gemm g, const Sched& S, const Epi& E, unsigned long long* stamps) {
    const int tid = threadIdx.x, wid = __builtin_amdgcn_readfirstlane(tid >> 6), lane = tid & 63, wr = wid >> 2, wc = wid & 3, fr = lane & 15, fq = lane >> 4;
    const int K = g.K, nt = K / BK;
    int ts_lo = 0, ts_hi = 0, nts = 0; const unsigned long long rt_entry = STAMP ? (unsigned long long)wall_clock64() : 0ull;
#define PG8_STAMP() do { if (STAMP && wid == 0 && nts < 64) { const unsigned long long _c = (unsigned long long)clock64(); \
        ts_lo = (lane == nts) ? (int)(unsigned)_c : ts_lo; ts_hi = (lane == nts) ? (int)(unsigned)(_c >> 32) : ts_hi; ++nts; } } while (0)
    PG8_STAMP();
    unsigned voffA[2], voffB[2];
#pragma unroll
    for (int i = 0; i < 2; ++i) { int R, C; stage_rc(tid * 16 + i * 8192, R, C); const int Rb = Epi::PERM ? ((R & ~31) + perm32(R & 31)) : R;
        voffA[i] = (unsigned)(R * K + C) * 2u; voffB[i] = (unsigned)(Rb * K + C) * 2u; }
    const size_t kstep = (size_t)(BK * 2);
    const size_t hstep = (size_t)HALF * K * 2;
    const size_t tstep = 2 * hstep;
    const unsigned ldsw = (unsigned)wid * 1024u;
    const int aoff = lds_byte(wr * 64 + fr, fq * 8), boff = lds_byte(wc * 32 + fr, fq * 8);
#define PG8_SA(b, h) (((b) * 2 + (h)) * HTB)
#define PG8_SB(b, h) ((4 + (b) * 2 + (h)) * HTB)
#define PG8_STAGE(bufoff, gbase, voff) do { _Pragma("unroll") for (int _i = 0; _i < 2; ++_i) \
        __builtin_amdgcn_global_load_lds((const unsigned*)((const char*)(gbase) + (voff)[_i]), (PG8_LAS unsigned*)(lds + (bufoff) + ldsw + _i * 8192), 16, 0, 0); } while (0)
#define PG8_LDA(dst, b, h) do { _Pragma("unroll") for (int m = 0; m < 4; ++m) _Pragma("unroll") for (int k = 0; k < 2; ++k) dst[m][k] = *(const PG8_LAS bf16x8*)(lds + PG8_SA(b, h) + aoff + m * 2048 + k * 1024); } while (0)
#define PG8_LDB(dst, b, h) do { _Pragma("unroll") for (int n = 0; n < 2; ++n) _Pragma("unroll") for (int k = 0; k < 2; ++k) dst[n][k] = *(const PG8_LAS bf16x8*)(lds + PG8_SB(b, h) + boff + n * 2048 + k * 1024); } while (0)
#define PG8_MMA(ai, bj, At, Bt) do { __builtin_amdgcn_s_setprio(1); _Pragma("unroll") for (int m = 0; m < 4; ++m) _Pragma("unroll") for (int n = 0; n < 2; ++n) _Pragma("unroll") for (int k = 0; k < 2; ++k) \
        acc[ai][bj][m][n] = __builtin_amdgcn_mfma_f32_16x16x32_bf16(Bt[n][k], At[m][k], acc[ai][bj][m][n], 0, 0, 0); __builtin_amdgcn_s_setprio(0); } while (0)
#define PG8_WAIT_V(n) asm volatile("s_waitcnt vmcnt(" #n ")" ::: "memory")
#define PG8_WAIT_L(n) asm volatile("s_waitcnt lgkmcnt(" #n ")" ::: "memory")
#define PG8_BAR __builtin_amdgcn_s_barrier()
#define PG8_SCHED __builtin_amdgcn_sched_barrier(0)
    Unit cur, nxt; int ui = 0;
    if (!S.next(0, cur)) return;
    f32x4 acc[2][2][4][2];
#pragma unroll
    for (int a = 0; a < 2; ++a)
#pragma unroll
        for (int b = 0; b < 2; ++b)
#pragma unroll
            for (int m = 0; m < 4; ++m)
#pragma unroll
                for (int n = 0; n < 2; ++n) acc[a][b][m][n] = (f32x4){0.f, 0.f, 0.f, 0.f};
    bf16x8 At[4][2], B0[2][2], B1[2][2];
    const char* cA = (const char*)g.A + (size_t)cur.pm * tstep; const char* cB = (const char*)g.Bt + (size_t)cur.pn * tstep;
    S.a_ready(cur);
    PG8_STAGE(PG8_SB(0, 0), cB, voffB); PG8_STAGE(PG8_SA(0, 0), cA, voffA); PG8_STAGE(PG8_SB(0, 1), cB + hstep, voffB); PG8_STAGE(PG8_SA(0, 1), cA + hstep, voffA);
    if (wr == 1) PG8_BAR;
    PG8_WAIT_V(4); PG8_BAR;
    PG8_STAGE(PG8_SB(1, 0), cB + kstep, voffB); PG8_STAGE(PG8_SA(1, 0), cA + kstep, voffA); PG8_STAGE(PG8_SB(1, 1), cB + hstep + kstep, voffB);
    PG8_WAIT_V(6); PG8_BAR;
    PG8_STAMP();
    for (;;) {
        const bool has_next = S.next(ui + 1, nxt);
        const char* nA = has_next ? (const char*)g.A + (size_t)nxt.pm * tstep : cA; const char* nB = has_next ? (const char*)g.Bt + (size_t)nxt.pn * tstep : cB;
        for (int t = 0; t < nt; t += 2) {
            const bool last = (t == nt - 2);
            const char* a1 = cA + (size_t)(t + 1) * kstep;
            const char* a2 = last ? nA : cA + (size_t)(t + 2) * kstep; const char* b2 = last ? nB : cB + (size_t)(t + 2) * kstep;
            const char* a3 = a2 + kstep; const char* b3 = b2 + kstep;
            if (last && has_next) S.a_ready(nxt);
            PG8_LDB(B0, 0, 0); PG8_SCHED; PG8_LDA(At, 0, 0); PG8_STAGE(PG8_SA(1, 1), a1 + hstep, voffA);
            PG8_WAIT_L(8); PG8_BAR; PG8_WAIT_L(0); PG8_MMA(0, 0, At, B0); PG8_BAR; PG8_SCHED;
            PG8_LDB(B1, 0, 1); PG8_STAGE(PG8_SB(0, 0), b2, voffB);
            PG8_BAR; PG8_WAIT_L(0); PG8_MMA(0, 1, At, B1); PG8_BAR;
            PG8_LDA(At, 0, 1); PG8_STAGE(PG8_SA(0, 0), a2, voffA);
            PG8_BAR; PG8_WAIT_L(0); PG8_MMA(1, 0, At, B0); PG8_BAR; PG8_SCHED;
            PG8_STAGE(PG8_SB(0, 1), b2 + hstep, voffB);
            PG8_WAIT_V(6); PG8_BAR; PG8_MMA(1, 1, At, B1); PG8_BAR;
            PG8_LDB(B0, 1, 0); PG8_SCHED; PG8_LDA(At, 1, 0); PG8_STAGE(PG8_SA(0, 1), a2 + hstep, voffA);
            PG8_WAIT_L(8); PG8_BAR; PG8_WAIT_L(0); PG8_MMA(0, 0, At, B0); PG8_BAR; PG8_SCHED;
            PG8_LDB(B1, 1, 1); PG8_STAGE(PG8_SB(1, 0), b3, voffB);
            PG8_BAR; PG8_WAIT_L(0); PG8_MMA(0, 1, At, B1); PG8_BAR;
            PG8_LDA(At, 1, 1); PG8_STAGE(PG8_SA(1, 0), a3, voffA);
            PG8_BAR; PG8_WAIT_L(0); PG8_MMA(1, 0, At, B0); PG8_BAR; PG8_SCHED;
            PG8_STAGE(PG8_SB(1, 1), b3 + hstep, voffB);
            PG8_WAIT_V(6); PG8_BAR; PG8_MMA(1, 1, At, B1); PG8_BAR;
        }
        PG8_STAMP();
        if constexpr (!Epi::AFTER_DRAIN) { E(acc, cur, wr, wc, fr, fq); S.done(cur); }
        PG8_STAMP();
        if (!has_next) break;
#pragma unroll
        for (int a = 0; a < 2; ++a)
#pragma unroll
            for (int b = 0; b < 2; ++b)
#pragma unroll
                for (int m = 0; m < 4; ++m)
#pragma unroll
                    for (int n = 0; n < 2; ++n) acc[a][b][m][n] = (f32x4){0.f, 0.f, 0.f, 0.f};
        cur = nxt; cA = nA; cB = nB; ++ui;
    }
    PG8_WAIT_V(0);
    if (wr == 0) PG8_BAR;
    PG8_BAR;
    if constexpr (Epi::AFTER_DRAIN) { E.fused(acc, cur, wr, wc, fr, fq, lds, wid, lane); S.done(cur); }
    PG8_STAMP();
    if (STAMP && wid == 0) { stamps[lane] = lane < nts ? (((unsigned long long)(unsigned)ts_hi << 32) | (unsigned)ts_lo) : 0ull;
        if (lane == 62) stamps[62] = rt_entry; if (lane == 63) stamps[63] = (unsigned long long)wall_clock64(); }
#undef PG8_STAMP
#undef PG8_SA
#undef PG8_SB
#undef PG8_STAGE
#undef PG8_LDA
#undef PG8_LDB
#undef PG8_MMA
#undef PG8_WAIT_V
#undef PG8_WAIT_L
#undef PG8_BAR
#undef PG8_SCHED
}
}

using pg8::bf16_t; using pg8::f32x4; using pg8::u32x4; using pg8::Unit; using pg8::cvt_pk_bf16;
#define LAS __attribute__((address_space(3)))

constexpr int D = 2048, NB = 8, TL = 2048, TC = 256, MLAT = NB * TL  , MCTX = NB * TC  , MALL = MLAT + MCTX  ;
constexpr int N1 = 6656, N2 = 5120, LD1 = N1, LD2 = N2, FFH = 5632, NADA = 6 * D;
constexpr int COL_CV = 3520, COL_AB = 6592;
constexpr int LDS_BYTES = 147456;
constexpr size_t MiB = 1048576;
constexpr size_t WS_A = 0;
constexpr size_t WS_B = WS_A + 46 * MiB;
constexpr size_t WS_X = WS_B + 16 * MiB;
constexpr size_t WS_D = WS_X + 234 * MiB;
constexpr size_t WS_F = WS_D + 160 * MiB;
constexpr size_t WS_M = WS_F + 32 * MiB;
constexpr size_t WS_END = WS_M + 3 * MiB;

struct Params { const float* in[30]; float* out; unsigned char* ws; int ph_lo, ph_hi, coop, pad; };

__device__ __forceinline__ float bf2f(bf16_t b) { return __uint_as_float(((unsigned)b) << 16); }
typedef __bf16 bf16x2_t __attribute__((ext_vector_type(2)));
typedef float f32x2_t __attribute__((ext_vector_type(2)));
__device__ __forceinline__ unsigned pk2(float lo, float hi) { const f32x2_t v = {lo, hi}; return __builtin_bit_cast(unsigned, __builtin_convertvector(v, bf16x2_t)); }
__device__ __forceinline__ bf16_t f2bf(float f) { return (bf16_t)(pk2(f, 0.f) & 0xffffu); }
__device__ __forceinline__ float sigm(float x) { return __builtin_amdgcn_rcpf(1.f + __expf(-x)); }
__device__ __forceinline__ float tanh_fast(float x) { return 1.f - 2.f * __builtin_amdgcn_rcpf(1.f + __expf(2.f * x)); }
__device__ __forceinline__ float wave_sum(float v) {
#pragma unroll
    for (int o = 1; o < 64; o <<= 1) v += __shfl_xor(v, o);
    return v;
}
template <int CTRL> __device__ __forceinline__ float dppf(float x) { return __int_as_float(__builtin_amdgcn_update_dpp(0, __float_as_int(x), CTRL, 0xF, 0xF, true)); }
__device__ __forceinline__ float red8(float x) { x += dppf<0x141>(x); x += dppf<0xB1>(x); x += dppf<0x4E>(x); return x; }

struct EpiBf16Plain {
    static constexpr bool PERM = true, AFTER_DRAIN = false;
    bf16_t* O; int ldc;
    __device__ __forceinline__ void operator()(const f32x4 (&acc)[2][2][4][2], const Unit& u, int wr, int wc, int fr, int fq) const {
        const int row0 = u.pm * 256 + wr * 64 + fr, col0 = u.pn * 256 + wc * 32 + 8 * fq;
#pragma unroll
        for (int ai = 0; ai < 2; ++ai)
#pragma unroll
            for (int m = 0; m < 4; ++m) { bf16_t* rowp = O + (size_t)(row0 + ai * 128 + m * 16) * ldc + col0;
#pragma unroll
                for (int bj = 0; bj < 2; ++bj) { const f32x4 v0 = acc[ai][bj][m][0], v1 = acc[ai][bj][m][1];
                    u32x4 w; w.x = pk2(v0[0], v0[1]); w.y = pk2(v0[2], v0[3]); w.z = pk2(v1[0], v1[1]); w.w = pk2(v1[2], v1[3]);
                    *(u32x4*)(rowp + bj * 128) = w; } }
    }
};
template <bool SECOND> struct EpiGate {
    static constexpr bool PERM = true, AFTER_DRAIN = false;
    bf16_t* Mo; const bf16_t* G;
    __device__ __forceinline__ void operator()(const f32x4 (&acc)[2][2][4][2], const Unit& u, int wr, int wc, int fr, int fq) const {
        const int row0 = u.pm * 256 + wr * 64 + fr, col0 = u.pn * 256 + wc * 32 + 8 * fq;
#pragma unroll
        for (int ai = 0; ai < 2; ++ai)
#pragma unroll
            for (int m = 0; m < 4; ++m) { const size_t row = (size_t)(row0 + ai * 128 + m * 16);
#pragma unroll
                for (int bj = 0; bj < 2; ++bj) { const f32x4 v0 = acc[ai][bj][m][0], v1 = acc[ai][bj][m][1];
                    const int col = col0 + bj * 128;
                    const u32x4 g = *(const u32x4*)(G + row * LD2 + col);
                    float r[8];
                    r[0] = sigm(__uint_as_float(g.x << 16)) * v0[0]; r[1] = sigm(__uint_as_float(g.x & 0xffff0000u)) * v0[1];
                    r[2] = sigm(__uint_as_float(g.y << 16)) * v0[2]; r[3] = sigm(__uint_as_float(g.y & 0xffff0000u)) * v0[3];
                    r[4] = sigm(__uint_as_float(g.z << 16)) * v1[0]; r[5] = sigm(__uint_as_float(g.z & 0xffff0000u)) * v1[1];
                    r[6] = sigm(__uint_as_float(g.w << 16)) * v1[2]; r[7] = sigm(__uint_as_float(g.w & 0xffff0000u)) * v1[3];
                    u32x4* op = (u32x4*)(Mo + row * D + col);
                    if (SECOND) { const u32x4 o = *op;
                        r[0] += __uint_as_float(o.x << 16); r[1] += __uint_as_float(o.x & 0xffff0000u); r[2] += __uint_as_float(o.y << 16); r[3] += __uint_as_float(o.y & 0xffff0000u);
                        r[4] += __uint_as_float(o.z << 16); r[5] += __uint_as_float(o.z & 0xffff0000u); r[6] += __uint_as_float(o.w << 16); r[7] += __uint_as_float(o.w & 0xffff0000u); }
                    u32x4 w; w.x = pk2(r[0], r[1]); w.y = pk2(r[2], r[3]); w.z = pk2(r[4], r[5]); w.w = pk2(r[6], r[7]);
                    *op = w; } }
    }
};
struct EpiRes {
    static constexpr bool PERM = false, AFTER_DRAIN = false;
    float* out; const float* res; const float* gt;
    __device__ __forceinline__ void operator()(const f32x4 (&acc)[2][2][4][2], const Unit& u, int wr, int wc, int fr, int fq) const {
        const int row0 = u.pm * 256 + wr * 64 + fr, col0 = u.pn * 256 + wc * 32 + 4 * fq;
        const float* gtb = gt + (size_t)((u.pm * 256) >> 11) * NADA + col0;
        f32x4 gv[2][2];
#pragma unroll
        for (int bj = 0; bj < 2; ++bj)
#pragma unroll
            for (int n = 0; n < 2; ++n) gv[bj][n] = *(const f32x4*)(gtb + bj * 128 + n * 16);
#pragma unroll
        for (int ai = 0; ai < 2; ++ai)
#pragma unroll
            for (int m = 0; m < 4; ++m) { const size_t ro = (size_t)(row0 + ai * 128 + m * 16) * D + col0;
#pragma unroll
                for (int bj = 0; bj < 2; ++bj)
#pragma unroll
                    for (int n = 0; n < 2; ++n) { const f32x4 rv = *(const f32x4*)(res + ro + bj * 128 + n * 16);
                        *(f32x4*)(out + ro + bj * 128 + n * 16) = rv + gv[bj][n] * acc[ai][bj][m][n]; } }
    }
};
struct EpiSwiglu {
    static constexpr bool PERM = true, AFTER_DRAIN = false;
    bf16_t* O;
    __device__ __forceinline__ void operator()(const f32x4 (&acc)[2][2][4][2], const Unit& u, int wr, int wc, int fr, int fq) const {
        const int row0 = u.pm * 256 + wr * 64 + fr, col0 = u.pn * 128 + wc * 32 + 8 * fq;
#pragma unroll
        for (int ai = 0; ai < 2; ++ai)
#pragma unroll
            for (int m = 0; m < 4; ++m) { bf16_t* rowp = O + (size_t)(row0 + ai * 128 + m * 16) * FFH + col0;
                float r[8];
#pragma unroll
                for (int n = 0; n < 2; ++n)
#pragma unroll
                    for (int e = 0; e < 4; ++e) { const float g = acc[ai][0][m][n][e], up = acc[ai][1][m][n][e]; r[4 * n + e] = g * sigm(g) * up; }
                u32x4 w; w.x = pk2(r[0], r[1]); w.y = pk2(r[2], r[3]); w.z = pk2(r[4], r[5]); w.w = pk2(r[6], r[7]);
                *(u32x4*)rowp = w; }
    }
};

template <class Epi> __device__ __forceinline__ void run_gemm(unsigned char* smem, const bf16_t* A, const bf16_t* Bt, int M, int N, int K, const Epi& E) {
    pg8::Gemm g; g.A = A; g.Bt = Bt; g.M = M; g.N = N; g.K = K;
    pg8::StaticOrder S; S.init(M, N, (int)gridDim.x, (int)blockIdx.x);
    pg8::gemm_phase<Epi, pg8::StaticOrder, false>((PG8_LAS unsigned char*)smem, g, S, E, nullptr);
    __syncthreads();
}

__device__ __forceinline__ void transpose_item(const float* W, int K, int N, bf16_t* WT, int dst_row0, int src_col0, float* scr, int k0, int lane) {
    if (src_col0 >= 0) {
#pragma unroll 8
        for (int i = 0; i < 32; ++i) { const int kk = 2 * i + (lane >> 5); scr[kk * 33 + (lane & 31)] = W[(size_t)(k0 + kk) * N + src_col0 + (lane & 31)]; }
    } else {
#pragma unroll 8
        for (int i = 0; i < 32; ++i) { const int kk = 2 * i + (lane >> 5); scr[kk * 33 + (lane & 31)] = 0.f; }
    }
    asm volatile("s_waitcnt lgkmcnt(0)" ::: "memory");
    const int c = lane & 7;
#pragma unroll
    for (int j = 0; j < 4; ++j) { const int n = (lane >> 3) + 8 * j; const float* s = scr + (8 * c) * 33 + n;
        u32x4 o; o.x = pk2(s[0], s[33]); o.y = pk2(s[2 * 33], s[3 * 33]); o.z = pk2(s[4 * 33], s[5 * 33]); o.w = pk2(s[6 * 33], s[7 * 33]);
        *(u32x4*)(WT + (size_t)(dst_row0 + n) * K + k0 + 8 * c) = o; }
    asm volatile("s_waitcnt lgkmcnt(0)" ::: "memory");
}
__device__ __forceinline__ int win_src_col(int n0) {
    if (n0 < 6592) return n0;
    if (n0 < 6624) return 7616 + (n0 - 6592);
    if (n0 < 6656) return -1;
    const int j = n0 - 6656;
    return j < 1024 ? 6592 + j : 7648 + (j - 1024);
}

__device__ __forceinline__ void phase_prep(const Params& P, unsigned char* smem) {
    const int tid = threadIdx.x, lane = tid & 63, wave = tid >> 6;
    float* MOD = (float*)(P.ws + WS_M);
    if ((int)blockIdx.x < 192) {
        float* sT = (float*)smem;
        float* red = (float*)(smem + 98304);
        const float* c = P.in[1]; const float* cc = P.in[3];
        for (int idx = tid; idx < 9 * D; idx += 512) { const int m = idx >> 11, k = idx & 2047; const float v = m < 8 ? c[m * D + k] : cc[k]; sT[k * 12 + m] = v * sigm(v); }
        __syncthreads();
        const float* W = P.in[4]; const float* bias = P.in[5];
        for (int item = blockIdx.x; item < 192; item += gridDim.x) {
            const int n0 = item * 64, cl = tid & 15, kl = tid >> 4;
            float acc[9][4];
#pragma unroll
            for (int m = 0; m < 9; ++m)
#pragma unroll
                for (int e = 0; e < 4; ++e) acc[m][e] = 0.f;
#pragma unroll 4
            for (int kk = 0; kk < 64; ++kk) { const int k = kk * 32 + kl;
                const f32x4 w = *(const f32x4*)(W + (size_t)k * NADA + n0 + 4 * cl);
                const f32x4 s0 = *(const f32x4*)(sT + k * 12), s1 = *(const f32x4*)(sT + k * 12 + 4); const float s2 = sT[k * 12 + 8];
#pragma unroll
                for (int e = 0; e < 4; ++e) { acc[0][e] += s0[0] * w[e]; acc[1][e] += s0[1] * w[e]; acc[2][e] += s0[2] * w[e]; acc[3][e] += s0[3] * w[e];
                    acc[4][e] += s1[0] * w[e]; acc[5][e] += s1[1] * w[e]; acc[6][e] += s1[2] * w[e]; acc[7][e] += s1[3] * w[e]; acc[8][e] += s2 * w[e]; } }
#pragma unroll
            for (int m = 0; m < 9; ++m)
#pragma unroll
                for (int e = 0; e < 4; ++e) { float v = acc[m][e]; v += __shfl_xor(v, 16); v += __shfl_xor(v, 32); if ((lane >> 4) == 0) red[(wave * 9 + m) * 64 + 4 * cl + e] = v; }
            __syncthreads();
            for (int o = tid; o < 576; o += 512) { const int m = o >> 6, c2 = o & 63; float s = bias[n0 + c2];
#pragma unroll
                for (int w8 = 0; w8 < 8; ++w8) s += red[(w8 * 9 + m) * 64 + c2];
                MOD[m * NADA + n0 + c2] = s; }
            __syncthreads();
        }
    }
    __syncthreads();
    { bf16_t* G2T = (bf16_t*)(P.ws + WS_M + MiB / 2); const float* g2 = P.in[13];
      for (int s = blockIdx.x * 512 + tid; s < 1024 * 32; s += gridDim.x * 512) { const int n = s >> 5, k8 = s & 31; u32x4 w = {0u, 0u, 0u, 0u};
          if (k8 < 8) { const float* gp = g2 + (size_t)(8 * k8) * 1024 + n; w.x = pk2(gp[0], gp[1024]); w.y = pk2(gp[2048], gp[3072]); w.z = pk2(gp[4096], gp[5120]); w.w = pk2(gp[6144], gp[7168]); }
          *(u32x4*)(G2T + (size_t)n * 256 + 8 * k8) = w; } }
    float* scr = (float*)(smem + wave * 8448);
    const int gw = blockIdx.x * 8 + wave, NGW = gridDim.x * 8;
    bf16_t* WT_IN = (bf16_t*)(P.ws + WS_A); bf16_t* WT_PA = (bf16_t*)(P.ws + WS_B); bf16_t* WT_PB = WT_PA + 2048 * 1024; bf16_t* WT_OUT = WT_PB + 2048 * 1024;
    constexpr int I_IN = 368 * 32, I_PA = 64 * 16, I_OUT = 64 * 32;
    for (int it = gw; it < I_IN + 2 * I_PA + I_OUT; it += NGW) {
        int r = it;
        if (r < I_IN) { const int nb = r % 368, kb = r / 368; transpose_item(P.in[7], 2048, 11744, WT_IN, nb * 32, win_src_col(nb * 32), scr, kb * 64, lane); continue; } r -= I_IN;
        if (r < I_PA) { const int nb = r % 64, kb = r / 64; transpose_item(P.in[23], 1024, 2048, WT_PA, nb * 32, nb * 32, scr, kb * 64, lane); continue; } r -= I_PA;
        if (r < I_PA) { const int nb = r % 64, kb = r / 64; transpose_item(P.in[24], 1024, 2048, WT_PB, nb * 32, nb * 32, scr, kb * 64, lane); continue; } r -= I_PA;
        { const int nb = r % 64, kb = r / 64; transpose_item(P.in[25], 2048, 2048, WT_OUT, nb * 32, nb * 32, scr, kb * 64, lane); }
    }
}
__device__ __forceinline__ void phase_ffn_weights(const Params& P, unsigned char* smem) {
    const int tid = threadIdx.x, lane = tid & 63, wave = tid >> 6;
    float* scr = (float*)(smem + wave * 8448);
    const int gw = blockIdx.x * 8 + wave, NGW = gridDim.x * 8;
    bf16_t* WT_GU = (bf16_t*)(P.ws + WS_A); bf16_t* WT_DN = (bf16_t*)(P.ws + WS_F);
    constexpr int I_GU = 352 * 32, I_DN = 64 * 88;
    for (int it = gw; it < I_GU + I_DN; it += NGW) {
        int r = it;
        if (r < I_GU) { const int nb = r % 352, kb = r / 352; const int n0 = nb * 32, pn = n0 >> 8, cq = n0 & 255; const int src = cq < 128 ? 128 * pn + cq : FFH + 128 * pn + (cq - 128);
            transpose_item(P.in[27], 2048, 2 * FFH, WT_GU, n0, src, scr, kb * 64, lane); continue; } r -= I_GU;
        { const int nb = r % 64, kb = r / 64; transpose_item(P.in[28], FFH, 2048, WT_DN, nb * 32, nb * 32, scr, kb * 64, lane); }
    }
}

__device__ __forceinline__ void norm_mod_row(const float* src, const float* nw, const float* sh, const float* sc, bf16_t* dst, int lane) {
    f32x4 v[8]; float ss = 0.f;
#pragma unroll
    for (int j = 0; j < 8; ++j) { v[j] = *(const f32x4*)(src + (j * 64 + lane) * 4); ss += v[j][0] * v[j][0] + v[j][1] * v[j][1] + v[j][2] * v[j][2] + v[j][3] * v[j][3]; }
    const float rstd = rsqrtf(wave_sum(ss) * (1.f / D) + 1e-6f);
#pragma unroll
    for (int j = 0; j < 8; ++j) { const int c = (j * 64 + lane) * 4; const f32x4 w = *(const f32x4*)(nw + c), a = *(const f32x4*)(sh + c), b = *(const f32x4*)(sc + c);
        float o[4];
#pragma unroll
        for (int e = 0; e < 4; ++e) o[e] = (v[j][e] * rstd * w[e]) * (1.f + b[e]) + a[e];
        uint2 pk; pk.x = pk2(o[0], o[1]); pk.y = pk2(o[2], o[3]); *(uint2*)(dst + c) = pk; }
}
__device__ __forceinline__ void phase_norm1(const Params& P) {
    const int lane = threadIdx.x & 63, gw = blockIdx.x * 8 + (threadIdx.x >> 6), NGW = gridDim.x * 8;
    const float* MOD = (const float*)(P.ws + WS_M); bf16_t* H = (bf16_t*)P.out;
    for (int row = gw; row < MALL; row += NGW) {
        const float* src = row < MLAT ? P.in[0] + (size_t)row * D : P.in[2] + (size_t)(row - MLAT) * D;
        const int mr = row < MLAT ? (row >> 11) : 8;
        norm_mod_row(src, P.in[6], MOD + mr * NADA, MOD + mr * NADA + D, H + (size_t)row * D, lane);
    }
}
__device__ __forceinline__ void phase_norm2(const Params& P) {
    const int lane = threadIdx.x & 63, gw = blockIdx.x * 8 + (threadIdx.x >> 6), NGW = gridDim.x * 8;
    const float* MOD = (const float*)(P.ws + WS_M); bf16_t* H2 = (bf16_t*)(P.ws + WS_D);
    for (int row = gw; row < MLAT; row += NGW) { const int mr = row >> 11;
        norm_mod_row(P.out + (size_t)row * D, P.in[26], MOD + mr * NADA + 3 * D, MOD + mr * NADA + 4 * D, H2 + (size_t)row * D, lane); }
}
__device__ __forceinline__ void phase_final_norm(const Params& P) {
    const int lane = threadIdx.x & 63, gw = blockIdx.x * 8 + (threadIdx.x >> 6), NGW = gridDim.x * 8;
    const float* nw = P.in[29];
    for (int row = gw; row < MLAT; row += NGW) { float* src = P.out + (size_t)row * D;
        f32x4 v[8]; float ss = 0.f;
#pragma unroll
        for (int j = 0; j < 8; ++j) { v[j] = *(const f32x4*)(src + (j * 64 + lane) * 4); ss += v[j][0] * v[j][0] + v[j][1] * v[j][1] + v[j][2] * v[j][2] + v[j][3] * v[j][3]; }
        const float rstd = rsqrtf(wave_sum(ss) * (1.f / D) + 1e-6f);
#pragma unroll
        for (int j = 0; j < 8; ++j) { const int c = (j * 64 + lane) * 4; const f32x4 w = *(const f32x4*)(nw + c); *(f32x4*)(src + c) = v[j] * rstd * w; }
    }
}

__device__ __forceinline__ float mixed_load(const bf16_t* P1, int row, int t, bool isctx, int col, const float* mu) {
    const float p = bf2f(P1[(size_t)row * LD1 + col]);
    int nrow; bool valid;
    if (isctx) { if (col & 1) { valid = t < TC - 1; nrow = row + 1; } else { valid = t > 0; nrow = row - 1; } }
    else { const int m = col & 3, x = t & 63, y = t >> 6;
        if (m == 0) { valid = x > 0; nrow = row - 1; } else if (m == 1) { valid = x < 63; nrow = row + 1; }
        else if (m == 2) { valid = y > 0; nrow = row - 64; } else { valid = y < 31; nrow = row + 64; } }
    const float ps = valid ? bf2f(P1[(size_t)nrow * LD1 + col]) : 0.f;
    return p + (ps - p) * mu[col];
}


__device__ __forceinline__ void tri_inv_part1(const float* LM, bf16_t* TM, bf16_t* T11T, int blk, int lane) {
    constexpr int LDLc = 36, LDCc = 40;
    { const int c = lane & 15, o = 16 * blk; float t[16];
        const float* Lb = LM + o * LDLc + o;
#pragma unroll
        for (int i = 0; i < 16; ++i) { float a4[4] = {(i == c) ? 1.f : 0.f, 0.f, 0.f, 0.f};
#pragma unroll
            for (int j4 = 0; j4 < (i + 3) / 4; ++j4) { const f32x4 l = *(const f32x4*)(Lb + i * LDLc + 4 * j4);
#pragma unroll
                for (int x = 0; x < 4; ++x) if (4 * j4 + x < i) a4[x] -= l[x] * t[4 * j4 + x]; }
            t[i] = (a4[0] + a4[1]) + (a4[2] + a4[3]); }
        if (lane < 16) {
#pragma unroll
            for (int i = 0; i < 16; ++i) TM[(o + i) * LDCc + o + c] = f2bf(t[i]);
            if (blk == 0) { u32x4 w0, w1;
#pragma unroll
                for (int e = 0; e < 4; ++e) { w0[e] = pk2(t[2 * e], t[2 * e + 1]); w1[e] = pk2(t[8 + 2 * e], t[8 + 2 * e + 1]); }
                *(u32x4*)(T11T + c * 16) = w0; *(u32x4*)(T11T + c * 16 + 8) = w1; } }
        else if (lane < 32 && blk == 0) { const u32x4 zz = {0u, 0u, 0u, 0u}; *(u32x4*)(TM + c * LDCc + 16) = zz; *(u32x4*)(TM + c * LDCc + 24) = zz; } }
}
__device__ __forceinline__ void tri_inv_part2(const float* LM, bf16_t* TM, const bf16_t* T11T, bf16_t* XT, int lane) {
    constexpr int LDLc = 36, LDCc = 40;
    typedef short s16x8_ __attribute__((ext_vector_type(8)));
    const int fr = lane & 15, fq = lane >> 4;
    s16x8_ a = {0, 0, 0, 0, 0, 0, 0, 0}, b = {0, 0, 0, 0, 0, 0, 0, 0};
    if (fq < 2) { const f32x4 l0 = *(const f32x4*)(LM + (16 + fr) * LDLc + 8 * fq), l1 = *(const f32x4*)(LM + (16 + fr) * LDLc + 8 * fq + 4);
        u32x4 w; w.x = pk2(l0[0], l0[1]); w.y = pk2(l0[2], l0[3]); w.z = pk2(l1[0], l1[1]); w.w = pk2(l1[2], l1[3]);
        a = __builtin_bit_cast(s16x8_, w); b = *(const s16x8_*)(T11T + fr * 16 + 8 * fq); }
    const f32x4 X = __builtin_amdgcn_mfma_f32_16x16x32_bf16(a, b, ((f32x4){0.f, 0.f, 0.f, 0.f}), 0, 0, 0);
    { uint2 o; o.x = pk2(X[0], X[1]); o.y = pk2(X[2], X[3]); *(uint2*)(XT + fr * 16 + fq * 4) = o; }
    asm volatile("s_waitcnt lgkmcnt(0)" ::: "memory");
    s16x8_ a2 = {0, 0, 0, 0, 0, 0, 0, 0}, b2 = {0, 0, 0, 0, 0, 0, 0, 0};
    if (fq < 2) { a2 = *(const s16x8_*)(XT + fr * 16 + 8 * fq); b2 = *(const s16x8_*)(TM + (16 + fr) * LDCc + 16 + 8 * fq); }
    const f32x4 O = __builtin_amdgcn_mfma_f32_16x16x32_bf16(a2, b2, ((f32x4){0.f, 0.f, 0.f, 0.f}), 0, 0, 0);
    { uint2 o; o.x = pk2(-O[0], -O[1]); o.y = pk2(-O[2], -O[3]); *(uint2*)(TM + (16 + fr) * LDCc + fq * 4) = o; }
}
constexpr int CH = 32, NCHUNK = (TC + TL) / CH;
typedef short s16x8 __attribute__((ext_vector_type(8)));
__device__ __forceinline__ float red16(float x) { x += dppf<0x140>(x); x += dppf<0x141>(x); x += dppf<0xB1>(x); x += dppf<0x4E>(x); return x; }
#define TROW(r) ((r) * LDC + ((r) >> 3) * 8)
#define MFMA16(a, b, c) __builtin_amdgcn_mfma_f32_16x16x32_bf16((a), (b), (c), 0, 0, 0)

constexpr int L_WR = 0, L_KD = 8192, L_V = 16384, L_W = 24576, L_BB = 32768, L_KK = 40960, L_THW = 49152  , L_THA = 55296, L_SC = 61440  , L_PRM = 61952  ;
__device__ __forceinline__ void phase_rwkv(const Params& P, unsigned char* smem) {
    const int tid = threadIdx.x;
    const bf16_t* P1 = (const bf16_t*)(P.ws + WS_X);
    bf16_t* YD = (bf16_t*)P.out;
    float* SBON = (float*)(P.ws + WS_M + MiB);
    float* A_wr = (float*)(smem + L_WR); float* A_kd = (float*)(smem + L_KD); float* A_v = (float*)(smem + L_V); float* A_w = (float*)(smem + L_W);
    float* A_bb = (float*)(smem + L_BB); float* A_kk = (float*)(smem + L_KK); bf16_t* TH_w = (bf16_t*)(smem + L_THW); bf16_t* TH_a = (bf16_t*)(smem + L_THA); float* SC = (float*)(smem + L_SC);
    float* PRM = (float*)(smem + L_PRM);
    const float* mu = P.in[8];
    for (int it = blockIdx.x; it < 256; it += gridDim.x) {
        const int b = it >> 5, h = (it >> 1) & 15, d = it & 1;
        float S[8];
#pragma unroll
        for (int j = 0; j < 8; ++j) S[j] = 0.f;
        s16x8 Bw[3], Ba[3];
        __syncthreads();
        { const int lane = tid & 63, wave = tid >> 6; const int cB = h * 64 + 16 * (wave & 3) + (lane & 15);
#pragma unroll
          for (int ks = 0; ks < 3; ++ks)
#pragma unroll
            for (int j = 0; j < 8; ++j) { const int k = ks * 32 + (lane >> 4) * 8 + j;
                Bw[ks][j] = (short)f2bf(P.in[10][((size_t)d * 96 + k) * 1024 + cB]); Ba[ks][j] = (short)f2bf(P.in[12][((size_t)d * 96 + k) * 1024 + cB]); }
          if (tid < 64) { PRM[tid] = P.in[14][h * 64 + tid]; PRM[64 + tid] = P.in[15][h * 64 + tid]; PRM[128 + tid] = P.in[16][h * 64 + tid]; } }
        const float w0c = P.in[9][d * 1024 + h * 64 + 16 * ((tid >> 6) & 3) + (tid & 15)], a0c = P.in[11][d * 1024 + h * 64 + 16 * ((tid >> 6) & 3) + (tid & 15)];
        unsigned pre[3][12];
        auto prefetch = [&](int ch) {
            const bool isctx = ch < 8;
            const int sbase = isctx ? ch * CH : (ch - 8) * CH, Tlen = isctx ? TC : TL;
            const int rowbase = isctx ? MLAT + b * TC : b * TL;
            const int t0 = d == 0 ? sbase : Tlen - 1 - sbase, sgn = d == 0 ? 1 : -1;
            const u32x4 zz = {0u, 0u, 0u, 0u};
            int qv = tid; asm volatile("" : "+v"(qv));
#pragma unroll
            for (int n = 0; n < 3; ++n) { const int s = qv + 512 * n, i = s / 48, cv = s % 48; const int t = t0 + sgn * i;
                const int col = cv < 8 ? h * 64 + 8 * cv : (cv < 16 ? 1024 + h * 64 + 8 * (cv - 8) : (cv < 24 ? 2048 + h * 64 + 8 * (cv - 16) : (cv < 36 ? 3072 + d * 96 + 8 * (cv - 24) : 3264 + d * 96 + 8 * (cv - 36))));
                const bf16_t* pp = P1 + (size_t)(rowbase + t) * LD1 + col;
                { const u32x4 pv_ = *(const u32x4*)pp; pre[n][0] = pv_.x; pre[n][1] = pv_.y; pre[n][2] = pv_.z; pre[n][3] = pv_.w; }
                const unsigned* pw = (const unsigned*)pp; constexpr int LW = LD1 / 2;
                if (isctx) { const bool vl = t > 0, vr = t < TC - 1;
                    const u32x4 L = vl ? *(const u32x4*)(pp - LD1) : zz, R = vr ? *(const u32x4*)(pp + LD1) : zz;
                    pre[n][4] = L.x; pre[n][5] = L.y; pre[n][6] = L.z; pre[n][7] = L.w; pre[n][8] = R.x; pre[n][9] = R.y; pre[n][10] = R.z; pre[n][11] = R.w; }
                else { const int x = t & 63, y = t >> 6; const bool vl = x > 0, vr = x < 63, vu = y > 0, vd = y < 31;
                    pre[n][4] = vl ? pw[-LW + 0] : 0u; pre[n][5] = vl ? pw[-LW + 2] : 0u; pre[n][6] = vr ? pw[LW + 0] : 0u; pre[n][7] = vr ? pw[LW + 2] : 0u;
                    pre[n][8] = vu ? pw[-64 * LW + 1] : 0u; pre[n][9] = vu ? pw[-64 * LW + 3] : 0u; pre[n][10] = vd ? pw[64 * LW + 1] : 0u; pre[n][11] = vd ? pw[64 * LW + 3] : 0u; } }
        };
        prefetch(0);
        for (int ch = 0; ch < NCHUNK; ++ch) {
            int qo = tid; asm volatile("" : "+v"(qo));
            const int lane_o = qo & 63, wave_o = qo >> 6;
            const bool isctx = ch < 8;
            const int sbase = isctx ? ch * CH : (ch - 8) * CH, Tlen = isctx ? TC : TL;
            const int rowbase = isctx ? MLAT + b * TC : b * TL;
            const int t0 = d == 0 ? sbase : Tlen - 1 - sbase, sgn = d == 0 ? 1 : -1;
#pragma unroll
            for (int n = 0; n < 3; ++n) { const int s = qo + 512 * n, i = s / 48, cv = s % 48;
                const int col = cv < 8 ? h * 64 + 8 * cv : (cv < 16 ? 1024 + h * 64 + 8 * (cv - 8) : (cv < 24 ? 2048 + h * 64 + 8 * (cv - 16) : (cv < 36 ? 3072 + d * 96 + 8 * (cv - 24) : 3264 + d * 96 + 8 * (cv - 36))));
                const f32x4 m0 = *(const f32x4*)(mu + col), m1 = *(const f32x4*)(mu + col + 4);
                float xs[8];
#pragma unroll
                for (int e = 0; e < 8; ++e) { const float p = __uint_as_float((e & 1) ? (pre[n][e >> 1] & 0xffff0000u) : (pre[n][e >> 1] << 16));
                    unsigned wv_; const bool hi = (e & 1);
                    if (isctx) wv_ = (e & 1) ? pre[n][8 + (e >> 1)] : pre[n][4 + (e >> 1)];
                    else wv_ = pre[n][4 + 2 * (e & 3) + (e >> 2)];
                    const float ps = __uint_as_float(hi ? (wv_ & 0xffff0000u) : (wv_ << 16));
                    xs[e] = p + (ps - p) * (e < 4 ? m0[e & 3] : m1[e & 3]); }
                if (cv < 24) { float* dst = (cv < 8 ? A_wr + i * 64 + 8 * cv : (cv < 16 ? A_kd + i * 64 + 8 * (cv - 8) : A_v + i * 64 + 8 * (cv - 16)));
                    *(f32x4*)dst = (f32x4){xs[0], xs[1], xs[2], xs[3]}; *(f32x4*)(dst + 4) = (f32x4){xs[4], xs[5], xs[6], xs[7]}; }
                else if (cv < 36) { u32x4 w; w.x = pk2(tanhf(xs[0]), tanhf(xs[1])); w.y = pk2(tanhf(xs[2]), tanhf(xs[3])); w.z = pk2(tanhf(xs[4]), tanhf(xs[5])); w.w = pk2(tanhf(xs[6]), tanhf(xs[7]));
                    *(u32x4*)(TH_w + i * 96 + 8 * (cv - 24)) = w; }
                else { u32x4 w; w.x = pk2(xs[0], xs[1]); w.y = pk2(xs[2], xs[3]); w.z = pk2(xs[4], xs[5]); w.w = pk2(xs[6], xs[7]);
                    *(u32x4*)(TH_a + i * 96 + 8 * (cv - 36)) = w; } }
            __syncthreads();
            { const int rt = wave_o >> 2, c = 16 * (wave_o & 3) + (lane_o & 15);
              f32x4 cw = {0.f, 0.f, 0.f, 0.f}, ca = {0.f, 0.f, 0.f, 0.f};
#pragma unroll
              for (int ks = 0; ks < 3; ++ks) { const int off = (rt * 16 + (lane_o & 15)) * 96 + ks * 32 + (lane_o >> 4) * 8;
                  const s16x8 fa = *(const s16x8*)(TH_w + off), fb = *(const s16x8*)(TH_a + off);
                  cw = MFMA16(fa, Bw[ks], cw); ca = MFMA16(fb, Ba[ks], ca); }
#pragma unroll
              for (int j = 0; j < 4; ++j) { const int i = rt * 16 + (lane_o >> 4) * 4 + j;
                  A_w[i * 64 + c] = __expf(-0.6065306597126334f * sigm(w0c + cw[j])); A_bb[i * 64 + c] = sigm(a0c + ca[j]); } }
            __syncthreads();
            if (qo < 256) {
                const int i = qo >> 3, cgp = qo & 7, j0 = 8 * cgp; float xr[8], xk[8], w[8], ic[8], kkw[8], kaw[8], rkw[8];
#pragma unroll
                for (int e = 0; e < 2; ++e) { const f32x4 a = *(const f32x4*)(A_wr + i * 64 + j0 + 4 * e), b2 = *(const f32x4*)(A_kd + i * 64 + j0 + 4 * e), c2 = *(const f32x4*)(A_w + i * 64 + j0 + 4 * e),
                        d2 = *(const f32x4*)(A_bb + i * 64 + j0 + 4 * e), e2 = *(const f32x4*)(PRM + j0 + 4 * e), f2 = *(const f32x4*)(PRM + 64 + j0 + 4 * e), g2 = *(const f32x4*)(PRM + 128 + j0 + 4 * e);
#pragma unroll
                    for (int x = 0; x < 4; ++x) { xr[4 * e + x] = a[x]; xk[4 * e + x] = b2[x]; w[4 * e + x] = c2[x]; ic[4 * e + x] = d2[x]; kkw[4 * e + x] = e2[x]; kaw[4 * e + x] = f2[x]; rkw[4 * e + x] = g2[x]; } }
                float ss = 0.f;
#pragma unroll
                for (int e = 0; e < 8; ++e) { const float kr_ = xk[e] * kkw[e]; ss += kr_ * kr_; }
                ss = red8(ss); const float rn = rsqrtf(ss + 1e-6f);
                float kk[8], kd[8], bb[8], br = 0.f, kr = 0.f, sb = 0.f;
#pragma unroll
                for (int e = 0; e < 8; ++e) { kk[e] = xk[e] * kkw[e] * rn; kd[e] = xk[e] * (1.f + (ic[e] - 1.f) * kaw[e]); bb[e] = kk[e] * ic[e];
                    br += bb[e] * xr[e]; kr += kd[e] * xr[e]; sb += xr[e] * kd[e] * rkw[e]; }
                br = red8(br); kr = red8(kr); sb = 0.5f * red8(sb);
#pragma unroll
                for (int e = 0; e < 2; ++e) {
                    *(f32x4*)(A_kk + i * 64 + j0 + 4 * e) = (f32x4){kk[4 * e], kk[4 * e + 1], kk[4 * e + 2], kk[4 * e + 3]};
                    *(f32x4*)(A_wr + i * 64 + j0 + 4 * e) = (f32x4){w[4 * e] * xr[4 * e], w[4 * e + 1] * xr[4 * e + 1], w[4 * e + 2] * xr[4 * e + 2], w[4 * e + 3] * xr[4 * e + 3]};
                    *(f32x4*)(A_kd + i * 64 + j0 + 4 * e) = (f32x4){kd[4 * e], kd[4 * e + 1], kd[4 * e + 2], kd[4 * e + 3]};
                    *(f32x4*)(A_bb + i * 64 + j0 + 4 * e) = (f32x4){bb[4 * e], bb[4 * e + 1], bb[4 * e + 2], bb[4 * e + 3]}; }
                if (cgp == 0) { SC[i * 4 + 0] = br; SC[i * 4 + 1] = kr; if (!isctx) SBON[((size_t)d * MLAT + rowbase + t0 + sgn * i) * 16 + h] = sb; }
            }
            __syncthreads();
            if (ch + 1 < NCHUNK) prefetch(ch + 1);
            { const int cgp = qo & 7, row = qo >> 3, j0 = 8 * cgp;
              bf16_t* yp = YD + ((size_t)d * MLAT + rowbase + t0) * 1024 + h * 64 + row;
              for (int i = 0; i < CH; ++i) {
                  float kk8[8], wr8[8], w8[8], bb8[8], kd8[8];
#pragma unroll
                  for (int e = 0; e < 2; ++e) { const f32x4 a = *(const f32x4*)(A_kk + i * 64 + j0 + 4 * e), b2 = *(const f32x4*)(A_wr + i * 64 + j0 + 4 * e), c2 = *(const f32x4*)(A_w + i * 64 + j0 + 4 * e),
                          d2 = *(const f32x4*)(A_bb + i * 64 + j0 + 4 * e), e2 = *(const f32x4*)(A_kd + i * 64 + j0 + 4 * e);
#pragma unroll
                      for (int x = 0; x < 4; ++x) { kk8[4 * e + x] = a[x]; wr8[4 * e + x] = b2[x]; w8[4 * e + x] = c2[x]; bb8[4 * e + x] = d2[x]; kd8[4 * e + x] = e2[x]; } }
                  const float v = A_v[i * 64 + row]; const float2 sc = *(const float2*)(SC + i * 4);
                  float sa = 0.f, pp = 0.f;
#pragma unroll
                  for (int j = 0; j < 8; ++j) { sa += S[j] * kk8[j]; pp += S[j] * wr8[j]; }
                  sa = red8(sa); pp = red8(pp);
                  const float y = pp - sa * sc.x + v * sc.y;
#pragma unroll
                  for (int j = 0; j < 8; ++j) S[j] = S[j] * w8[j] - sa * bb8[j] + v * kd8[j];
                  if (!isctx && cgp == 0) yp[(ptrdiff_t)sgn * i * 1024] = f2bf(y);
              } }
            __syncthreads();
        }
    }
}

constexpr int LDK = 136, LDC = 40, LDL = 36;
constexpr int G_RAW = 0, G_CW = 23040, G_SC = 29440, G_UQ = 29952, G_WK = 29952, G_VNT = 38656, G_UK = 46336, G_TM = 46336, G_QKM = 48896, G_LM = 51456, G_UV = 62720,
              G_KA = 70912, G_QA = 79616, G_QD = 88320, G_KGT = 97024, G_KTT = 107520, G_VT = 118016, G_ST = 123264, G_GC = 140672, G_T11T = 140928, G_XT = 141440;
__device__ __forceinline__ void phase_gdn(const Params& P, unsigned char* smem) {
    const int tid = threadIdx.x;
    const bf16_t* P1 = (const bf16_t*)(P.ws + WS_X);
    bf16_t* OD = (bf16_t*)P.out + (size_t)2 * MLAT * 1024;
    bf16_t* RAW = (bf16_t*)(smem + G_RAW); float* CW = (float*)(smem + G_CW); float* GSC = (float*)(smem + G_SC); float* UQ = (float*)(smem + G_UQ); float* UK = (float*)(smem + G_UK); float* UV = (float*)(smem + G_UV);
    bf16_t* WK = (bf16_t*)(smem + G_WK); bf16_t* VNT = (bf16_t*)(smem + G_VNT); bf16_t* TM = (bf16_t*)(smem + G_TM); bf16_t* QKM = (bf16_t*)(smem + G_QKM); float* LM = (float*)(smem + G_LM);
    bf16_t* KA = (bf16_t*)(smem + G_KA); bf16_t* QA = (bf16_t*)(smem + G_QA); bf16_t* QD = (bf16_t*)(smem + G_QD); bf16_t* KGT = (bf16_t*)(smem + G_KGT); bf16_t* KTT = (bf16_t*)(smem + G_KTT);
    bf16_t* VT = (bf16_t*)(smem + G_VT); bf16_t* ST = (bf16_t*)(smem + G_ST); float* GC = (float*)(smem + G_GC);
    for (int it = blockIdx.x; it < 256; it += gridDim.x) {
        const int b = it >> 5, hg = (it >> 2) & 7, d = (it >> 1) & 1, half = it & 1;
        f32x4 sacc[4];
#pragma unroll
        for (int nt = 0; nt < 4; ++nt) sacc[nt] = (f32x4){0.f, 0.f, 0.f, 0.f};
        __syncthreads();
        float cwr[5][8];
        { const int cv = tid % 40; const int ccol = cv < 16 ? hg * 128 + 8 * cv : (cv < 32 ? 1024 + hg * 128 + 8 * (cv - 16) : 2048 + hg * 128 + half * 64 + 8 * (cv - 32));
#pragma unroll
          for (int j = 0; j < 5; ++j) { const f32x4 c0 = *(const f32x4*)(P.in[19] + j * 3072 + ccol), c1 = *(const f32x4*)(P.in[19] + j * 3072 + ccol + 4);
#pragma unroll
              for (int x = 0; x < 4; ++x) { cwr[j][x] = c0[x]; cwr[j][4 + x] = c1[x]; } } }
        for (int e = tid; e < 64 * LDK / 2; e += 512) ((unsigned*)ST)[e] = 0u;
        const float alog = -__expf(P.in[20][d * 8 + hg]), dtb = P.in[21][d * 8 + hg];
        unsigned pre[3][4]; unsigned pab = 0;
        auto prefetch = [&](int ch) {
            const bool isctx = ch < 8;
            const int sbase = isctx ? ch * CH : (ch - 8) * CH, Tlen = isctx ? TC : TL;
            const int rowbase = isctx ? MLAT + b * TC : b * TL;
            const int t0 = d == 0 ? sbase : Tlen - 1 - sbase, sgn = d == 0 ? 1 : -1;
            const int lo = d == 0 ? sbase : Tlen - sbase - CH;
            const u32x4 zz = {0u, 0u, 0u, 0u};
            int qv = tid; asm volatile("" : "+v"(qv));
#pragma unroll
            for (int n = 0; n < 3; ++n) { const int s = qv + 512 * n, wt = s / 40, cv = s % 40; const int t = lo - 2 + wt;
                const int col = COL_CV + (cv < 16 ? hg * 128 + 8 * cv : (cv < 32 ? 1024 + hg * 128 + 8 * (cv - 16) : 2048 + hg * 128 + half * 64 + 8 * (cv - 32)));
                const u32x4 gv_ = (s < 1440 && t >= 0 && t < Tlen) ? *(const u32x4*)(P1 + (size_t)(rowbase + t) * LD1 + col) : zz; pre[n][0] = gv_.x; pre[n][1] = gv_.y; pre[n][2] = gv_.z; pre[n][3] = gv_.w; }
            if (qv < CH) { const int t = t0 + sgn * qv; const bf16_t* ro = P1 + (size_t)(rowbase + t) * LD1 + COL_AB;
                pab = (unsigned)ro[d * 8 + hg] | ((unsigned)ro[16 + d * 8 + hg] << 16); }
        };
        auto consumeA = [&]() {
            int qa = tid; asm volatile("" : "+v"(qa));
#pragma unroll
            for (int n = 0; n < 3; ++n) { const int s = qa + 512 * n; if (s < 1440) *(u32x4*)(RAW + s * 8) = (u32x4){pre[n][0], pre[n][1], pre[n][2], pre[n][3]}; }
            if (qa < CH) { const float a_raw = __uint_as_float(pab << 16), b_raw = __uint_as_float(pab & 0xffff0000u);
                const float xx = a_raw + dtb; const float sp = xx > 20.f ? xx : __logf(1.f + __expf(xx));
                GSC[qa * 4 + 0] = alog * sp; GSC[qa * 4 + 1] = sigm(b_raw); }
        };
        prefetch(0);
        consumeA();
        __syncthreads();
        for (int ch = 0; ch < NCHUNK; ++ch) {
            int qo = tid; asm volatile("" : "+v"(qo));
            const int lane = qo & 63, wave = qo >> 6, fr = lane & 15, fq = lane >> 4;
            const bool isctx = ch < 8;
            const int sbase = isctx ? ch * CH : (ch - 8) * CH, Tlen = isctx ? TC : TL;
            const int rowbase = isctx ? MLAT + b * TC : b * TL;
            const int t0 = d == 0 ? sbase : Tlen - 1 - sbase, sgn = d == 0 ? 1 : -1;
            if (ch + 1 < NCHUNK) prefetch(ch + 1);
            if (qo < 480) { const int cv = qo % 40, tg = qo / 40; const int ntok = tg < 8 ? 3 : 2, tok0 = tg < 8 ? 3 * tg : 24 + 2 * (tg - 8);
                u32x4 raw[7];
#pragma unroll
                for (int r = 0; r < 7; ++r) { const int rr = tok0 + r < 36 ? tok0 + r : 35; raw[r] = *(const u32x4*)(RAW + rr * 320 + 8 * cv); }
#pragma unroll
                for (int o = 0; o < 3; ++o) if (o < ntok) { float acc[8];
#pragma unroll
                    for (int e = 0; e < 8; ++e) { float a_ = 0.f;
#pragma unroll
                        for (int j = 0; j < 5; ++j) { const unsigned w_ = raw[o + j][e >> 1]; a_ += cwr[j][e] * __uint_as_float((e & 1) ? (w_ & 0xffff0000u) : (w_ << 16)); }
                        acc[e] = a_ * sigm(a_); }
                    const int wt_ = tok0 + o, i = (d == 0 ? wt_ : CH - 1 - wt_);
                    float* dst = cv < 16 ? UQ + i * 128 + 8 * cv : (cv < 32 ? UK + i * 128 + 8 * (cv - 16) : UV + i * 64 + 8 * (cv - 32));
                    *(f32x4*)dst = (f32x4){acc[0], acc[1], acc[2], acc[3]}; *(f32x4*)(dst + 4) = (f32x4){acc[4], acc[5], acc[6], acc[7]}; } }
            if (wave == 7) { float g = lane < CH ? GSC[lane * 4] : 0.f;
#pragma unroll
                for (int o = 1; o < 32; o <<= 1) { const float t = __shfl_up(g, o); if (lane >= o) g += t; }
                if (lane < CH) GC[lane] = g; }
            __syncthreads();
            { const int i = qo >> 4, cg = qo & 15, j0 = 8 * cg;
              float qv8[8], kv8[8];
#pragma unroll
              for (int e = 0; e < 2; ++e) { const f32x4 a = *(const f32x4*)(UQ + i * 128 + j0 + 4 * e), b2 = *(const f32x4*)(UK + i * 128 + j0 + 4 * e);
#pragma unroll
                  for (int x = 0; x < 4; ++x) { qv8[4 * e + x] = a[x]; kv8[4 * e + x] = b2[x]; } }
              float sq = 0.f, sk = 0.f;
#pragma unroll
              for (int e = 0; e < 8; ++e) { sq += qv8[e] * qv8[e]; sk += kv8[e] * kv8[e]; }
              sq = red16(sq); sk = red16(sk);
              const float rq = rsqrtf(sq + 1e-6f) * 0.08838834764831845f, rk = rsqrtf(sk + 1e-6f);
              const float gci = GC[i], gcl = GC[CH - 1], beta = GSC[i * 4 + 1];
              const float eg = __expf(gci), et = __expf(gcl - gci), bg = beta * eg;
              float vv[8];
              if (cg < 8) { const f32x4 a = *(const f32x4*)(UV + i * 64 + j0), b2 = *(const f32x4*)(UV + i * 64 + j0 + 4);
#pragma unroll
                  for (int x = 0; x < 4; ++x) { vv[x] = a[x]; vv[4 + x] = b2[x]; } }
#pragma unroll
              for (int e = 0; e < 8; ++e) { qv8[e] *= rq; kv8[e] *= rk; }
              u32x4 w;
              w.x = pk2(kv8[0], kv8[1]); w.y = pk2(kv8[2], kv8[3]); w.z = pk2(kv8[4], kv8[5]); w.w = pk2(kv8[6], kv8[7]); *(u32x4*)(KA + i * LDK + j0) = w;
              w.x = pk2(qv8[0], qv8[1]); w.y = pk2(qv8[2], qv8[3]); w.z = pk2(qv8[4], qv8[5]); w.w = pk2(qv8[6], qv8[7]); *(u32x4*)(QA + i * LDK + j0) = w;
              w.x = pk2(qv8[0] * eg, qv8[1] * eg); w.y = pk2(qv8[2] * eg, qv8[3] * eg); w.z = pk2(qv8[4] * eg, qv8[5] * eg); w.w = pk2(qv8[6] * eg, qv8[7] * eg); *(u32x4*)(QD + i * LDK + j0) = w;
#pragma unroll
              for (int e = 0; e < 8; ++e) { KGT[TROW(j0 + e) + i] = f2bf(kv8[e] * bg); KTT[TROW(j0 + e) + i] = f2bf(kv8[e] * et); }
              if (cg < 8) {
#pragma unroll
                  for (int e = 0; e < 8; ++e) VT[TROW(j0 + e) + i] = f2bf(vv[e] * beta); } }
            __syncthreads();
            { const int mt = (wave >> 1) & 1, nt = wave & 1; const bf16_t* Am = wave < 4 ? KA : QA;
              f32x4 acc = {0.f, 0.f, 0.f, 0.f};
#pragma unroll
              for (int ks = 0; ks < 4; ++ks) { const s16x8 a = *(const s16x8*)(KA + (nt * 16 + fr) * LDK + ks * 32 + fq * 8), bb = *(const s16x8*)(Am + (mt * 16 + fr) * LDK + ks * 32 + fq * 8);
                  acc = MFMA16(a, bb, acc); }
              const int i = mt * 16 + fr; const float gci = GC[i], bi = GSC[i * 4 + 1];
              const f32x4 gcj = *(const f32x4*)(GC + nt * 16 + fq * 4);
              float lv[4];
#pragma unroll
              for (int r = 0; r < 4; ++r) { const int j = nt * 16 + fq * 4 + r; const float dec = __expf(fminf(gci - gcj[r], 0.f));
                  lv[r] = wave < 4 ? ((i > j) ? bi * acc[r] * dec : 0.f) : ((i >= j) ? acc[r] * dec : 0.f); }
              if (wave < 4) *(f32x4*)(LM + i * LDL + nt * 16 + fq * 4) = (f32x4){lv[0], lv[1], lv[2], lv[3]};
              else { uint2 o; o.x = pk2(lv[0], lv[1]); o.y = pk2(lv[2], lv[3]); *(uint2*)(QKM + i * LDC + nt * 16 + fq * 4) = o; } }
            if (wave == 0 || wave == 3) { asm volatile("s_waitcnt lgkmcnt(0)" ::: "memory"); tri_inv_part1(LM, TM, (bf16_t*)(smem + G_T11T), wave == 0 ? 0 : 1, lane); }
            __syncthreads();
            if (wave == 0) tri_inv_part2(LM, TM, (const bf16_t*)(smem + G_T11T), (bf16_t*)(smem + G_XT), lane);
            __syncthreads();
            const int mtu = wave >> 2, ntu = wave & 3;
            f32x4 vacc;
            { const s16x8 a = *(const s16x8*)(TM + (mtu * 16 + fr) * LDC + fq * 8), bb = *(const s16x8*)(VT + TROW(ntu * 16 + fr) + fq * 8);
              vacc = MFMA16(a, bb, ((f32x4){0.f, 0.f, 0.f, 0.f}));
#pragma unroll
              for (int x = 0; x < 2; ++x) { const int tt = 2 * wave + x, mtk = tt >> 1, ntk = tt & 1;
                  const s16x8 a2 = *(const s16x8*)(KGT + TROW(mtk * 16 + fr) + fq * 8), b2 = *(const s16x8*)(TM + (ntk * 16 + fr) * LDC + fq * 8);
                  const f32x4 r = MFMA16(a2, b2, ((f32x4){0.f, 0.f, 0.f, 0.f}));
                  uint2 o; o.x = pk2(-r[0], -r[1]); o.y = pk2(-r[2], -r[3]);
                  *(uint2*)(WK + (ntk * 16 + fr) * LDK + mtk * 16 + fq * 4) = o; } }
            __syncthreads();
            f32x4 oacc = {0.f, 0.f, 0.f, 0.f};
#pragma unroll
            for (int ks = 0; ks < 4; ++ks) { const s16x8 bs = *(const s16x8*)(ST + (ntu * 16 + fr) * LDK + ks * 32 + fq * 8);
                const s16x8 aw = *(const s16x8*)(WK + (mtu * 16 + fr) * LDK + ks * 32 + fq * 8), aq = *(const s16x8*)(QD + (mtu * 16 + fr) * LDK + ks * 32 + fq * 8);
                vacc = MFMA16(aw, bs, vacc); oacc = MFMA16(aq, bs, oacc); }
            { uint2 o; o.x = pk2(vacc[0], vacc[1]); o.y = pk2(vacc[2], vacc[3]); *(uint2*)(VNT + (ntu * 16 + fr) * LDC + mtu * 16 + fq * 4) = o; }
            __syncthreads();
            { const s16x8 a = *(const s16x8*)(QKM + (mtu * 16 + fr) * LDC + fq * 8), bb = *(const s16x8*)(VNT + (ntu * 16 + fr) * LDC + fq * 8);
              oacc = MFMA16(a, bb, oacc);
              if (!isctx) { bf16_t* op = OD + ((size_t)d * MLAT + rowbase + t0) * 1024 + hg * 128 + half * 64 + ntu * 16 + fr;
#pragma unroll
                  for (int r = 0; r < 4; ++r) op[(ptrdiff_t)sgn * (mtu * 16 + fq * 4 + r) * 1024] = f2bf(oacc[r]); }
              const float gl = __expf(GC[CH - 1]);
              const s16x8 ak = *(const s16x8*)(KTT + TROW(wave * 16 + fr) + fq * 8);
#pragma unroll
              for (int nt = 0; nt < 4; ++nt) { const s16x8 bv = *(const s16x8*)(VNT + (nt * 16 + fr) * LDC + fq * 8);
                  sacc[nt] = MFMA16(ak, bv, sacc[nt] * gl);
                  uint2 o; o.x = pk2(sacc[nt][0], sacc[nt][1]); o.y = pk2(sacc[nt][2], sacc[nt][3]);
                  *(uint2*)(ST + (nt * 16 + fr) * LDK + wave * 16 + fq * 4) = o; } }
            if (ch + 1 < NCHUNK) consumeA();
            __syncthreads();
        }
    }
}

constexpr int LK2 = 72;
constexpr int R_WR = 0, R_KD = 8192, R_W = 16384, R_BB = 24576, R_LM = 0, R_TM = 4608, R_AKM = 7168, R_RKM = 9728, R_RBM = 12288, R_WM = 14848, R_X1T = 19456, R_NUT = 24576,
              R_V = 32768, R_THW = 40960, R_THA = 47104, R_GAM = 53248, R_PRM = 61440, R_AT = 62464, R_RT = 67072, R_KT = 71680, R_BT = 76288,
              R_ATT = 80896, R_KTT = 86144, R_BTT = 91392, R_VT = 96640, R_ST = 101888, R_T11T = 111104, R_XT = 111616;
__device__ __forceinline__ void phase_rwkv_chunked(const Params& P, unsigned char* smem) {
    const int tid = threadIdx.x;
    const bf16_t* P1 = (const bf16_t*)(P.ws + WS_X);
    bf16_t* YD = (bf16_t*)P.out;
    float* SBON = (float*)(P.ws + WS_M + MiB);
    float* A_wr = (float*)(smem + R_WR); float* A_kd = (float*)(smem + R_KD); float* A_w = (float*)(smem + R_W); float* A_bb = (float*)(smem + R_BB); float* A_v = (float*)(smem + R_V);
    bf16_t* TH_w = (bf16_t*)(smem + R_THW); bf16_t* TH_a = (bf16_t*)(smem + R_THA); float* GAM = (float*)(smem + R_GAM); float* PRM = (float*)(smem + R_PRM);
    float* LM = (float*)(smem + R_LM); bf16_t* TM = (bf16_t*)(smem + R_TM); bf16_t* AKM = (bf16_t*)(smem + R_AKM); bf16_t* RKM = (bf16_t*)(smem + R_RKM); bf16_t* RBM = (bf16_t*)(smem + R_RBM);
    bf16_t* WM = (bf16_t*)(smem + R_WM); bf16_t* X1T = (bf16_t*)(smem + R_X1T); bf16_t* NUT = (bf16_t*)(smem + R_NUT);
    bf16_t* AT = (bf16_t*)(smem + R_AT); bf16_t* RT = (bf16_t*)(smem + R_RT); bf16_t* KT = (bf16_t*)(smem + R_KT); bf16_t* BT = (bf16_t*)(smem + R_BT);
    bf16_t* ATT = (bf16_t*)(smem + R_ATT); bf16_t* KTT = (bf16_t*)(smem + R_KTT); bf16_t* BTT = (bf16_t*)(smem + R_BTT); bf16_t* VT = (bf16_t*)(smem + R_VT); bf16_t* ST = (bf16_t*)(smem + R_ST);
    const float* mu = P.in[8];
    for (int it = blockIdx.x; it < 256; it += gridDim.x) {
        const int b = it >> 5, h = (it >> 1) & 15, d = it & 1;
        f32x4 sacc[2];
        sacc[0] = (f32x4){0.f, 0.f, 0.f, 0.f}; sacc[1] = (f32x4){0.f, 0.f, 0.f, 0.f};
        s16x8 Bw[3], Ba[3];
        __syncthreads();
        { const int lane = tid & 63, wave = tid >> 6; const int cB = h * 64 + 16 * (wave & 3) + (lane & 15);
#pragma unroll
          for (int ks = 0; ks < 3; ++ks)
#pragma unroll
            for (int j = 0; j < 8; ++j) { const int k = ks * 32 + (lane >> 4) * 8 + j;
                Bw[ks][j] = (short)f2bf(P.in[10][((size_t)d * 96 + k) * 1024 + cB]); Ba[ks][j] = (short)f2bf(P.in[12][((size_t)d * 96 + k) * 1024 + cB]); }
          if (tid < 64) { PRM[tid] = P.in[14][h * 64 + tid]; PRM[64 + tid] = P.in[15][h * 64 + tid]; PRM[128 + tid] = P.in[16][h * 64 + tid]; }
          for (int e = tid; e < 64 * LK2 / 2; e += 512) ((unsigned*)ST)[e] = 0u; }
        const float w0c = P.in[9][d * 1024 + h * 64 + 16 * ((tid >> 6) & 3) + (tid & 15)], a0c = P.in[11][d * 1024 + h * 64 + 16 * ((tid >> 6) & 3) + (tid & 15)];
        unsigned pre[3][12];
        auto prefetch = [&](int ch) {
            const bool isctx = ch < 8;
            const int sbase = isctx ? ch * CH : (ch - 8) * CH, Tlen = isctx ? TC : TL;
            const int rowbase = isctx ? MLAT + b * TC : b * TL;
            const int t0 = d == 0 ? sbase : Tlen - 1 - sbase, sgn = d == 0 ? 1 : -1;
            const u32x4 zz = {0u, 0u, 0u, 0u};
            int qv = tid; asm volatile("" : "+v"(qv));
#pragma unroll
            for (int n = 0; n < 3; ++n) { const int ws = n * 8 + (qv >> 6), ln_ = qv & 63; const int L_ = (ws < 12 ? ws : (ws < 18 ? ws - 12 : ws - 18)) * 64 + ln_;
                const int i = ws < 12 ? L_ / 24 : L_ / 12, cv = ws < 12 ? L_ % 24 : (ws < 18 ? 24 + L_ % 12 : 36 + L_ % 12); const int t = t0 + sgn * i;
                const int col = cv < 8 ? h * 64 + 8 * cv : (cv < 16 ? 1024 + h * 64 + 8 * (cv - 8) : (cv < 24 ? 2048 + h * 64 + 8 * (cv - 16) : (cv < 36 ? 3072 + d * 96 + 8 * (cv - 24) : 3264 + d * 96 + 8 * (cv - 36))));
                const bf16_t* pp = P1 + (size_t)(rowbase + t) * LD1 + col;
                { const u32x4 pv_ = *(const u32x4*)pp; pre[n][0] = pv_.x; pre[n][1] = pv_.y; pre[n][2] = pv_.z; pre[n][3] = pv_.w; }
                const unsigned* pw = (const unsigned*)pp; constexpr int LW = LD1 / 2;
                if (isctx) { const bool vl = t > 0, vr = t < TC - 1;
                    const u32x4 L = vl ? *(const u32x4*)(pp - LD1) : zz, R = vr ? *(const u32x4*)(pp + LD1) : zz;
                    pre[n][4] = L.x; pre[n][5] = L.y; pre[n][6] = L.z; pre[n][7] = L.w; pre[n][8] = R.x; pre[n][9] = R.y; pre[n][10] = R.z; pre[n][11] = R.w; }
                else { const int x = t & 63, y = t >> 6; const bool vl = x > 0, vr = x < 63, vu = y > 0, vd = y < 31;
                    pre[n][4] = vl ? pw[-LW + 0] : 0u; pre[n][5] = vl ? pw[-LW + 2] : 0u; pre[n][6] = vr ? pw[LW + 0] : 0u; pre[n][7] = vr ? pw[LW + 2] : 0u;
                    pre[n][8] = vu ? pw[-64 * LW + 1] : 0u; pre[n][9] = vu ? pw[-64 * LW + 3] : 0u; pre[n][10] = vd ? pw[64 * LW + 1] : 0u; pre[n][11] = vd ? pw[64 * LW + 3] : 0u; } }
        };
        prefetch(0);
        for (int ch = 0; ch < NCHUNK; ++ch) {
            int qo = tid; asm volatile("" : "+v"(qo));
            const int lane = qo & 63, wave = qo >> 6, fr = lane & 15, fq = lane >> 4;
            const bool isctx = ch < 8;
            const int sbase = isctx ? ch * CH : (ch - 8) * CH, Tlen = isctx ? TC : TL;
            const int rowbase = isctx ? MLAT + b * TC : b * TL;
            const int t0 = d == 0 ? sbase : Tlen - 1 - sbase, sgn = d == 0 ? 1 : -1;
#pragma unroll
            for (int n = 0; n < 3; ++n) { const int ws = n * 8 + wave; const int L_ = (ws < 12 ? ws : (ws < 18 ? ws - 12 : ws - 18)) * 64 + lane;
                const int i = ws < 12 ? L_ / 24 : L_ / 12, cv = ws < 12 ? L_ % 24 : (ws < 18 ? 24 + L_ % 12 : 36 + L_ % 12);
                const int col = cv < 8 ? h * 64 + 8 * cv : (cv < 16 ? 1024 + h * 64 + 8 * (cv - 8) : (cv < 24 ? 2048 + h * 64 + 8 * (cv - 16) : (cv < 36 ? 3072 + d * 96 + 8 * (cv - 24) : 3264 + d * 96 + 8 * (cv - 36))));
                const f32x4 m0 = *(const f32x4*)(mu + col), m1 = *(const f32x4*)(mu + col + 4);
                float xs[8];
#pragma unroll
                for (int e = 0; e < 8; ++e) { const float p = __uint_as_float((e & 1) ? (pre[n][e >> 1] & 0xffff0000u) : (pre[n][e >> 1] << 16));
                    unsigned wv_; const bool hi = (e & 1);
                    if (isctx) wv_ = (e & 1) ? pre[n][8 + (e >> 1)] : pre[n][4 + (e >> 1)];
                    else wv_ = pre[n][4 + 2 * (e & 3) + (e >> 2)];
                    const float ps = __uint_as_float(hi ? (wv_ & 0xffff0000u) : (wv_ << 16));
                    xs[e] = p + (ps - p) * (e < 4 ? m0[e & 3] : m1[e & 3]); }
                if (cv < 24) { float* dst = (cv < 8 ? A_wr + i * 64 + 8 * cv : (cv < 16 ? A_kd + i * 64 + 8 * (cv - 8) : A_v + i * 64 + 8 * (cv - 16)));
                    *(f32x4*)dst = (f32x4){xs[0], xs[1], xs[2], xs[3]}; *(f32x4*)(dst + 4) = (f32x4){xs[4], xs[5], xs[6], xs[7]}; }
                else if (cv < 36) { u32x4 w; w.x = pk2(tanh_fast(xs[0]), tanh_fast(xs[1])); w.y = pk2(tanh_fast(xs[2]), tanh_fast(xs[3])); w.z = pk2(tanh_fast(xs[4]), tanh_fast(xs[5])); w.w = pk2(tanh_fast(xs[6]), tanh_fast(xs[7]));
                    *(u32x4*)(TH_w + i * 96 + 8 * (cv - 24)) = w; }
                else { u32x4 w; w.x = pk2(xs[0], xs[1]); w.y = pk2(xs[2], xs[3]); w.z = pk2(xs[4], xs[5]); w.w = pk2(xs[6], xs[7]);
                    *(u32x4*)(TH_a + i * 96 + 8 * (cv - 36)) = w; } }
            __syncthreads();
            if (ch + 1 < NCHUNK) prefetch(ch + 1);
            if (wave < 4) { const int c = 16 * wave + fr;
              float wv[2][4];
#pragma unroll
              for (int rt = 0; rt < 2; ++rt) { f32x4 cw = {0.f, 0.f, 0.f, 0.f}, ca = {0.f, 0.f, 0.f, 0.f};
#pragma unroll
                  for (int ks = 0; ks < 3; ++ks) { const int off = (rt * 16 + fr) * 96 + ks * 32 + fq * 8;
                      const s16x8 fa = *(const s16x8*)(TH_w + off), fb = *(const s16x8*)(TH_a + off);
                      cw = MFMA16(fa, Bw[ks], cw); ca = MFMA16(fb, Ba[ks], ca); }
#pragma unroll
                  for (int j = 0; j < 4; ++j) { const int i = rt * 16 + fq * 4 + j;
                      wv[rt][j] = __expf(-0.6065306597126334f * sigm(w0c + cw[j])); A_bb[i * 64 + c] = sigm(a0c + ca[j]); } }
              float tot[2];
#pragma unroll
              for (int rt = 0; rt < 2; ++rt) { wv[rt][1] *= wv[rt][0]; wv[rt][2] *= wv[rt][1]; wv[rt][3] *= wv[rt][2];
                  float sx = wv[rt][3]; float u1 = __shfl_up(sx, 16); if (fq >= 1) sx *= u1; float u2 = __shfl_up(sx, 32); if (fq >= 2) sx *= u2;
                  float ex = __shfl_up(sx, 16); if (fq == 0) ex = 1.f;
                  tot[rt] = __shfl(sx, 48 + fr);
                  const float base = ex * (rt == 1 ? tot[0] : 1.f);
#pragma unroll
                  for (int j = 0; j < 4; ++j) GAM[(rt * 16 + fq * 4 + j) * 64 + c] = base * wv[rt][j]; } }
            __syncthreads();
            { const int i = qo >> 4, cg = qo & 15, j0 = 4 * cg;
              const f32x4 xr = *(const f32x4*)(A_wr + i * 64 + j0), xk = *(const f32x4*)(A_kd + i * 64 + j0), ic = *(const f32x4*)(A_bb + i * 64 + j0), xv = *(const f32x4*)(A_v + i * 64 + j0);
              const f32x4 kkw = *(const f32x4*)(PRM + j0), kaw = *(const f32x4*)(PRM + 64 + j0), rkw = *(const f32x4*)(PRM + 128 + j0);
              const f32x4 gi = *(const f32x4*)(GAM + i * 64 + j0), gl = *(const f32x4*)(GAM + 31 * 64 + j0);
              f32x4 gp = {1.f, 1.f, 1.f, 1.f}; if (i > 0) gp = *(const f32x4*)(GAM + (i - 1) * 64 + j0);
              const f32x4 kkr = xk * kkw;
              const float ss = red16(kkr[0] * kkr[0] + kkr[1] * kkr[1] + kkr[2] * kkr[2] + kkr[3] * kkr[3]);
              const f32x4 kk = kkr * rsqrtf(ss + 1e-6f);
              f32x4 kd, bb, at, rt_, kt, bt, ktl, btl; float sbp = 0.f;
#pragma unroll
              for (int e = 0; e < 4; ++e) { kd[e] = xk[e] * (1.f + (ic[e] - 1.f) * kaw[e]); bb[e] = kk[e] * ic[e]; sbp += xr[e] * kd[e] * rkw[e];
                  const float ig = __builtin_amdgcn_rcpf(gi[e]); at[e] = kk[e] * gp[e]; rt_[e] = xr[e] * gi[e]; kt[e] = kd[e] * ig; bt[e] = bb[e] * ig; ktl[e] = kt[e] * gl[e]; btl[e] = bt[e] * gl[e]; }
              const float sb = 0.5f * red16(sbp);
              if (cg == 0 && !isctx) SBON[((size_t)d * MLAT + rowbase + t0 + sgn * i) * 16 + h] = sb;
              uint2 o;
              o.x = pk2(at[0], at[1]); o.y = pk2(at[2], at[3]); *(uint2*)(AT + i * LK2 + j0) = o;
              o.x = pk2(rt_[0], rt_[1]); o.y = pk2(rt_[2], rt_[3]); *(uint2*)(RT + i * LK2 + j0) = o;
              o.x = pk2(kt[0], kt[1]); o.y = pk2(kt[2], kt[3]); *(uint2*)(KT + i * LK2 + j0) = o;
              o.x = pk2(bt[0], bt[1]); o.y = pk2(bt[2], bt[3]); *(uint2*)(BT + i * LK2 + j0) = o;
#pragma unroll
              for (int e = 0; e < 4; ++e) { ATT[TROW(j0 + e) + i] = f2bf(at[e]); KTT[TROW(j0 + e) + i] = f2bf(ktl[e]); BTT[TROW(j0 + e) + i] = f2bf(btl[e]); VT[TROW(j0 + e) + i] = f2bf(xv[e]); } }
            __syncthreads();
#pragma unroll
            for (int x = 0; x < 2; ++x) { const int t = 2 * wave + x, m = t >> 2, mt = (t >> 1) & 1, nt = t & 1;
                const bf16_t* Am = m < 2 ? AT : RT; const bf16_t* Bm = (m == 0 || m == 3) ? BT : KT;
                f32x4 acc = {0.f, 0.f, 0.f, 0.f};
#pragma unroll
                for (int ks = 0; ks < 2; ++ks) { const s16x8 a = *(const s16x8*)(Bm + (nt * 16 + fr) * LK2 + ks * 32 + fq * 8), bb2 = *(const s16x8*)(Am + (mt * 16 + fr) * LK2 + ks * 32 + fq * 8);
                    acc = MFMA16(a, bb2, acc); }
                const int i = mt * 16 + fr; float lv[4];
#pragma unroll
                for (int r = 0; r < 4; ++r) { const int j = nt * 16 + fq * 4 + r; lv[r] = (m < 2 ? (i > j) : (i >= j)) ? acc[r] : 0.f; }
                if (m == 0) *(f32x4*)(LM + i * LDL + nt * 16 + fq * 4) = (f32x4){lv[0], lv[1], lv[2], lv[3]};
                else { bf16_t* dstm = m == 1 ? AKM : (m == 2 ? RKM : RBM); uint2 o; o.x = pk2(lv[0], lv[1]); o.y = pk2(lv[2], lv[3]); *(uint2*)(dstm + i * LDC + nt * 16 + fq * 4) = o; } }
            if (wave < 2) { asm volatile("s_waitcnt lgkmcnt(0)" ::: "memory"); tri_inv_part1(LM, TM, (bf16_t*)(smem + R_T11T), wave, lane); }
            __syncthreads();
            if (wave == 0) tri_inv_part2(LM, TM, (const bf16_t*)(smem + R_T11T), (bf16_t*)(smem + R_XT), lane);
            else {
                const int ntile = (wave == 1) ? 2 : 1;
                for (int q2 = 0; q2 < ntile; ++q2) { const int tl = (q2 == 0) ? wave : 0; const int mt = tl >> 2, nt = tl & 3;
                    const s16x8 a = *(const s16x8*)(AKM + (mt * 16 + fr) * LDC + fq * 8), bb2 = *(const s16x8*)(VT + TROW(nt * 16 + fr) + fq * 8);
                    const f32x4 r = MFMA16(a, bb2, ((f32x4){0.f, 0.f, 0.f, 0.f}));
                    uint2 o; o.x = pk2(r[0], r[1]); o.y = pk2(r[2], r[3]); *(uint2*)(X1T + (nt * 16 + fr) * LDC + mt * 16 + fq * 4) = o; }
            }
            __syncthreads();
            const int mtu = wave >> 2, ntu = wave & 3;
            f32x4 uacc;
            { const s16x8 a = *(const s16x8*)(TM + (mtu * 16 + fr) * LDC + fq * 8), bb2 = *(const s16x8*)(X1T + (ntu * 16 + fr) * LDC + fq * 8);
              uacc = MFMA16(a, bb2, ((f32x4){0.f, 0.f, 0.f, 0.f}));
              const int kt_ = wave >> 1, it_ = wave & 1;
              const s16x8 a2 = *(const s16x8*)(ATT + TROW(kt_ * 16 + fr) + fq * 8), b2 = *(const s16x8*)(TM + (it_ * 16 + fr) * LDC + fq * 8);
              const f32x4 r = MFMA16(a2, b2, ((f32x4){0.f, 0.f, 0.f, 0.f}));
              uint2 o; o.x = pk2(r[0], r[1]); o.y = pk2(r[2], r[3]); *(uint2*)(WM + (it_ * 16 + fr) * LK2 + kt_ * 16 + fq * 4) = o; }
            __syncthreads();
            f32x4 yacc = {0.f, 0.f, 0.f, 0.f};
#pragma unroll
            for (int ks = 0; ks < 2; ++ks) { const s16x8 bs = *(const s16x8*)(ST + (ntu * 16 + fr) * LK2 + ks * 32 + fq * 8);
                const s16x8 aw = *(const s16x8*)(WM + (mtu * 16 + fr) * LK2 + ks * 32 + fq * 8), ar = *(const s16x8*)(RT + (mtu * 16 + fr) * LK2 + ks * 32 + fq * 8);
                uacc = MFMA16(aw, bs, uacc); yacc = MFMA16(ar, bs, yacc); }
            { const s16x8 a = *(const s16x8*)(RKM + (mtu * 16 + fr) * LDC + fq * 8), bb2 = *(const s16x8*)(VT + TROW(ntu * 16 + fr) + fq * 8);
              yacc = MFMA16(a, bb2, yacc);
              uint2 o; o.x = pk2(-uacc[0], -uacc[1]); o.y = pk2(-uacc[2], -uacc[3]); *(uint2*)(NUT + (ntu * 16 + fr) * LDC + mtu * 16 + fq * 4) = o; }
            __syncthreads();
            { const s16x8 a = *(const s16x8*)(RBM + (mtu * 16 + fr) * LDC + fq * 8), bb2 = *(const s16x8*)(NUT + (ntu * 16 + fr) * LDC + fq * 8);
              yacc = MFMA16(a, bb2, yacc);
              if (!isctx) { bf16_t* yp = YD + ((size_t)d * MLAT + rowbase + t0) * 1024 + h * 64 + ntu * 16 + fr;
#pragma unroll
                  for (int r = 0; r < 4; ++r) yp[(ptrdiff_t)sgn * (mtu * 16 + fq * 4 + r) * 1024] = f2bf(yacc[r]); }
              const int kt_ = wave >> 1;
              const f32x4 gl = *(const f32x4*)(GAM + 31 * 64 + kt_ * 16 + fq * 4);
              const s16x8 ak = *(const s16x8*)(KTT + TROW(kt_ * 16 + fr) + fq * 8), ab = *(const s16x8*)(BTT + TROW(kt_ * 16 + fr) + fq * 8);
#pragma unroll
              for (int x = 0; x < 2; ++x) { const int vt = 2 * (wave & 1) + x;
                  const s16x8 bv = *(const s16x8*)(VT + TROW(vt * 16 + fr) + fq * 8), bu = *(const s16x8*)(NUT + (vt * 16 + fr) * LDC + fq * 8);
                  sacc[x] = MFMA16(ak, bv, sacc[x] * gl); sacc[x] = MFMA16(ab, bu, sacc[x]);
                  uint2 o; o.x = pk2(sacc[x][0], sacc[x][1]); o.y = pk2(sacc[x][2], sacc[x][3]);
                  *(uint2*)(ST + (vt * 16 + fr) * LK2 + kt_ * 16 + fq * 4) = o; } }
            __syncthreads();
        }
    }
}


__device__ __forceinline__ void mix8_lat(const bf16_t* P1, int row, int col0, const float* mu, float (&xs)[8]) {
    const int t = row & (TL - 1), x = t & 63, y = t >> 6; const bool vl = x > 0, vr = x < 63, vu = y > 0, vd = y < 31;
    const bf16_t* pp = P1 + (size_t)row * LD1 + col0; const unsigned* pw = (const unsigned*)pp; constexpr int LW = LD1 / 2;
    const u32x4 pv = *(const u32x4*)pp;
    unsigned nb[8];
    nb[0] = vl ? pw[-LW + 0] : 0u; nb[1] = vl ? pw[-LW + 2] : 0u; nb[2] = vr ? pw[LW + 0] : 0u; nb[3] = vr ? pw[LW + 2] : 0u;
    nb[4] = vu ? pw[-64 * LW + 1] : 0u; nb[5] = vu ? pw[-64 * LW + 3] : 0u; nb[6] = vd ? pw[64 * LW + 1] : 0u; nb[7] = vd ? pw[64 * LW + 3] : 0u;
    const f32x4 m0 = *(const f32x4*)(mu + col0), m1 = *(const f32x4*)(mu + col0 + 4);
#pragma unroll
    for (int e = 0; e < 8; ++e) { const float p = __uint_as_float((e & 1) ? (pv[e >> 1] & 0xffff0000u) : (pv[e >> 1] << 16));
        const unsigned w_ = nb[2 * (e & 3) + (e >> 2)]; const float ps = __uint_as_float((e & 1) ? (w_ & 0xffff0000u) : (w_ << 16));
        xs[e] = p + (ps - p) * (e < 4 ? m0[e & 3] : m1[e & 3]); }
}
__device__ __forceinline__ void phase_sg(const Params& P) {
    const bf16_t* P1 = (const bf16_t*)(P.ws + WS_X); bf16_t* SG = (bf16_t*)(P.ws + WS_A + 32 * MiB);
    const int gt = blockIdx.x * 512 + threadIdx.x, NT = gridDim.x * 512;
    for (int s = gt; s < MLAT * 32; s += NT) { const int row = s >> 5, k8 = s & 31;
        u32x4 w = {0u, 0u, 0u, 0u};
        if (k8 < 8) { float xs[8]; mix8_lat(P1, row, 3456 + 8 * k8, P.in[8], xs);
            w.x = pk2(sigm(xs[0]), sigm(xs[1])); w.y = pk2(sigm(xs[2]), sigm(xs[3])); w.z = pk2(sigm(xs[4]), sigm(xs[5])); w.w = pk2(sigm(xs[6]), sigm(xs[7])); }
        *(u32x4*)(SG + (size_t)row * 256 + 8 * k8) = w; }
}
__device__ __forceinline__ void phase_readout_rwkv(const Params& P) {
    const bf16_t* P1 = (const bf16_t*)(P.ws + WS_X); const bf16_t* YD = (const bf16_t*)P.out; const float* SBON = (const float*)(P.ws + WS_M + MiB);
    bf16_t* OA = (bf16_t*)(P.ws + WS_A);
    const float* lnw = P.in[17]; const float* lnb = P.in[18];
    const int gt = blockIdx.x * 512 + threadIdx.x, NT = gridDim.x * 512;
    for (int s = gt; s < MLAT * 128; s += NT) { const int row = s >> 7, cv = s & 127, c0 = 8 * cv, hd = cv >> 3;
        const u32x4 y0 = *(const u32x4*)(YD + (size_t)row * 1024 + c0), y1 = *(const u32x4*)(YD + ((size_t)MLAT + row) * 1024 + c0), gg = *(const u32x4*)(OA + (size_t)row * 1024 + c0);
        float xv[8]; mix8_lat(P1, row, 2048 + c0, P.in[8], xv);
        const float sb = SBON[(size_t)row * 16 + hd] + SBON[((size_t)MLAT + row) * 16 + hd];
        const f32x4 w0 = *(const f32x4*)(lnw + c0), w1 = *(const f32x4*)(lnw + c0 + 4), b0 = *(const f32x4*)(lnb + c0), b1 = *(const f32x4*)(lnb + c0 + 4);
        float y[8], sum = 0.f;
#pragma unroll
        for (int e = 0; e < 8; ++e) { const unsigned a_ = y0[e >> 1], b_ = y1[e >> 1];
            y[e] = __uint_as_float((e & 1) ? (a_ & 0xffff0000u) : (a_ << 16)) + __uint_as_float((e & 1) ? (b_ & 0xffff0000u) : (b_ << 16)); sum += y[e]; }
        const float m = red8(sum) * (1.f / 64.f); float vs = 0.f;
#pragma unroll
        for (int e = 0; e < 8; ++e) { y[e] -= m; vs += y[e] * y[e]; }
        const float rs = rsqrtf(red8(vs) * (1.f / 64.f) + 64e-5f);
        float o[8];
#pragma unroll
        for (int e = 0; e < 8; ++e) { const unsigned g_ = gg[e >> 1]; const float gate = __uint_as_float((e & 1) ? (g_ & 0xffff0000u) : (g_ << 16));
            o[e] = (y[e] * rs * (e < 4 ? w0[e & 3] : w1[e & 3]) + (e < 4 ? b0[e & 3] : b1[e & 3]) + sb * xv[e]) * gate; }
        u32x4 w; w.x = pk2(o[0], o[1]); w.y = pk2(o[2], o[3]); w.z = pk2(o[4], o[5]); w.w = pk2(o[6], o[7]);
        *(u32x4*)(OA + (size_t)row * 1024 + c0) = w; }
}
__device__ __forceinline__ void phase_readout(const Params& P, unsigned char* smem) {
    const int tid = threadIdx.x, lane = tid & 63, wave = tid >> 6;
    const bf16_t* P1 = (const bf16_t*)(P.ws + WS_X); const bf16_t* P2 = (const bf16_t*)(P.ws + WS_D);
    const bf16_t* YD = (const bf16_t*)P.out; const bf16_t* OD = YD + (size_t)2 * MLAT * 1024;
    const float* SBON = (const float*)(P.ws + WS_M + MiB);
    bf16_t* OA = (bf16_t*)(P.ws + WS_A); bf16_t* OB = (bf16_t*)(P.ws + WS_F);
    const float* mu = P.in[8];
    { const int gw = blockIdx.x * 8 + wave, NGW = gridDim.x * 8; const float* nw = P.in[22];
      for (int row = gw; row < MLAT; row += NGW) { const int c0 = lane * 16;
        const u32x4 a0 = *(const u32x4*)(OD + (size_t)row * 1024 + c0), a1 = *(const u32x4*)(OD + (size_t)row * 1024 + c0 + 8);
        const u32x4 b0 = *(const u32x4*)(OD + ((size_t)MLAT + row) * 1024 + c0), b1 = *(const u32x4*)(OD + ((size_t)MLAT + row) * 1024 + c0 + 8);
        const u32x4 z0 = *(const u32x4*)(P2 + (size_t)row * LD2 + c0), z1 = *(const u32x4*)(P2 + (size_t)row * LD2 + c0 + 8);
        float o[16], z[16];
#pragma unroll
        for (int e = 0; e < 4; ++e) { o[2 * e] = __uint_as_float(a0[e] << 16) + __uint_as_float(b0[e] << 16); o[2 * e + 1] = __uint_as_float(a0[e] & 0xffff0000u) + __uint_as_float(b0[e] & 0xffff0000u);
            o[8 + 2 * e] = __uint_as_float(a1[e] << 16) + __uint_as_float(b1[e] << 16); o[8 + 2 * e + 1] = __uint_as_float(a1[e] & 0xffff0000u) + __uint_as_float(b1[e] & 0xffff0000u);
            z[2 * e] = __uint_as_float(z0[e] << 16); z[2 * e + 1] = __uint_as_float(z0[e] & 0xffff0000u); z[8 + 2 * e] = __uint_as_float(z1[e] << 16); z[8 + 2 * e + 1] = __uint_as_float(z1[e] & 0xffff0000u); }
        float ss = 0.f;
#pragma unroll
        for (int e = 0; e < 16; ++e) ss += o[e] * o[e];
        ss = red8(ss);
        const float rs = rsqrtf(ss * (1.f / 128.f) + 1e-6f);
        float r[16];
#pragma unroll
        for (int e = 0; e < 16; ++e) r[e] = o[e] * rs * nw[(c0 + e) & 127] * (z[e] * sigm(z[e]));
        u32x4 w0, w1;
#pragma unroll
        for (int e = 0; e < 4; ++e) { w0[e] = pk2(r[2 * e], r[2 * e + 1]); w1[e] = pk2(r[8 + 2 * e], r[8 + 2 * e + 1]); }
        *(u32x4*)(OB + (size_t)row * 1024 + c0) = w0; *(u32x4*)(OB + (size_t)row * 1024 + c0 + 8) = w1; } }
}

__global__ void __launch_bounds__(512, 2) fwd_mega(Params P) {
    extern __shared__ __attribute__((aligned(16))) unsigned char smem[];
    cg::grid_group grid = cg::this_grid();
    bf16_t* WT_IN = (bf16_t*)(P.ws + WS_A); bf16_t* WT_PA = (bf16_t*)(P.ws + WS_B); bf16_t* WT_PB = WT_PA + 2048 * 1024; bf16_t* WT_OUT = WT_PB + 2048 * 1024;
    bf16_t* P1 = (bf16_t*)(P.ws + WS_X); bf16_t* P2 = (bf16_t*)(P.ws + WS_D); bf16_t* H = (bf16_t*)P.out;
    bf16_t* OA = (bf16_t*)(P.ws + WS_A); bf16_t* OB = (bf16_t*)(P.ws + WS_F); bf16_t* MBUF = (bf16_t*)(P.ws + WS_X); bf16_t* A3 = (bf16_t*)(P.ws + WS_X);
    bf16_t* H2 = (bf16_t*)(P.ws + WS_D); bf16_t* WT_GU = (bf16_t*)(P.ws + WS_A); bf16_t* WT_DN = (bf16_t*)(P.ws + WS_F);
    const float* MOD = (const float*)(P.ws + WS_M);
#define PHASE(n) if (P.ph_lo <= (n) && (n) < P.ph_hi)
#define SEAM(n) do { if (P.coop && P.ph_lo <= (n) && (n) + 1 < P.ph_hi) grid.sync(); } while (0)
    PHASE(0) { phase_prep(P, smem); } SEAM(0);
    PHASE(1) { phase_norm1(P); } SEAM(1);
    PHASE(2) { EpiBf16Plain e1{P1, LD1}; run_gemm(smem, H, WT_IN, MALL, N1, D, e1);
               EpiBf16Plain e2{P2, LD2}; run_gemm(smem, H, WT_IN + (size_t)N1 * D, MLAT, N2, D, e2); } SEAM(2);
    PHASE(3) { phase_sg(P); phase_rwkv_chunked(P, smem); }
    PHASE(4) { phase_gdn(P, smem); } SEAM(4);
    PHASE(5) { EpiBf16Plain eg{OA, 1024}; run_gemm(smem, (const bf16_t*)(P.ws + WS_A + 32 * MiB), (const bf16_t*)(P.ws + WS_M + MiB / 2), MLAT, 1024, 256, eg); phase_readout(P, smem); } SEAM(5);
    PHASE(6) { phase_readout_rwkv(P); } SEAM(6);
    PHASE(7) { EpiGate<false> ea{MBUF, P2 + 1024}; run_gemm(smem, OA, WT_PA, MLAT, D, 1024, ea);
               EpiGate<true> eb{MBUF, P2 + 1024 + 2048}; run_gemm(smem, OB, WT_PB, MLAT, D, 1024, eb); } SEAM(7);
    PHASE(8) { EpiRes e{P.out, P.in[0], MOD + 2 * D}; run_gemm(smem, MBUF, WT_OUT, MLAT, D, D, e); } SEAM(8);
    PHASE(9) { phase_norm2(P); phase_ffn_weights(P, smem); } SEAM(9);
    PHASE(10) { EpiSwiglu e{A3}; run_gemm(smem, H2, WT_GU, MLAT, 2 * FFH, D, e); } SEAM(10);
    PHASE(11) { EpiRes e{P.out, P.out, MOD + 5 * D}; run_gemm(smem, A3, WT_DN, MLAT, D, FFH, e); } SEAM(11);
    PHASE(12) { phase_final_norm(P); }
}

#ifndef N_LAUNCH_PER_PHASE
#define N_LAUNCH_PER_PHASE 0
#endif
#ifndef PROBE_SEQ
#define PROBE_SEQ {0,1,2,3,4,5,6,7,8,9,10,11,12}
#endif
extern "C" void kernel_launch(void* const* d_in, const int* in_sizes, int n_in, void* d_out, int out_size, void* d_ws, size_t ws_size, hipStream_t stream) {
    static int grid = 0;
    if (grid == 0) {
        if (n_in != 30 || out_size != MLAT * D || ws_size < WS_END) { fprintf(stderr, "kernel_launch: unexpected shapes: n_in %d out %d ws %zu (need %zu)\n", n_in, out_size, ws_size, (size_t)WS_END); grid = -1; return; }
        int dev = 0, cus = 0, per_cu = 0;
        if (hipGetDevice(&dev) != hipSuccess || hipDeviceGetAttribute(&cus, hipDeviceAttributeMultiprocessorCount, dev) != hipSuccess) { grid = -1; return; }
        if (hipFuncSetAttribute((const void*)fwd_mega, hipFuncAttributeMaxDynamicSharedMemorySize, LDS_BYTES) != hipSuccess) { fprintf(stderr, "kernel_launch: hipFuncSetAttribute failed\n"); grid = -1; return; }
        if (hipOccupancyMaxActiveBlocksPerMultiprocessor(&per_cu, (const void*)fwd_mega, 512, LDS_BYTES) != hipSuccess || per_cu < 1) { fprintf(stderr, "kernel_launch: occupancy query gives %d\n", per_cu); grid = -1; return; }
        grid = cus * per_cu; if (grid > 256) grid = 256;
    }
    if (grid < 0) return;
    Params p{};
    for (int i = 0; i < 30; ++i) p.in[i] = (const float*)d_in[i];
    p.out = (float*)d_out; p.ws = (unsigned char*)d_ws;
#if N_LAUNCH_PER_PHASE
    { const int seq[] = PROBE_SEQ; for (int si = 0; si < (int)(sizeof(seq) / sizeof(int)); ++si) { const int ph = seq[si]; p.ph_lo = ph; p.ph_hi = ph + 1; p.coop = 0; hipLaunchKernelGGL(fwd_mega, dim3(grid), dim3(512), LDS_BYTES, stream, p); } }
#else
    p.ph_lo = 0; p.ph_hi = 13; p.coop = 1;
    void* args[] = {&p};
    hipError_t e = hipLaunchCooperativeKernel((const void*)fwd_mega, dim3(grid), dim3(512), args, LDS_BYTES, stream);
    if (e != hipSuccess) fprintf(stderr, "cooperative launch failed: %s (grid %d)\n", hipGetErrorString(e), grid);
#endif
}
```

```cpp
#include <hip/hip_runtime.h>
#include <hip/hip_cooperative_groups.h>
#include <cstdio>
#include <cstdint>
namespace cg = cooperative_groups;
namespace pg8 {
#define PG8_LAS __attribute__((address_space(3)))
typedef unsigned short bf16_t;
typedef short bf16x8 __attribute__((ext_vector_type(8)));
typedef float f32x4 __attribute__((ext_vector_type(4)));
typedef unsigned u32x4 __attribute__((ext_vector_type(4)));
constexpr int BM = 256, BK = 64, HALF = 128, HTB = HALF * BK * 2  , STAGE_BYTES = 8 * HTB, NXCD = 8, WGM = 8;

__host__ __device__ __forceinline__ int lds_byte(int r, int c) { const int st = (r >> 4) * 2 + (c >> 5), rr = r & 15, cc = c & 31, ob = rr * 64 + cc * 2; return st * 1024 + (ob ^ (((ob >> 9) & 1) << 5)); }
__host__ __device__ __forceinline__ void stage_rc(int b, int& R, int& C) { const int st = b / 1024, sb = b % 1024, swz = sb ^ (((sb >> 9) & 1) << 5); R = (st >> 1) * 16 + swz / 64; C = (st & 1) * 32 + (swz % 64) / 2; }
__host__ __device__ __forceinline__ int perm32(int rho) { const int n = rho >> 4, i = rho & 15; return 8 * (i >> 2) + 4 * n + (i & 3); }

struct Unit { int pm, pn; };
struct Gemm { const bf16_t* A; const bf16_t* Bt; int M, N, K; };

struct StaticOrder {
    int nM, nN, nwg, G, c;
    __host__ __device__ void init(int M, int N, int G_, int c_) { nM = M / BM; nN = N / BM; nwg = nM * nN; G = G_; c = c_; }
    __host__ __device__ bool next(int i, Unit& u) const {
        const long L = (long)i * G + c; if (L >= nwg) return false;
        int wgid = (int)L; { const int q = nwg / NXCD, r = nwg % NXCD, xcd = wgid % NXCD, off = wgid / NXCD; wgid = (xcd < r ? xcd * (q + 1) : r * (q + 1) + (xcd - r) * q) + off; }
        const int nig = WGM * nN, gid = wgid / nig, fm = gid * WGM, gsz = (nM - fm) < WGM ? (nM - fm) : WGM;
        u.pm = fm + ((wgid % nig) % gsz); u.pn = (wgid % nig) / gsz; return true;
    }
    __device__ __forceinline__ void a_ready(const Unit&) const {}
    __device__ __forceinline__ void done(const Unit&) const {}
};
__device__ __forceinline__ unsigned cvt_pk_bf16(float lo, float hi) { unsigned r; asm volatile("v_cvt_pk_bf16_f32 %0, %1, %2" : "=v"(r) : "v"(lo), "v"(hi)); return r; }
template <class Epi, class Sched, bool ALIGN_EPI = false, bool SP2 = false>
__device__ __forceinline__ void gemm_phase(PG8_LAS unsigned char* lds, const Gemm g, const Sched& S, const Epi& E) {
    const int tid = threadIdx.x, wid = __builtin_amdgcn_readfirstlane(tid >> 6), lane = tid & 63, wr = wid >> 2, wc = wid & 3, fr = lane & 15, fq = lane >> 4;
    const int K = g.K, nt = K / BK;
    unsigned voffA[2], voffB[2];
#pragma unroll
    for (int i = 0; i < 2; ++i) { int R, C; stage_rc(tid * 16 + i * 8192, R, C); const int Rb = Epi::PERM ? ((R & ~31) + perm32(R & 31)) : R;
        voffA[i] = (unsigned)(R * K + C) * 2u; voffB[i] = (unsigned)(Rb * K + C) * 2u; }
    const size_t kstep = (size_t)(BK * 2);
    const size_t hstep = (size_t)HALF * K * 2;
    const size_t tstep = 2 * hstep;
    const unsigned ldsw = (unsigned)wid * 1024u;
    const int aoff = lds_byte(wr * 64 + fr, fq * 8), boff = lds_byte(wc * 32 + fr, fq * 8);
#define PG8_SA(b, h) (((b) * 2 + (h)) * HTB)
#define PG8_SB(b, h) ((4 + (b) * 2 + (h)) * HTB)
#define PG8_STAGE(bufoff, gbase, voff) do { _Pragma("unroll") for (int _i = 0; _i < 2; ++_i) \
        __builtin_amdgcn_global_load_lds((const unsigned*)((const char*)(gbase) + (voff)[_i]), (PG8_LAS unsigned*)(lds + (bufoff) + ldsw + _i * 8192), 16, 0, 0); } while (0)
#define PG8_LDA(dst, b, h) do { _Pragma("unroll") for (int m = 0; m < 4; ++m) _Pragma("unroll") for (int k = 0; k < 2; ++k) dst[m][k] = *(const PG8_LAS bf16x8*)(lds + PG8_SA(b, h) + aoff + m * 2048 + k * 1024); } while (0)
#define PG8_LDB(dst, b, h) do { _Pragma("unroll") for (int n = 0; n < 2; ++n) _Pragma("unroll") for (int k = 0; k < 2; ++k) dst[n][k] = *(const PG8_LAS bf16x8*)(lds + PG8_SB(b, h) + boff + n * 2048 + k * 1024); } while (0)
#define PG8_MMA(ai, bj, At, Bt) do { __builtin_amdgcn_s_setprio(1); _Pragma("unroll") for (int m = 0; m < 4; ++m) _Pragma("unroll") for (int n = 0; n < 2; ++n) _Pragma("unroll") for (int k = 0; k < 2; ++k) \
        acc[ai][bj][m][n] = __builtin_amdgcn_mfma_f32_16x16x32_bf16(Bt[n][k], At[m][k], acc[ai][bj][m][n], 0, 0, 0); __builtin_amdgcn_s_setprio(0); } while (0)
#define PG8_WAIT_V(n) asm volatile("s_waitcnt vmcnt(" #n ")" ::: "memory")
#define PG8_WAIT_L(n) asm volatile("s_waitcnt lgkmcnt(" #n ")" ::: "memory")
#define PG8_BAR __builtin_amdgcn_s_barrier()
#define PG8_SCHED __builtin_amdgcn_sched_barrier(0)
    Unit cur, nxt; int ui = 0;
    if (!S.next(0, cur)) return;
    f32x4 acc[2][2][4][2];
#pragma unroll
    for (int a = 0; a < 2; ++a)
#pragma unroll
        for (int b = 0; b < 2; ++b)
#pragma unroll
            for (int m = 0; m < 4; ++m)
#pragma unroll
                for (int n = 0; n < 2; ++n) acc[a][b][m][n] = (f32x4){0.f, 0.f, 0.f, 0.f};
    bf16x8 At[4][2], B0[2][2], B1[2][2];
    const char* cA = (const char*)g.A + (size_t)cur.pm * tstep; const char* cB = (const char*)g.Bt + (size_t)cur.pn * tstep;
    S.a_ready(cur);
    if constexpr (SP2) {
        PG8_STAGE(PG8_SB(0, 0), cB, voffB); PG8_STAGE(PG8_SB(0, 1), cB + hstep, voffB); PG8_STAGE(PG8_SA(0, 0), cA, voffA); PG8_STAGE(PG8_SA(0, 1), cA + hstep, voffA);
        if (wr == 1) PG8_BAR;
        PG8_WAIT_V(2); PG8_BAR;
        PG8_STAGE(PG8_SB(1, 0), cB + kstep, voffB); PG8_STAGE(PG8_SA(1, 0), cA + kstep, voffA); PG8_STAGE(PG8_SB(1, 1), cB + hstep + kstep, voffB);
        PG8_WAIT_V(6); PG8_BAR;
    } else {
        PG8_STAGE(PG8_SB(0, 0), cB, voffB); PG8_STAGE(PG8_SA(0, 0), cA, voffA); PG8_STAGE(PG8_SB(0, 1), cB + hstep, voffB); PG8_STAGE(PG8_SA(0, 1), cA + hstep, voffA);
        if (wr == 1) PG8_BAR;
        PG8_WAIT_V(4); PG8_BAR;
        PG8_STAGE(PG8_SB(1, 0), cB + kstep, voffB); PG8_STAGE(PG8_SA(1, 0), cA + kstep, voffA); PG8_STAGE(PG8_SB(1, 1), cB + hstep + kstep, voffB);
        PG8_WAIT_V(6); PG8_BAR;
    }
    for (;;) {
        const bool has_next = S.next(ui + 1, nxt);
        const char* nA = has_next ? (const char*)g.A + (size_t)nxt.pm * tstep : cA; const char* nB = has_next ? (const char*)g.Bt + (size_t)nxt.pn * tstep : cB;
        for (int t = 0; t < nt; t += 2) {
            const bool last = (t == nt - 2);
            const char* a1 = cA + (size_t)(t + 1) * kstep;
            const char* a2 = last ? nA : cA + (size_t)(t + 2) * kstep; const char* b2 = last ? nB : cB + (size_t)(t + 2) * kstep;
            const char* a3 = a2 + kstep; const char* b3 = b2 + kstep;
            if (last && has_next) S.a_ready(nxt);
            if constexpr (SP2) {
            PG8_LDB(B0, 0, 0); PG8_LDB(B1, 0, 1); PG8_SCHED; PG8_LDA(At, 0, 0); PG8_STAGE(PG8_SA(1, 1), a1 + hstep, voffA);
            PG8_WAIT_V(8); PG8_WAIT_L(0); PG8_BAR; PG8_MMA(0, 0, At, B0); PG8_MMA(0, 1, At, B1); PG8_BAR; PG8_SCHED;
            PG8_LDA(At, 0, 1); PG8_STAGE(PG8_SB(0, 0), b2, voffB); PG8_STAGE(PG8_SB(0, 1), b2 + hstep, voffB); PG8_STAGE(PG8_SA(0, 0), a2, voffA);
            PG8_WAIT_V(8); PG8_WAIT_L(0); PG8_BAR; PG8_MMA(1, 0, At, B0); PG8_MMA(1, 1, At, B1); PG8_BAR; PG8_SCHED;
            PG8_LDB(B0, 1, 0); PG8_LDB(B1, 1, 1); PG8_SCHED; PG8_LDA(At, 1, 0); PG8_STAGE(PG8_SA(0, 1), a2 + hstep, voffA);
            PG8_WAIT_V(8); PG8_WAIT_L(0); PG8_BAR; PG8_MMA(0, 0, At, B0); PG8_MMA(0, 1, At, B1); PG8_BAR; PG8_SCHED;
            PG8_LDA(At, 1, 1); PG8_STAGE(PG8_SB(1, 0), b3, voffB); PG8_STAGE(PG8_SB(1, 1), b3 + hstep, voffB); PG8_STAGE(PG8_SA(1, 0), a3, voffA);
            PG8_WAIT_V(8); PG8_WAIT_L(0); PG8_BAR; PG8_MMA(1, 0, At, B0); PG8_MMA(1, 1, At, B1); PG8_BAR; PG8_SCHED;
            } else {
            PG8_LDB(B0, 0, 0); PG8_SCHED; PG8_LDA(At, 0, 0); PG8_STAGE(PG8_SA(1, 1), a1 + hstep, voffA);
            PG8_WAIT_L(8); PG8_BAR; PG8_WAIT_L(0); PG8_MMA(0, 0, At, B0); PG8_BAR; PG8_SCHED;
            PG8_LDB(B1, 0, 1); PG8_STAGE(PG8_SB(0, 0), b2, voffB);
            PG8_BAR; PG8_WAIT_L(0); PG8_MMA(0, 1, At, B1); PG8_BAR;
            PG8_LDA(At, 0, 1); PG8_STAGE(PG8_SA(0, 0), a2, voffA);
            PG8_BAR; PG8_WAIT_L(0); PG8_MMA(1, 0, At, B0); PG8_BAR; PG8_SCHED;
            PG8_STAGE(PG8_SB(0, 1), b2 + hstep, voffB);
            PG8_WAIT_V(6); PG8_BAR; PG8_MMA(1, 1, At, B1); PG8_BAR;
            PG8_LDB(B0, 1, 0); PG8_SCHED; PG8_LDA(At, 1, 0); PG8_STAGE(PG8_SA(0, 1), a2 + hstep, voffA);
            PG8_WAIT_L(8); PG8_BAR; PG8_WAIT_L(0); PG8_MMA(0, 0, At, B0); PG8_BAR; PG8_SCHED;
            PG8_LDB(B1, 1, 1); PG8_STAGE(PG8_SB(1, 0), b3, voffB);
            PG8_BAR; PG8_WAIT_L(0); PG8_MMA(0, 1, At, B1); PG8_BAR;
            PG8_LDA(At, 1, 1); PG8_STAGE(PG8_SA(1, 0), a3, voffA);
            PG8_BAR; PG8_WAIT_L(0); PG8_MMA(1, 0, At, B0); PG8_BAR; PG8_SCHED;
            PG8_STAGE(PG8_SB(1, 1), b3 + hstep, voffB);
            PG8_WAIT_V(6); PG8_BAR; PG8_MMA(1, 1, At, B1); PG8_BAR;
            }
        }
        if constexpr (ALIGN_EPI) { if (wr == 0) PG8_BAR; }
        if constexpr (!Epi::AFTER_DRAIN) { E(acc, cur, wr, wc, fr, fq); S.done(cur); }
        if (!has_next) break;
#pragma unroll
        for (int a = 0; a < 2; ++a)
#pragma unroll
            for (int b = 0; b < 2; ++b)
#pragma unroll
                for (int m = 0; m < 4; ++m)
#pragma unroll
                    for (int n = 0; n < 2; ++n) acc[a][b][m][n] = (f32x4){0.f, 0.f, 0.f, 0.f};
        cur = nxt; cA = nA; cB = nB; ++ui;
        if constexpr (ALIGN_EPI) { if (wr == 1) PG8_BAR; }
    }
    PG8_WAIT_V(0);
    if constexpr (!ALIGN_EPI) { if (wr == 0) PG8_BAR; }
    PG8_BAR;
    if constexpr (Epi::AFTER_DRAIN) { E.fused(acc, cur, wr, wc, fr, fq, lds, wid, lane); S.done(cur); }
#undef PG8_SA
#undef PG8_SB
#undef PG8_STAGE
#undef PG8_LDA
#undef PG8_LDB
#undef PG8_MMA
#undef PG8_WAIT_V
#undef PG8_WAIT_L
#undef PG8_BAR
#undef PG8_SCHED
}
}


using pg8::bf16_t; using pg8::f32x4; using pg8::u32x4; using pg8::Unit; using pg8::cvt_pk_bf16;
#define LAS __attribute__((address_space(3)))

constexpr int D = 2048, NB = 8, TL = 2048, TC = 256, MLAT = NB * TL  , MCTX = NB * TC  , MALL = MLAT + MCTX  ;
constexpr int N1 = 6656, N2 = 5120, LD1 = N1, LD2 = N2, FFH = 5632, NADA = 6 * D;
constexpr int COL_CV = 3520, COL_AB = 6592;
constexpr int LDS_BYTES = 147456;
constexpr size_t MiB = 1048576;
constexpr size_t WS_A = 0;
constexpr size_t WS_B = WS_A + 46 * MiB;
constexpr size_t WS_X = WS_B + 16 * MiB;
constexpr size_t WS_D = WS_X + 234 * MiB;
constexpr size_t WS_F = WS_D + 160 * MiB;
constexpr size_t WS_M = WS_F + 32 * MiB;
constexpr size_t WS_END = WS_M + 3 * MiB;

struct Params { const float* in[30]; float* out; unsigned char* ws; int ph_lo, ph_hi, coop, pad; };

__device__ __forceinline__ float bf2f(bf16_t b) { return __uint_as_float(((unsigned)b) << 16); }
typedef __bf16 bf16x2_t __attribute__((ext_vector_type(2)));
typedef float f32x2_t __attribute__((ext_vector_type(2)));
__device__ __forceinline__ unsigned pk2(float lo, float hi) { const f32x2_t v = {lo, hi}; return __builtin_bit_cast(unsigned, __builtin_convertvector(v, bf16x2_t)); }
__device__ __forceinline__ bf16_t f2bf(float f) { return (bf16_t)(pk2(f, 0.f) & 0xffffu); }
__device__ __forceinline__ float sigm(float x) { return __builtin_amdgcn_rcpf(1.f + __expf(-x)); }
__device__ __forceinline__ float tanh_fast(float x) { return 1.f - 2.f * __builtin_amdgcn_rcpf(1.f + __expf(2.f * x)); }
__device__ __forceinline__ float wave_sum(float v) {
#pragma unroll
    for (int o = 1; o < 64; o <<= 1) v += __shfl_xor(v, o);
    return v;
}
template <int CTRL> __device__ __forceinline__ float dppf(float x) { return __int_as_float(__builtin_amdgcn_update_dpp(0, __float_as_int(x), CTRL, 0xF, 0xF, true)); }
__device__ __forceinline__ float red8(float x) { x += dppf<0x141>(x); x += dppf<0xB1>(x); x += dppf<0x4E>(x); return x; }

struct EpiBf16Plain {
    static constexpr bool PERM = true, AFTER_DRAIN = false;
    bf16_t* O; int ldc;
    __device__ __forceinline__ void operator()(const f32x4 (&acc)[2][2][4][2], const Unit& u, int wr, int wc, int fr, int fq) const {
        const int row0 = u.pm * 256 + wr * 64 + fr, col0 = u.pn * 256 + wc * 32 + 8 * fq;
#pragma unroll
        for (int ai = 0; ai < 2; ++ai)
#pragma unroll
            for (int m = 0; m < 4; ++m) { bf16_t* rowp = O + (size_t)(row0 + ai * 128 + m * 16) * ldc + col0;
#pragma unroll
                for (int bj = 0; bj < 2; ++bj) { const f32x4 v0 = acc[ai][bj][m][0], v1 = acc[ai][bj][m][1];
                    u32x4 w; w.x = pk2(v0[0], v0[1]); w.y = pk2(v0[2], v0[3]); w.z = pk2(v1[0], v1[1]); w.w = pk2(v1[2], v1[3]);
                    *(u32x4*)(rowp + bj * 128) = w; } }
    }
};
template <bool SECOND> struct EpiGate {
    static constexpr bool PERM = true, AFTER_DRAIN = false;
    bf16_t* Mo; const bf16_t* G;
    __device__ __forceinline__ void operator()(const f32x4 (&acc)[2][2][4][2], const Unit& u, int wr, int wc, int fr, int fq) const {
        const int row0 = u.pm * 256 + wr * 64 + fr, col0 = u.pn * 256 + wc * 32 + 8 * fq;
#pragma unroll
        for (int ai = 0; ai < 2; ++ai)
#pragma unroll
            for (int m = 0; m < 4; ++m) { const size_t row = (size_t)(row0 + ai * 128 + m * 16);
#pragma unroll
                for (int bj = 0; bj < 2; ++bj) { const f32x4 v0 = acc[ai][bj][m][0], v1 = acc[ai][bj][m][1];
                    const int col = col0 + bj * 128;
                    const u32x4 g = *(const u32x4*)(G + row * LD2 + col);
                    float r[8];
                    r[0] = sigm(__uint_as_float(g.x << 16)) * v0[0]; r[1] = sigm(__uint_as_float(g.x & 0xffff0000u)) * v0[1];
                    r[2] = sigm(__uint_as_float(g.y << 16)) * v0[2]; r[3] = sigm(__uint_as_float(g.y & 0xffff0000u)) * v0[3];
                    r[4] = sigm(__uint_as_float(g.z << 16)) * v1[0]; r[5] = sigm(__uint_as_float(g.z & 0xffff0000u)) * v1[1];
                    r[6] = sigm(__uint_as_float(g.w << 16)) * v1[2]; r[7] = sigm(__uint_as_float(g.w & 0xffff0000u)) * v1[3];
                    u32x4* op = (u32x4*)(Mo + row * D + col);
                    if (SECOND) { const u32x4 o = *op;
                        r[0] += __uint_as_float(o.x << 16); r[1] += __uint_as_float(o.x & 0xffff0000u); r[2] += __uint_as_float(o.y << 16); r[3] += __uint_as_float(o.y & 0xffff0000u);
                        r[4] += __uint_as_float(o.z << 16); r[5] += __uint_as_float(o.z & 0xffff0000u); r[6] += __uint_as_float(o.w << 16); r[7] += __uint_as_float(o.w & 0xffff0000u); }
                    u32x4 w; w.x = pk2(r[0], r[1]); w.y = pk2(r[2], r[3]); w.z = pk2(r[4], r[5]); w.w = pk2(r[6], r[7]);
                    *op = w; } }
    }
};
struct EpiRes {
    static constexpr bool PERM = false, AFTER_DRAIN = false;
    float* out; const float* res; const float* gt;
    __device__ __forceinline__ void operator()(const f32x4 (&acc)[2][2][4][2], const Unit& u, int wr, int wc, int fr, int fq) const {
        const int row0 = u.pm * 256 + wr * 64 + fr, col0 = u.pn * 256 + wc * 32 + 4 * fq;
        const float* gtb = gt + (size_t)((u.pm * 256) >> 11) * NADA + col0;
        f32x4 gv[2][2];
#pragma unroll
        for (int bj = 0; bj < 2; ++bj)
#pragma unroll
            for (int n = 0; n < 2; ++n) gv[bj][n] = *(const f32x4*)(gtb + bj * 128 + n * 16);
#pragma unroll
        for (int ai = 0; ai < 2; ++ai)
#pragma unroll
            for (int m = 0; m < 4; ++m) { const size_t ro = (size_t)(row0 + ai * 128 + m * 16) * D + col0;
#pragma unroll
                for (int bj = 0; bj < 2; ++bj)
#pragma unroll
                    for (int n = 0; n < 2; ++n) { const f32x4 rv = *(const f32x4*)(res + ro + bj * 128 + n * 16);
                        *(f32x4*)(out + ro + bj * 128 + n * 16) = rv + gv[bj][n] * acc[ai][bj][m][n]; } }
    }
};
struct EpiSwiglu {
    static constexpr bool PERM = true, AFTER_DRAIN = false;
    bf16_t* O;
    __device__ __forceinline__ void operator()(const f32x4 (&acc)[2][2][4][2], const Unit& u, int wr, int wc, int fr, int fq) const {
        const int row0 = u.pm * 256 + wr * 64 + fr, col0 = u.pn * 128 + wc * 32 + 8 * fq;
#pragma unroll
        for (int ai = 0; ai < 2; ++ai)
#pragma unroll
            for (int m = 0; m < 4; ++m) { bf16_t* rowp = O + (size_t)(row0 + ai * 128 + m * 16) * FFH + col0;
                float r[8];
#pragma unroll
                for (int n = 0; n < 2; ++n)
#pragma unroll
                    for (int e = 0; e < 4; ++e) { const float g = acc[ai][0][m][n][e], up = acc[ai][1][m][n][e]; r[4 * n + e] = g * sigm(g) * up; }
                u32x4 w; w.x = pk2(r[0], r[1]); w.y = pk2(r[2], r[3]); w.z = pk2(r[4], r[5]); w.w = pk2(r[6], r[7]);
                *(u32x4*)rowp = w; }
    }
};

#ifndef GEMM_ALIGN_EPI
#define GEMM_ALIGN_EPI true
#endif
#ifndef GEMM_SP2
#define GEMM_SP2 true
#endif
template <class Epi> __device__ __forceinline__ void run_gemm(unsigned char* smem, const bf16_t* A, const bf16_t* Bt, int M, int N, int K, const Epi& E) {
    pg8::Gemm g; g.A = A; g.Bt = Bt; g.M = M; g.N = N; g.K = K;
    pg8::StaticOrder S; S.init(M, N, (int)gridDim.x, (int)blockIdx.x);
    pg8::gemm_phase<Epi, pg8::StaticOrder, GEMM_ALIGN_EPI, GEMM_SP2>((PG8_LAS unsigned char*)smem, g, S, E);
    __syncthreads();
}

__device__ __forceinline__ void transpose_item(const float* W, int K, int N, bf16_t* WT, int dst_row0, int src_col0, float* scr, int k0, int lane) {
    if (src_col0 >= 0) {
#pragma unroll 8
        for (int i = 0; i < 32; ++i) { const int kk = 2 * i + (lane >> 5); scr[kk * 33 + (lane & 31)] = W[(size_t)(k0 + kk) * N + src_col0 + (lane & 31)]; }
    } else {
#pragma unroll 8
        for (int i = 0; i < 32; ++i) { const int kk = 2 * i + (lane >> 5); scr[kk * 33 + (lane & 31)] = 0.f; }
    }
    asm volatile("s_waitcnt lgkmcnt(0)" ::: "memory");
    const int c = lane & 7;
#pragma unroll
    for (int j = 0; j < 4; ++j) { const int n = (lane >> 3) + 8 * j; const float* s = scr + (8 * c) * 33 + n;
        u32x4 o; o.x = pk2(s[0], s[33]); o.y = pk2(s[2 * 33], s[3 * 33]); o.z = pk2(s[4 * 33], s[5 * 33]); o.w = pk2(s[6 * 33], s[7 * 33]);
        *(u32x4*)(WT + (size_t)(dst_row0 + n) * K + k0 + 8 * c) = o; }
    asm volatile("s_waitcnt lgkmcnt(0)" ::: "memory");
}
__device__ __forceinline__ int win_src_col(int n0) {
    if (n0 < 6592) return n0;
    if (n0 < 6624) return 7616 + (n0 - 6592);
    if (n0 < 6656) return -1;
    const int j = n0 - 6656;
    return j < 1024 ? 6592 + j : 7648 + (j - 1024);
}

__device__ __forceinline__ void phase_prep(const Params& P, unsigned char* smem) {
    const int tid = threadIdx.x, lane = tid & 63, wave = tid >> 6;
    float* MOD = (float*)(P.ws + WS_M);
    if ((int)blockIdx.x < 192) {
        float* sT = (float*)smem;
        float* red = (float*)(smem + 98304);
        const float* c = P.in[1]; const float* cc = P.in[3];
        for (int idx = tid; idx < 9 * D; idx += 512) { const int m = idx >> 11, k = idx & 2047; const float v = m < 8 ? c[m * D + k] : cc[k]; sT[k * 12 + m] = v * sigm(v); }
        __syncthreads();
        const float* W = P.in[4]; const float* bias = P.in[5];
        for (int item = blockIdx.x; item < 192; item += gridDim.x) {
            const int n0 = item * 64, cl = tid & 15, kl = tid >> 4;
            float acc[9][4];
#pragma unroll
            for (int m = 0; m < 9; ++m)
#pragma unroll
                for (int e = 0; e < 4; ++e) acc[m][e] = 0.f;
#pragma unroll 4
            for (int kk = 0; kk < 64; ++kk) { const int k = kk * 32 + kl;
                const f32x4 w = *(const f32x4*)(W + (size_t)k * NADA + n0 + 4 * cl);
                const f32x4 s0 = *(const f32x4*)(sT + k * 12), s1 = *(const f32x4*)(sT + k * 12 + 4); const float s2 = sT[k * 12 + 8];
#pragma unroll
                for (int e = 0; e < 4; ++e) { acc[0][e] += s0[0] * w[e]; acc[1][e] += s0[1] * w[e]; acc[2][e] += s0[2] * w[e]; acc[3][e] += s0[3] * w[e];
                    acc[4][e] += s1[0] * w[e]; acc[5][e] += s1[1] * w[e]; acc[6][e] += s1[2] * w[e]; acc[7][e] += s1[3] * w[e]; acc[8][e] += s2 * w[e]; } }
#pragma unroll
            for (int m = 0; m < 9; ++m)
#pragma unroll
                for (int e = 0; e < 4; ++e) { float v = acc[m][e]; v += __shfl_xor(v, 16); v += __shfl_xor(v, 32); if ((lane >> 4) == 0) red[(wave * 9 + m) * 64 + 4 * cl + e] = v; }
            __syncthreads();
            for (int o = tid; o < 576; o += 512) { const int m = o >> 6, c2 = o & 63; float s = bias[n0 + c2];
#pragma unroll
                for (int w8 = 0; w8 < 8; ++w8) s += red[(w8 * 9 + m) * 64 + c2];
                MOD[m * NADA + n0 + c2] = s; }
            __syncthreads();
        }
    }
    __syncthreads();
    { bf16_t* G2T = (bf16_t*)(P.ws + WS_M + MiB / 2); const float* g2 = P.in[13];
      for (int s = blockIdx.x * 512 + tid; s < 1024 * 32; s += gridDim.x * 512) { const int n = s >> 5, k8 = s & 31; u32x4 w = {0u, 0u, 0u, 0u};
          if (k8 < 8) { const float* gp = g2 + (size_t)(8 * k8) * 1024 + n; w.x = pk2(gp[0], gp[1024]); w.y = pk2(gp[2048], gp[3072]); w.z = pk2(gp[4096], gp[5120]); w.w = pk2(gp[6144], gp[7168]); }
          *(u32x4*)(G2T + (size_t)n * 256 + 8 * k8) = w; } }
    float* scr = (float*)(smem + wave * 8448);
    const int gw = blockIdx.x * 8 + wave, NGW = gridDim.x * 8;
    bf16_t* WT_IN = (bf16_t*)(P.ws + WS_A); bf16_t* WT_PA = (bf16_t*)(P.ws + WS_B); bf16_t* WT_PB = WT_PA + 2048 * 1024; bf16_t* WT_OUT = WT_PB + 2048 * 1024;
    constexpr int I_IN = 368 * 32, I_PA = 64 * 16, I_OUT = 64 * 32;
    for (int it = gw; it < I_IN + 2 * I_PA + I_OUT; it += NGW) {
        int r = it;
        if (r < I_IN) { const int nb = r % 368, kb = r / 368; transpose_item(P.in[7], 2048, 11744, WT_IN, nb * 32, win_src_col(nb * 32), scr, kb * 64, lane); continue; } r -= I_IN;
        if (r < I_PA) { const int nb = r % 64, kb = r / 64; transpose_item(P.in[23], 1024, 2048, WT_PA, nb * 32, nb * 32, scr, kb * 64, lane); continue; } r -= I_PA;
        if (r < I_PA) { const int nb = r % 64, kb = r / 64; transpose_item(P.in[24], 1024, 2048, WT_PB, nb * 32, nb * 32, scr, kb * 64, lane); continue; } r -= I_PA;
        { const int nb = r % 64, kb = r / 64; transpose_item(P.in[25], 2048, 2048, WT_OUT, nb * 32, nb * 32, scr, kb * 64, lane); }
    }
}
__device__ __forceinline__ void phase_ffn_weights(const Params& P, unsigned char* smem) {
    const int tid = threadIdx.x, lane = tid & 63, wave = tid >> 6;
    float* scr = (float*)(smem + wave * 8448);
    const int gw = blockIdx.x * 8 + wave, NGW = gridDim.x * 8;
    bf16_t* WT_GU = (bf16_t*)(P.ws + WS_A); bf16_t* WT_DN = (bf16_t*)(P.ws + WS_F);
    constexpr int I_GU = 352 * 32, I_DN = 64 * 88;
    for (int it = gw; it < I_GU + I_DN; it += NGW) {
        int r = it;
        if (r < I_GU) { const int nb = r % 352, kb = r / 352; const int n0 = nb * 32, pn = n0 >> 8, cq = n0 & 255; const int src = cq < 128 ? 128 * pn + cq : FFH + 128 * pn + (cq - 128);
            transpose_item(P.in[27], 2048, 2 * FFH, WT_GU, n0, src, scr, kb * 64, lane); continue; } r -= I_GU;
        { const int nb = r % 64, kb = r / 64; transpose_item(P.in[28], FFH, 2048, WT_DN, nb * 32, nb * 32, scr, kb * 64, lane); }
    }
}

__device__ __forceinline__ void norm_mod_row(const float* src, const float* nw, const float* sh, const float* sc, bf16_t* dst, int lane) {
    f32x4 v[8]; float ss = 0.f;
#pragma unroll
    for (int j = 0; j < 8; ++j) { v[j] = *(const f32x4*)(src + (j * 64 + lane) * 4); ss += v[j][0] * v[j][0] + v[j][1] * v[j][1] + v[j][2] * v[j][2] + v[j][3] * v[j][3]; }
    const float rstd = rsqrtf(wave_sum(ss) * (1.f / D) + 1e-6f);
#pragma unroll
    for (int j = 0; j < 8; ++j) { const int c = (j * 64 + lane) * 4; const f32x4 w = *(const f32x4*)(nw + c), a = *(const f32x4*)(sh + c), b = *(const f32x4*)(sc + c);
        float o[4];
#pragma unroll
        for (int e = 0; e < 4; ++e) o[e] = (v[j][e] * rstd * w[e]) * (1.f + b[e]) + a[e];
        uint2 pk; pk.x = pk2(o[0], o[1]); pk.y = pk2(o[2], o[3]); *(uint2*)(dst + c) = pk; }
}
__device__ __forceinline__ void phase_norm1(const Params& P) {
    const int lane = threadIdx.x & 63, gw = blockIdx.x * 8 + (threadIdx.x >> 6), NGW = gridDim.x * 8;
    const float* MOD = (const float*)(P.ws + WS_M); bf16_t* H = (bf16_t*)P.out;
    for (int row = gw; row < MALL; row += NGW) {
        const float* src = row < MLAT ? P.in[0] + (size_t)row * D : P.in[2] + (size_t)(row - MLAT) * D;
        const int mr = row < MLAT ? (row >> 11) : 8;
        norm_mod_row(src, P.in[6], MOD + mr * NADA, MOD + mr * NADA + D, H + (size_t)row * D, lane);
    }
}
__device__ __forceinline__ void phase_norm2(const Params& P) {
    const int lane = threadIdx.x & 63, gw = blockIdx.x * 8 + (threadIdx.x >> 6), NGW = gridDim.x * 8;
    const float* MOD = (const float*)(P.ws + WS_M); bf16_t* H2 = (bf16_t*)(P.ws + WS_D);
    for (int row = gw; row < MLAT; row += NGW) { const int mr = row >> 11;
        norm_mod_row(P.out + (size_t)row * D, P.in[26], MOD + mr * NADA + 3 * D, MOD + mr * NADA + 4 * D, H2 + (size_t)row * D, lane); }
}
__device__ __forceinline__ void phase_final_norm(const Params& P) {
    const int lane = threadIdx.x & 63, gw = blockIdx.x * 8 + (threadIdx.x >> 6), NGW = gridDim.x * 8;
    const float* nw = P.in[29];
    for (int row = gw; row < MLAT; row += NGW) { float* src = P.out + (size_t)row * D;
        f32x4 v[8]; float ss = 0.f;
#pragma unroll
        for (int j = 0; j < 8; ++j) { v[j] = *(const f32x4*)(src + (j * 64 + lane) * 4); ss += v[j][0] * v[j][0] + v[j][1] * v[j][1] + v[j][2] * v[j][2] + v[j][3] * v[j][3]; }
        const float rstd = rsqrtf(wave_sum(ss) * (1.f / D) + 1e-6f);
#pragma unroll
        for (int j = 0; j < 8; ++j) { const int c = (j * 64 + lane) * 4; const f32x4 w = *(const f32x4*)(nw + c); *(f32x4*)(src + c) = v[j] * rstd * w; }
    }
}

__device__ __forceinline__ float mixed_load(const bf16_t* P1, int row, int t, bool isctx, int col, const float* mu) {
    const float p = bf2f(P1[(size_t)row * LD1 + col]);
    int nrow; bool valid;
    if (isctx) { if (col & 1) { valid = t < TC - 1; nrow = row + 1; } else { valid = t > 0; nrow = row - 1; } }
    else { const int m = col & 3, x = t & 63, y = t >> 6;
        if (m == 0) { valid = x > 0; nrow = row - 1; } else if (m == 1) { valid = x < 63; nrow = row + 1; }
        else if (m == 2) { valid = y > 0; nrow = row - 64; } else { valid = y < 31; nrow = row + 64; } }
    const float ps = valid ? bf2f(P1[(size_t)nrow * LD1 + col]) : 0.f;
    return p + (ps - p) * mu[col];
}


__device__ __forceinline__ void tri_inv_part1(const float* LM, bf16_t* TM, bf16_t* T11T, int blk, int lane) {
    constexpr int LDLc = 36, LDCc = 40;
    { const int c = lane & 15, o = 16 * blk; float t[16];
        const float* Lb = LM + o * LDLc + o;
#pragma unroll
        for (int i = 0; i < 16; ++i) { float a4[4] = {(i == c) ? 1.f : 0.f, 0.f, 0.f, 0.f};
#pragma unroll
            for (int j4 = 0; j4 < (i + 3) / 4; ++j4) { const f32x4 l = *(const f32x4*)(Lb + i * LDLc + 4 * j4);
#pragma unroll
                for (int x = 0; x < 4; ++x) if (4 * j4 + x < i) a4[x] -= l[x] * t[4 * j4 + x]; }
            t[i] = (a4[0] + a4[1]) + (a4[2] + a4[3]); }
        if (lane < 16) {
#pragma unroll
            for (int i = 0; i < 16; ++i) TM[(o + i) * LDCc + o + c] = f2bf(t[i]);
            if (blk == 0) { u32x4 w0, w1;
#pragma unroll
                for (int e = 0; e < 4; ++e) { w0[e] = pk2(t[2 * e], t[2 * e + 1]); w1[e] = pk2(t[8 + 2 * e], t[8 + 2 * e + 1]); }
                *(u32x4*)(T11T + c * 16) = w0; *(u32x4*)(T11T + c * 16 + 8) = w1; } }
        else if (lane < 32 && blk == 0) { const u32x4 zz = {0u, 0u, 0u, 0u}; *(u32x4*)(TM + c * LDCc + 16) = zz; *(u32x4*)(TM + c * LDCc + 24) = zz; } }
}
__device__ __forceinline__ void tri_inv_part2(const float* LM, bf16_t* TM, const bf16_t* T11T, bf16_t* XT, int lane) {
    constexpr int LDLc = 36, LDCc = 40;
    typedef short s16x8_ __attribute__((ext_vector_type(8)));
    const int fr = lane & 15, fq = lane >> 4;
    s16x8_ a = {0, 0, 0, 0, 0, 0, 0, 0}, b = {0, 0, 0, 0, 0, 0, 0, 0};
    if (fq < 2) { const f32x4 l0 = *(const f32x4*)(LM + (16 + fr) * LDLc + 8 * fq), l1 = *(const f32x4*)(LM + (16 + fr) * LDLc + 8 * fq + 4);
        u32x4 w; w.x = pk2(l0[0], l0[1]); w.y = pk2(l0[2], l0[3]); w.z = pk2(l1[0], l1[1]); w.w = pk2(l1[2], l1[3]);
        a = __builtin_bit_cast(s16x8_, w); b = *(const s16x8_*)(T11T + fr * 16 + 8 * fq); }
    const f32x4 X = __builtin_amdgcn_mfma_f32_16x16x32_bf16(a, b, ((f32x4){0.f, 0.f, 0.f, 0.f}), 0, 0, 0);
    { uint2 o; o.x = pk2(X[0], X[1]); o.y = pk2(X[2], X[3]); *(uint2*)(XT + fr * 16 + fq * 4) = o; }
    asm volatile("s_waitcnt lgkmcnt(0)" ::: "memory");
    s16x8_ a2 = {0, 0, 0, 0, 0, 0, 0, 0}, b2 = {0, 0, 0, 0, 0, 0, 0, 0};
    if (fq < 2) { a2 = *(const s16x8_*)(XT + fr * 16 + 8 * fq); b2 = *(const s16x8_*)(TM + (16 + fr) * LDCc + 16 + 8 * fq); }
    const f32x4 O = __builtin_amdgcn_mfma_f32_16x16x32_bf16(a2, b2, ((f32x4){0.f, 0.f, 0.f, 0.f}), 0, 0, 0);
    { uint2 o; o.x = pk2(-O[0], -O[1]); o.y = pk2(-O[2], -O[3]); *(uint2*)(TM + (16 + fr) * LDCc + fq * 4) = o; }
}
constexpr int CH = 32, NCHUNK = (TC + TL) / CH;
typedef short s16x8 __attribute__((ext_vector_type(8)));
__device__ __forceinline__ float red16(float x) { x += dppf<0x140>(x); x += dppf<0x141>(x); x += dppf<0xB1>(x); x += dppf<0x4E>(x); return x; }
#define TROW(r) ((r) * LDC + ((r) >> 3) * 8)
#define MFMA16(a, b, c) __builtin_amdgcn_mfma_f32_16x16x32_bf16((a), (b), (c), 0, 0, 0)

constexpr int L_WR = 0, L_KD = 8192, L_V = 16384, L_W = 24576, L_BB = 32768, L_KK = 40960, L_THW = 49152  , L_THA = 55296, L_SC = 61440  , L_PRM = 61952  ;
__device__ __forceinline__ void phase_rwkv(const Params& P, unsigned char* smem) {
    const int tid = threadIdx.x;
    const bf16_t* P1 = (const bf16_t*)(P.ws + WS_X);
    bf16_t* YD = (bf16_t*)P.out;
    float* SBON = (float*)(P.ws + WS_M + MiB);
    float* A_wr = (float*)(smem + L_WR); float* A_kd = (float*)(smem + L_KD); float* A_v = (float*)(smem + L_V); float* A_w = (float*)(smem + L_W);
    float* A_bb = (float*)(smem + L_BB); float* A_kk = (float*)(smem + L_KK); bf16_t* TH_w = (bf16_t*)(smem + L_THW); bf16_t* TH_a = (bf16_t*)(smem + L_THA); float* SC = (float*)(smem + L_SC);
    float* PRM = (float*)(smem + L_PRM);
    const float* mu = P.in[8];
    for (int it = blockIdx.x; it < 256; it += gridDim.x) {
        const int b = it >> 5, h = (it >> 1) & 15, d = it & 1;
        float S[8];
#pragma unroll
        for (int j = 0; j < 8; ++j) S[j] = 0.f;
        s16x8 Bw[3], Ba[3];
        __syncthreads();
        { const int lane = tid & 63, wave = tid >> 6; const int cB = h * 64 + 16 * (wave & 3) + (lane & 15);
#pragma unroll
          for (int ks = 0; ks < 3; ++ks)
#pragma unroll
            for (int j = 0; j < 8; ++j) { const int k = ks * 32 + (lane >> 4) * 8 + j;
                Bw[ks][j] = (short)f2bf(P.in[10][((size_t)d * 96 + k) * 1024 + cB]); Ba[ks][j] = (short)f2bf(P.in[12][((size_t)d * 96 + k) * 1024 + cB]); }
          if (tid < 64) { PRM[tid] = P.in[14][h * 64 + tid]; PRM[64 + tid] = P.in[15][h * 64 + tid]; PRM[128 + tid] = P.in[16][h * 64 + tid]; } }
        const float w0c = P.in[9][d * 1024 + h * 64 + 16 * ((tid >> 6) & 3) + (tid & 15)], a0c = P.in[11][d * 1024 + h * 64 + 16 * ((tid >> 6) & 3) + (tid & 15)];
        unsigned pre[3][12];
        auto prefetch = [&](int ch) {
            const bool isctx = ch < 8;
            const int sbase = isctx ? ch * CH : (ch - 8) * CH, Tlen = isctx ? TC : TL;
            const int rowbase = isctx ? MLAT + b * TC : b * TL;
            const int t0 = d == 0 ? sbase : Tlen - 1 - sbase, sgn = d == 0 ? 1 : -1;
            const u32x4 zz = {0u, 0u, 0u, 0u};
            int qv = tid; asm volatile("" : "+v"(qv));
#pragma unroll
            for (int n = 0; n < 3; ++n) { const int s = qv + 512 * n, i = s / 48, cv = s % 48; const int t = t0 + sgn * i;
                const int col = cv < 8 ? h * 64 + 8 * cv : (cv < 16 ? 1024 + h * 64 + 8 * (cv - 8) : (cv < 24 ? 2048 + h * 64 + 8 * (cv - 16) : (cv < 36 ? 3072 + d * 96 + 8 * (cv - 24) : 3264 + d * 96 + 8 * (cv - 36))));
                const bf16_t* pp = P1 + (size_t)(rowbase + t) * LD1 + col;
                { const u32x4 pv_ = *(const u32x4*)pp; pre[n][0] = pv_.x; pre[n][1] = pv_.y; pre[n][2] = pv_.z; pre[n][3] = pv_.w; }
                const unsigned* pw = (const unsigned*)pp; constexpr int LW = LD1 / 2;
                if (isctx) { const bool vl = t > 0, vr = t < TC - 1;
                    const u32x4 L = vl ? *(const u32x4*)(pp - LD1) : zz, R = vr ? *(const u32x4*)(pp + LD1) : zz;
                    pre[n][4] = L.x; pre[n][5] = L.y; pre[n][6] = L.z; pre[n][7] = L.w; pre[n][8] = R.x; pre[n][9] = R.y; pre[n][10] = R.z; pre[n][11] = R.w; }
                else { const int x = t & 63, y = t >> 6; const bool vl = x > 0, vr = x < 63, vu = y > 0, vd = y < 31;
                    pre[n][4] = vl ? pw[-LW + 0] : 0u; pre[n][5] = vl ? pw[-LW + 2] : 0u; pre[n][6] = vr ? pw[LW + 0] : 0u; pre[n][7] = vr ? pw[LW + 2] : 0u;
                    pre[n][8] = vu ? pw[-64 * LW + 1] : 0u; pre[n][9] = vu ? pw[-64 * LW + 3] : 0u; pre[n][10] = vd ? pw[64 * LW + 1] : 0u; pre[n][11] = vd ? pw[64 * LW + 3] : 0u; } }
        };
        prefetch(0);
        for (int ch = 0; ch < NCHUNK; ++ch) {
            int qo = tid; asm volatile("" : "+v"(qo));
            const int lane_o = qo & 63, wave_o = qo >> 6;
            const bool isctx = ch < 8;
            const int sbase = isctx ? ch * CH : (ch - 8) * CH, Tlen = isctx ? TC : TL;
            const int rowbase = isctx ? MLAT + b * TC : b * TL;
            const int t0 = d == 0 ? sbase : Tlen - 1 - sbase, sgn = d == 0 ? 1 : -1;
#pragma unroll
            for (int n = 0; n < 3; ++n) { const int s = qo + 512 * n, i = s / 48, cv = s % 48;
                const int col = cv < 8 ? h * 64 + 8 * cv : (cv < 16 ? 1024 + h * 64 + 8 * (cv - 8) : (cv < 24 ? 2048 + h * 64 + 8 * (cv - 16) : (cv < 36 ? 3072 + d * 96 + 8 * (cv - 24) : 3264 + d * 96 + 8 * (cv - 36))));
                const f32x4 m0 = *(const f32x4*)(mu + col), m1 = *(const f32x4*)(mu + col + 4);
                float xs[8];
#pragma unroll
                for (int e = 0; e < 8; ++e) { const float p = __uint_as_float((e & 1) ? (pre[n][e >> 1] & 0xffff0000u) : (pre[n][e >> 1] << 16));
                    unsigned wv_; const bool hi = (e & 1);
                    if (isctx) wv_ = (e & 1) ? pre[n][8 + (e >> 1)] : pre[n][4 + (e >> 1)];
                    else wv_ = pre[n][4 + 2 * (e & 3) + (e >> 2)];
                    const float ps = __uint_as_float(hi ? (wv_ & 0xffff0000u) : (wv_ << 16));
                    xs[e] = p + (ps - p) * (e < 4 ? m0[e & 3] : m1[e & 3]); }
                if (cv < 24) { float* dst = (cv < 8 ? A_wr + i * 64 + 8 * cv : (cv < 16 ? A_kd + i * 64 + 8 * (cv - 8) : A_v + i * 64 + 8 * (cv - 16)));
                    *(f32x4*)dst = (f32x4){xs[0], xs[1], xs[2], xs[3]}; *(f32x4*)(dst + 4) = (f32x4){xs[4], xs[5], xs[6], xs[7]}; }
                else if (cv < 36) { u32x4 w; w.x = pk2(tanhf(xs[0]), tanhf(xs[1])); w.y = pk2(tanhf(xs[2]), tanhf(xs[3])); w.z = pk2(tanhf(xs[4]), tanhf(xs[5])); w.w = pk2(tanhf(xs[6]), tanhf(xs[7]));
                    *(u32x4*)(TH_w + i * 96 + 8 * (cv - 24)) = w; }
                else { u32x4 w; w.x = pk2(xs[0], xs[1]); w.y = pk2(xs[2], xs[3]); w.z = pk2(xs[4], xs[5]); w.w = pk2(xs[6], xs[7]);
                    *(u32x4*)(TH_a + i * 96 + 8 * (cv - 36)) = w; } }
            __syncthreads();
            { const int rt = wave_o >> 2, c = 16 * (wave_o & 3) + (lane_o & 15);
              f32x4 cw = {0.f, 0.f, 0.f, 0.f}, ca = {0.f, 0.f, 0.f, 0.f};
#pragma unroll
              for (int ks = 0; ks < 3; ++ks) { const int off = (rt * 16 + (lane_o & 15)) * 96 + ks * 32 + (lane_o >> 4) * 8;
                  const s16x8 fa = *(const s16x8*)(TH_w + off), fb = *(const s16x8*)(TH_a + off);
                  cw = MFMA16(fa, Bw[ks], cw); ca = MFMA16(fb, Ba[ks], ca); }
#pragma unroll
              for (int j = 0; j < 4; ++j) { const int i = rt * 16 + (lane_o >> 4) * 4 + j;
                  A_w[i * 64 + c] = __expf(-0.6065306597126334f * sigm(w0c + cw[j])); A_bb[i * 64 + c] = sigm(a0c + ca[j]); } }
            __syncthreads();
            if (qo < 256) {
                const int i = qo >> 3, cgp = qo & 7, j0 = 8 * cgp; float xr[8], xk[8], w[8], ic[8], kkw[8], kaw[8], rkw[8];
#pragma unroll
                for (int e = 0; e < 2; ++e) { const f32x4 a = *(const f32x4*)(A_wr + i * 64 + j0 + 4 * e), b2 = *(const f32x4*)(A_kd + i * 64 + j0 + 4 * e), c2 = *(const f32x4*)(A_w + i * 64 + j0 + 4 * e),
                        d2 = *(const f32x4*)(A_bb + i * 64 + j0 + 4 * e), e2 = *(const f32x4*)(PRM + j0 + 4 * e), f2 = *(const f32x4*)(PRM + 64 + j0 + 4 * e), g2 = *(const f32x4*)(PRM + 128 + j0 + 4 * e);
#pragma unroll
                    for (int x = 0; x < 4; ++x) { xr[4 * e + x] = a[x]; xk[4 * e + x] = b2[x]; w[4 * e + x] = c2[x]; ic[4 * e + x] = d2[x]; kkw[4 * e + x] = e2[x]; kaw[4 * e + x] = f2[x]; rkw[4 * e + x] = g2[x]; } }
                float ss = 0.f;
#pragma unroll
                for (int e = 0; e < 8; ++e) { const float kr_ = xk[e] * kkw[e]; ss += kr_ * kr_; }
                ss = red8(ss); const float rn = rsqrtf(ss + 1e-6f);
                float kk[8], kd[8], bb[8], br = 0.f, kr = 0.f, sb = 0.f;
#pragma unroll
                for (int e = 0; e < 8; ++e) { kk[e] = xk[e] * kkw[e] * rn; kd[e] = xk[e] * (1.f + (ic[e] - 1.f) * kaw[e]); bb[e] = kk[e] * ic[e];
                    br += bb[e] * xr[e]; kr += kd[e] * xr[e]; sb += xr[e] * kd[e] * rkw[e]; }
                br = red8(br); kr = red8(kr); sb = 0.5f * red8(sb);
#pragma unroll
                for (int e = 0; e < 2; ++e) {
                    *(f32x4*)(A_kk + i * 64 + j0 + 4 * e) = (f32x4){kk[4 * e], kk[4 * e + 1], kk[4 * e + 2], kk[4 * e + 3]};
                    *(f32x4*)(A_wr + i * 64 + j0 + 4 * e) = (f32x4){w[4 * e] * xr[4 * e], w[4 * e + 1] * xr[4 * e + 1], w[4 * e + 2] * xr[4 * e + 2], w[4 * e + 3] * xr[4 * e + 3]};
                    *(f32x4*)(A_kd + i * 64 + j0 + 4 * e) = (f32x4){kd[4 * e], kd[4 * e + 1], kd[4 * e + 2], kd[4 * e + 3]};
                    *(f32x4*)(A_bb + i * 64 + j0 + 4 * e) = (f32x4){bb[4 * e], bb[4 * e + 1], bb[4 * e + 2], bb[4 * e + 3]}; }
                if (cgp == 0) { SC[i * 4 + 0] = br; SC[i * 4 + 1] = kr; if (!isctx) SBON[((size_t)d * MLAT + rowbase + t0 + sgn * i) * 16 + h] = sb; }
            }
            __syncthreads();
            if (ch + 1 < NCHUNK) prefetch(ch + 1);
            { const int cgp = qo & 7, row = qo >> 3, j0 = 8 * cgp;
              bf16_t* yp = YD + ((size_t)d * MLAT + rowbase + t0) * 1024 + h * 64 + row;
              for (int i = 0; i < CH; ++i) {
                  float kk8[8], wr8[8], w8[8], bb8[8], kd8[8];
#pragma unroll
                  for (int e = 0; e < 2; ++e) { const f32x4 a = *(const f32x4*)(A_kk + i * 64 + j0 + 4 * e), b2 = *(const f32x4*)(A_wr + i * 64 + j0 + 4 * e), c2 = *(const f32x4*)(A_w + i * 64 + j0 + 4 * e),
                          d2 = *(const f32x4*)(A_bb + i * 64 + j0 + 4 * e), e2 = *(const f32x4*)(A_kd + i * 64 + j0 + 4 * e);
#pragma unroll
                      for (int x = 0; x < 4; ++x) { kk8[4 * e + x] = a[x]; wr8[4 * e + x] = b2[x]; w8[4 * e + x] = c2[x]; bb8[4 * e + x] = d2[x]; kd8[4 * e + x] = e2[x]; } }
                  const float v = A_v[i * 64 + row]; const float2 sc = *(const float2*)(SC + i * 4);
                  float sa = 0.f, pp = 0.f;
#pragma unroll
                  for (int j = 0; j < 8; ++j) { sa += S[j] * kk8[j]; pp += S[j] * wr8[j]; }
                  sa = red8(sa); pp = red8(pp);
                  const float y = pp - sa * sc.x + v * sc.y;
#pragma unroll
                  for (int j = 0; j < 8; ++j) S[j] = S[j] * w8[j] - sa * bb8[j] + v * kd8[j];
                  if (!isctx && cgp == 0) yp[(ptrdiff_t)sgn * i * 1024] = f2bf(y);
              } }
            __syncthreads();
        }
    }
}

constexpr int LDK = 136, LDC = 40, LDL = 36;
constexpr int G_RAW = 0, G_CW = 23040, G_SC = 29440, G_UQ = 29952, G_WK = 29952, G_VNT = 38656, G_UK = 46336, G_TM = 46336, G_QKM = 48896, G_LM = 51456, G_UV = 62720,
              G_KA = 70912, G_QA = 79616, G_QD = 88320, G_KGT = 97024, G_KTT = 107520, G_VT = 118016, G_ST = 123264, G_GC = 140672, G_T11T = 140928, G_XT = 141440;
__device__ __forceinline__ void phase_gdn(const Params& P, unsigned char* smem) {
    const int tid = threadIdx.x;
    const bf16_t* P1 = (const bf16_t*)(P.ws + WS_X);
    bf16_t* OD = (bf16_t*)P.out + (size_t)2 * MLAT * 1024;
    bf16_t* RAW = (bf16_t*)(smem + G_RAW); float* CW = (float*)(smem + G_CW); float* GSC = (float*)(smem + G_SC); float* UQ = (float*)(smem + G_UQ); float* UK = (float*)(smem + G_UK); float* UV = (float*)(smem + G_UV);
    bf16_t* WK = (bf16_t*)(smem + G_WK); bf16_t* VNT = (bf16_t*)(smem + G_VNT); bf16_t* TM = (bf16_t*)(smem + G_TM); bf16_t* QKM = (bf16_t*)(smem + G_QKM); float* LM = (float*)(smem + G_LM);
    bf16_t* KA = (bf16_t*)(smem + G_KA); bf16_t* QA = (bf16_t*)(smem + G_QA); bf16_t* QD = (bf16_t*)(smem + G_QD); bf16_t* KGT = (bf16_t*)(smem + G_KGT); bf16_t* KTT = (bf16_t*)(smem + G_KTT);
    bf16_t* VT = (bf16_t*)(smem + G_VT); bf16_t* ST = (bf16_t*)(smem + G_ST); float* GC = (float*)(smem + G_GC);
    for (int it = blockIdx.x; it < 256; it += gridDim.x) {
        const int b = it >> 5, hg = (it >> 2) & 7, d = (it >> 1) & 1, half = it & 1;
        f32x4 sacc[4];
#pragma unroll
        for (int nt = 0; nt < 4; ++nt) sacc[nt] = (f32x4){0.f, 0.f, 0.f, 0.f};
        __syncthreads();
        float cwr[5][8];
        { const int cv = tid % 40; const int ccol = cv < 16 ? hg * 128 + 8 * cv : (cv < 32 ? 1024 + hg * 128 + 8 * (cv - 16) : 2048 + hg * 128 + half * 64 + 8 * (cv - 32));
#pragma unroll
          for (int j = 0; j < 5; ++j) { const f32x4 c0 = *(const f32x4*)(P.in[19] + j * 3072 + ccol), c1 = *(const f32x4*)(P.in[19] + j * 3072 + ccol + 4);
#pragma unroll
              for (int x = 0; x < 4; ++x) { cwr[j][x] = c0[x]; cwr[j][4 + x] = c1[x]; } } }
        for (int e = tid; e < 64 * LDK / 2; e += 512) ((unsigned*)ST)[e] = 0u;
        const float alog = -__expf(P.in[20][d * 8 + hg]), dtb = P.in[21][d * 8 + hg];
        unsigned pre[3][4]; unsigned pab = 0;
        auto prefetch = [&](int ch) {
            const bool isctx = ch < 8;
            const int sbase = isctx ? ch * CH : (ch - 8) * CH, Tlen = isctx ? TC : TL;
            const int rowbase = isctx ? MLAT + b * TC : b * TL;
            const int t0 = d == 0 ? sbase : Tlen - 1 - sbase, sgn = d == 0 ? 1 : -1;
            const int lo = d == 0 ? sbase : Tlen - sbase - CH;
            const u32x4 zz = {0u, 0u, 0u, 0u};
            int qv = tid; asm volatile("" : "+v"(qv));
#pragma unroll
            for (int n = 0; n < 3; ++n) { const int s = qv + 512 * n, wt = s / 40, cv = s % 40; const int t = lo - 2 + wt;
                const int col = COL_CV + (cv < 16 ? hg * 128 + 8 * cv : (cv < 32 ? 1024 + hg * 128 + 8 * (cv - 16) : 2048 + hg * 128 + half * 64 + 8 * (cv - 32)));
                const u32x4 gv_ = (s < 1440 && t >= 0 && t < Tlen) ? *(const u32x4*)(P1 + (size_t)(rowbase + t) * LD1 + col) : zz; pre[n][0] = gv_.x; pre[n][1] = gv_.y; pre[n][2] = gv_.z; pre[n][3] = gv_.w; }
            if (qv < CH) { const int t = t0 + sgn * qv; const bf16_t* ro = P1 + (size_t)(rowbase + t) * LD1 + COL_AB;
                pab = (unsigned)ro[d * 8 + hg] | ((unsigned)ro[16 + d * 8 + hg] << 16); }
        };
        auto consumeA = [&]() {
            int qa = tid; asm volatile("" : "+v"(qa));
#pragma unroll
            for (int n = 0; n < 3; ++n) { const int s = qa + 512 * n; if (s < 1440) *(u32x4*)(RAW + s * 8) = (u32x4){pre[n][0], pre[n][1], pre[n][2], pre[n][3]}; }
            if (qa < CH) { const float a_raw = __uint_as_float(pab << 16), b_raw = __uint_as_float(pab & 0xffff0000u);
                const float xx = a_raw + dtb; const float sp = xx > 20.f ? xx : __logf(1.f + __expf(xx));
                GSC[qa * 4 + 0] = alog * sp; GSC[qa * 4 + 1] = sigm(b_raw); }
        };
        prefetch(0);
        consumeA();
        __syncthreads();
        for (int ch = 0; ch < NCHUNK; ++ch) {
            int qo = tid; asm volatile("" : "+v"(qo));
            const int lane = qo & 63, wave = qo >> 6, fr = lane & 15, fq = lane >> 4;
            const bool isctx = ch < 8;
            const int sbase = isctx ? ch * CH : (ch - 8) * CH, Tlen = isctx ? TC : TL;
            const int rowbase = isctx ? MLAT + b * TC : b * TL;
            const int t0 = d == 0 ? sbase : Tlen - 1 - sbase, sgn = d == 0 ? 1 : -1;
            if (ch + 1 < NCHUNK) prefetch(ch + 1);
            if (qo < 480) { const int cv = qo % 40, tg = qo / 40; const int ntok = tg < 8 ? 3 : 2, tok0 = tg < 8 ? 3 * tg : 24 + 2 * (tg - 8);
                u32x4 raw[7];
#pragma unroll
                for (int r = 0; r < 7; ++r) { const int rr = tok0 + r < 36 ? tok0 + r : 35; raw[r] = *(const u32x4*)(RAW + rr * 320 + 8 * cv); }
#pragma unroll
                for (int o = 0; o < 3; ++o) if (o < ntok) { float acc[8];
#pragma unroll
                    for (int e = 0; e < 8; ++e) { float a_ = 0.f;
#pragma unroll
                        for (int j = 0; j < 5; ++j) { const unsigned w_ = raw[o + j][e >> 1]; a_ += cwr[j][e] * __uint_as_float((e & 1) ? (w_ & 0xffff0000u) : (w_ << 16)); }
                        acc[e] = a_ * sigm(a_); }
                    const int wt_ = tok0 + o, i = (d == 0 ? wt_ : CH - 1 - wt_);
                    float* dst = cv < 16 ? UQ + i * 128 + 8 * cv : (cv < 32 ? UK + i * 128 + 8 * (cv - 16) : UV + i * 64 + 8 * (cv - 32));
                    *(f32x4*)dst = (f32x4){acc[0], acc[1], acc[2], acc[3]}; *(f32x4*)(dst + 4) = (f32x4){acc[4], acc[5], acc[6], acc[7]}; } }
            if (wave == 7) { float g = lane < CH ? GSC[lane * 4] : 0.f;
#pragma unroll
                for (int o = 1; o < 32; o <<= 1) { const float t = __shfl_up(g, o); if (lane >= o) g += t; }
                if (lane < CH) GC[lane] = g; }
            __syncthreads();
            { const int i = qo >> 4, cg = qo & 15, j0 = 8 * cg;
              float qv8[8], kv8[8];
#pragma unroll
              for (int e = 0; e < 2; ++e) { const f32x4 a = *(const f32x4*)(UQ + i * 128 + j0 + 4 * e), b2 = *(const f32x4*)(UK + i * 128 + j0 + 4 * e);
#pragma unroll
                  for (int x = 0; x < 4; ++x) { qv8[4 * e + x] = a[x]; kv8[4 * e + x] = b2[x]; } }
              float sq = 0.f, sk = 0.f;
#pragma unroll
              for (int e = 0; e < 8; ++e) { sq += qv8[e] * qv8[e]; sk += kv8[e] * kv8[e]; }
              sq = red16(sq); sk = red16(sk);
              const float rq = rsqrtf(sq + 1e-6f) * 0.08838834764831845f, rk = rsqrtf(sk + 1e-6f);
              const float gci = GC[i], gcl = GC[CH - 1], beta = GSC[i * 4 + 1];
              const float eg = __expf(gci), et = __expf(gcl - gci), bg = beta * eg;
              float vv[8];
              if (cg < 8) { const f32x4 a = *(const f32x4*)(UV + i * 64 + j0), b2 = *(const f32x4*)(UV + i * 64 + j0 + 4);
#pragma unroll
                  for (int x = 0; x < 4; ++x) { vv[x] = a[x]; vv[4 + x] = b2[x]; } }
#pragma unroll
              for (int e = 0; e < 8; ++e) { qv8[e] *= rq; kv8[e] *= rk; }
              u32x4 w;
              w.x = pk2(kv8[0], kv8[1]); w.y = pk2(kv8[2], kv8[3]); w.z = pk2(kv8[4], kv8[5]); w.w = pk2(kv8[6], kv8[7]); *(u32x4*)(KA + i * LDK + j0) = w;
              w.x = pk2(qv8[0], qv8[1]); w.y = pk2(qv8[2], qv8[3]); w.z = pk2(qv8[4], qv8[5]); w.w = pk2(qv8[6], qv8[7]); *(u32x4*)(QA + i * LDK + j0) = w;
              w.x = pk2(qv8[0] * eg, qv8[1] * eg); w.y = pk2(qv8[2] * eg, qv8[3] * eg); w.z = pk2(qv8[4] * eg, qv8[5] * eg); w.w = pk2(qv8[6] * eg, qv8[7] * eg); *(u32x4*)(QD + i * LDK + j0) = w;
#pragma unroll
              for (int e = 0; e < 8; ++e) { KGT[TROW(j0 + e) + i] = f2bf(kv8[e] * bg); KTT[TROW(j0 + e) + i] = f2bf(kv8[e] * et); }
              if (cg < 8) {
#pragma unroll
                  for (int e = 0; e < 8; ++e) VT[TROW(j0 + e) + i] = f2bf(vv[e] * beta); } }
            __syncthreads();
            { const int mt = (wave >> 1) & 1, nt = wave & 1; const bf16_t* Am = wave < 4 ? KA : QA;
              f32x4 acc = {0.f, 0.f, 0.f, 0.f};
#pragma unroll
              for (int ks = 0; ks < 4; ++ks) { const s16x8 a = *(const s16x8*)(KA + (nt * 16 + fr) * LDK + ks * 32 + fq * 8), bb = *(const s16x8*)(Am + (mt * 16 + fr) * LDK + ks * 32 + fq * 8);
                  acc = MFMA16(a, bb, acc); }
              const int i = mt * 16 + fr; const float gci = GC[i], bi = GSC[i * 4 + 1];
              const f32x4 gcj = *(const f32x4*)(GC + nt * 16 + fq * 4);
              float lv[4];
#pragma unroll
              for (int r = 0; r < 4; ++r) { const int j = nt * 16 + fq * 4 + r; const float dec = __expf(fminf(gci - gcj[r], 0.f));
                  lv[r] = wave < 4 ? ((i > j) ? bi * acc[r] * dec : 0.f) : ((i >= j) ? acc[r] * dec : 0.f); }
              if (wave < 4) *(f32x4*)(LM + i * LDL + nt * 16 + fq * 4) = (f32x4){lv[0], lv[1], lv[2], lv[3]};
              else { uint2 o; o.x = pk2(lv[0], lv[1]); o.y = pk2(lv[2], lv[3]); *(uint2*)(QKM + i * LDC + nt * 16 + fq * 4) = o; } }
            if (wave == 0 || wave == 3) { asm volatile("s_waitcnt lgkmcnt(0)" ::: "memory"); tri_inv_part1(LM, TM, (bf16_t*)(smem + G_T11T), wave == 0 ? 0 : 1, lane); }
            __syncthreads();
            if (wave == 0) tri_inv_part2(LM, TM, (const bf16_t*)(smem + G_T11T), (bf16_t*)(smem + G_XT), lane);
            __syncthreads();
            const int mtu = wave >> 2, ntu = wave & 3;
            f32x4 vacc;
            { const s16x8 a = *(const s16x8*)(TM + (mtu * 16 + fr) * LDC + fq * 8), bb = *(const s16x8*)(VT + TROW(ntu * 16 + fr) + fq * 8);
              vacc = MFMA16(a, bb, ((f32x4){0.f, 0.f, 0.f, 0.f}));
#pragma unroll
              for (int x = 0; x < 2; ++x) { const int tt = 2 * wave + x, mtk = tt >> 1, ntk = tt & 1;
                  const s16x8 a2 = *(const s16x8*)(KGT + TROW(mtk * 16 + fr) + fq * 8), b2 = *(const s16x8*)(TM + (ntk * 16 + fr) * LDC + fq * 8);
                  const f32x4 r = MFMA16(a2, b2, ((f32x4){0.f, 0.f, 0.f, 0.f}));
                  uint2 o; o.x = pk2(-r[0], -r[1]); o.y = pk2(-r[2], -r[3]);
                  *(uint2*)(WK + (ntk * 16 + fr) * LDK + mtk * 16 + fq * 4) = o; } }
            __syncthreads();
            f32x4 oacc = {0.f, 0.f, 0.f, 0.f};
#pragma unroll
            for (int ks = 0; ks < 4; ++ks) { const s16x8 bs = *(const s16x8*)(ST + (ntu * 16 + fr) * LDK + ks * 32 + fq * 8);
                const s16x8 aw = *(const s16x8*)(WK + (mtu * 16 + fr) * LDK + ks * 32 + fq * 8), aq = *(const s16x8*)(QD + (mtu * 16 + fr) * LDK + ks * 32 + fq * 8);
                vacc = MFMA16(aw, bs, vacc); oacc = MFMA16(aq, bs, oacc); }
            { uint2 o; o.x = pk2(vacc[0], vacc[1]); o.y = pk2(vacc[2], vacc[3]); *(uint2*)(VNT + (ntu * 16 + fr) * LDC + mtu * 16 + fq * 4) = o; }
            __syncthreads();
            { const s16x8 a = *(const s16x8*)(QKM + (mtu * 16 + fr) * LDC + fq * 8), bb = *(const s16x8*)(VNT + (ntu * 16 + fr) * LDC + fq * 8);
              oacc = MFMA16(a, bb, oacc);
              if (!isctx) { bf16_t* op = OD + ((size_t)d * MLAT + rowbase + t0) * 1024 + hg * 128 + half * 64 + ntu * 16 + fr;
#pragma unroll
                  for (int r = 0; r < 4; ++r) op[(ptrdiff_t)sgn * (mtu * 16 + fq * 4 + r) * 1024] = f2bf(oacc[r]); }
              const float gl = __expf(GC[CH - 1]);
              const s16x8 ak = *(const s16x8*)(KTT + TROW(wave * 16 + fr) + fq * 8);
#pragma unroll
              for (int nt = 0; nt < 4; ++nt) { const s16x8 bv = *(const s16x8*)(VNT + (nt * 16 + fr) * LDC + fq * 8);
                  sacc[nt] = MFMA16(ak, bv, sacc[nt] * gl);
                  uint2 o; o.x = pk2(sacc[nt][0], sacc[nt][1]); o.y = pk2(sacc[nt][2], sacc[nt][3]);
                  *(uint2*)(ST + (nt * 16 + fr) * LDK + wave * 16 + fq * 4) = o; } }
            if (ch + 1 < NCHUNK) consumeA();
            __syncthreads();
        }
    }
}

constexpr int LK2 = 72;
constexpr int R_WR = 0, R_KD = 8192, R_W = 16384, R_BB = 24576, R_LM = 0, R_TM = 4608, R_AKM = 7168, R_RKM = 9728, R_RBM = 12288, R_WM = 14848, R_X1T = 19456, R_NUT = 24576,
              R_V = 32768, R_THW = 40960, R_THA = 47104, R_GAM = 53248, R_PRM = 61440, R_AT = 62464, R_RT = 67072, R_KT = 71680, R_BT = 76288,
              R_ATT = 80896, R_KTT = 86144, R_BTT = 91392, R_VT = 96640, R_ST = 101888, R_T11T = 111104, R_XT = 111616;
__device__ __forceinline__ void phase_rwkv_chunked(const Params& P, unsigned char* smem) {
    const int tid = threadIdx.x;
    const bf16_t* P1 = (const bf16_t*)(P.ws + WS_X);
    bf16_t* YD = (bf16_t*)P.out;
    float* SBON = (float*)(P.ws + WS_M + MiB);
    float* A_wr = (float*)(smem + R_WR); float* A_kd = (float*)(smem + R_KD); float* A_w = (float*)(smem + R_W); float* A_bb = (float*)(smem + R_BB); float* A_v = (float*)(smem + R_V);
    bf16_t* TH_w = (bf16_t*)(smem + R_THW); bf16_t* TH_a = (bf16_t*)(smem + R_THA); float* GAM = (float*)(smem + R_GAM); float* PRM = (float*)(smem + R_PRM);
    float* LM = (float*)(smem + R_LM); bf16_t* TM = (bf16_t*)(smem + R_TM); bf16_t* AKM = (bf16_t*)(smem + R_AKM); bf16_t* RKM = (bf16_t*)(smem + R_RKM); bf16_t* RBM = (bf16_t*)(smem + R_RBM);
    bf16_t* WM = (bf16_t*)(smem + R_WM); bf16_t* X1T = (bf16_t*)(smem + R_X1T); bf16_t* NUT = (bf16_t*)(smem + R_NUT);
    bf16_t* AT = (bf16_t*)(smem + R_AT); bf16_t* RT = (bf16_t*)(smem + R_RT); bf16_t* KT = (bf16_t*)(smem + R_KT); bf16_t* BT = (bf16_t*)(smem + R_BT);
    bf16_t* ATT = (bf16_t*)(smem + R_ATT); bf16_t* KTT = (bf16_t*)(smem + R_KTT); bf16_t* BTT = (bf16_t*)(smem + R_BTT); bf16_t* VT = (bf16_t*)(smem + R_VT); bf16_t* ST = (bf16_t*)(smem + R_ST);
    const float* mu = P.in[8];
    for (int it = blockIdx.x; it < 256; it += gridDim.x) {
        const int b = it >> 5, h = (it >> 1) & 15, d = it & 1;
        f32x4 sacc[2];
        sacc[0] = (f32x4){0.f, 0.f, 0.f, 0.f}; sacc[1] = (f32x4){0.f, 0.f, 0.f, 0.f};
        s16x8 Bw[3], Ba[3];
        __syncthreads();
        { const int lane = tid & 63, wave = tid >> 6; const int cB = h * 64 + 16 * (wave & 3) + (lane & 15);
#pragma unroll
          for (int ks = 0; ks < 3; ++ks)
#pragma unroll
            for (int j = 0; j < 8; ++j) { const int k = ks * 32 + (lane >> 4) * 8 + j;
                Bw[ks][j] = (short)f2bf(P.in[10][((size_t)d * 96 + k) * 1024 + cB]); Ba[ks][j] = (short)f2bf(P.in[12][((size_t)d * 96 + k) * 1024 + cB]); }
          if (tid < 64) { PRM[tid] = P.in[14][h * 64 + tid]; PRM[64 + tid] = P.in[15][h * 64 + tid]; PRM[128 + tid] = P.in[16][h * 64 + tid]; }
          for (int e = tid; e < 64 * LK2 / 2; e += 512) ((unsigned*)ST)[e] = 0u; }
        const float w0c = P.in[9][d * 1024 + h * 64 + 16 * ((tid >> 6) & 3) + (tid & 15)], a0c = P.in[11][d * 1024 + h * 64 + 16 * ((tid >> 6) & 3) + (tid & 15)];
        unsigned pre[3][12];
        auto prefetch = [&](int ch) {
            const bool isctx = ch < 8;
            const int sbase = isctx ? ch * CH : (ch - 8) * CH, Tlen = isctx ? TC : TL;
            const int rowbase = isctx ? MLAT + b * TC : b * TL;
            const int t0 = d == 0 ? sbase : Tlen - 1 - sbase, sgn = d == 0 ? 1 : -1;
            const u32x4 zz = {0u, 0u, 0u, 0u};
            int qv = tid; asm volatile("" : "+v"(qv));
#pragma unroll
            for (int n = 0; n < 3; ++n) { const int ws = n * 8 + (qv >> 6), ln_ = qv & 63; const int L_ = (ws < 12 ? ws : (ws < 18 ? ws - 12 : ws - 18)) * 64 + ln_;
                const int i = ws < 12 ? L_ / 24 : L_ / 12, cv = ws < 12 ? L_ % 24 : (ws < 18 ? 24 + L_ % 12 : 36 + L_ % 12); const int t = t0 + sgn * i;
                const int col = cv < 8 ? h * 64 + 8 * cv : (cv < 16 ? 1024 + h * 64 + 8 * (cv - 8) : (cv < 24 ? 2048 + h * 64 + 8 * (cv - 16) : (cv < 36 ? 3072 + d * 96 + 8 * (cv - 24) : 3264 + d * 96 + 8 * (cv - 36))));
                const bf16_t* pp = P1 + (size_t)(rowbase + t) * LD1 + col;
                { const u32x4 pv_ = *(const u32x4*)pp; pre[n][0] = pv_.x; pre[n][1] = pv_.y; pre[n][2] = pv_.z; pre[n][3] = pv_.w; }
                const unsigned* pw = (const unsigned*)pp; constexpr int LW = LD1 / 2;
                if (isctx) { const bool vl = t > 0, vr = t < TC - 1;
                    const u32x4 L = vl ? *(const u32x4*)(pp - LD1) : zz, R = vr ? *(const u32x4*)(pp + LD1) : zz;
                    pre[n][4] = L.x; pre[n][5] = L.y; pre[n][6] = L.z; pre[n][7] = L.w; pre[n][8] = R.x; pre[n][9] = R.y; pre[n][10] = R.z; pre[n][11] = R.w; }
                else { const int x = t & 63, y = t >> 6; const bool vl = x > 0, vr = x < 63, vu = y > 0, vd = y < 31;
                    pre[n][4] = vl ? pw[-LW + 0] : 0u; pre[n][5] = vl ? pw[-LW + 2] : 0u; pre[n][6] = vr ? pw[LW + 0] : 0u; pre[n][7] = vr ? pw[LW + 2] : 0u;
                    pre[n][8] = vu ? pw[-64 * LW + 1] : 0u; pre[n][9] = vu ? pw[-64 * LW + 3] : 0u; pre[n][10] = vd ? pw[64 * LW + 1] : 0u; pre[n][11] = vd ? pw[64 * LW + 3] : 0u; } }
        };
        prefetch(0);
        for (int ch = 0; ch < NCHUNK; ++ch) {
            int qo = tid; asm volatile("" : "+v"(qo));
            const int lane = qo & 63, wave = qo >> 6, fr = lane & 15, fq = lane >> 4;
            const bool isctx = ch < 8;
            const int sbase = isctx ? ch * CH : (ch - 8) * CH, Tlen = isctx ? TC : TL;
            const int rowbase = isctx ? MLAT + b * TC : b * TL;
            const int t0 = d == 0 ? sbase : Tlen - 1 - sbase, sgn = d == 0 ? 1 : -1;
#pragma unroll
            for (int n = 0; n < 3; ++n) { const int ws = n * 8 + wave; const int L_ = (ws < 12 ? ws : (ws < 18 ? ws - 12 : ws - 18)) * 64 + lane;
                const int i = ws < 12 ? L_ / 24 : L_ / 12, cv = ws < 12 ? L_ % 24 : (ws < 18 ? 24 + L_ % 12 : 36 + L_ % 12);
                const int col = cv < 8 ? h * 64 + 8 * cv : (cv < 16 ? 1024 + h * 64 + 8 * (cv - 8) : (cv < 24 ? 2048 + h * 64 + 8 * (cv - 16) : (cv < 36 ? 3072 + d * 96 + 8 * (cv - 24) : 3264 + d * 96 + 8 * (cv - 36))));
                const f32x4 m0 = *(const f32x4*)(mu + col), m1 = *(const f32x4*)(mu + col + 4);
                float xs[8];
#pragma unroll
                for (int e = 0; e < 8; ++e) { const float p = __uint_as_float((e & 1) ? (pre[n][e >> 1] & 0xffff0000u) : (pre[n][e >> 1] << 16));
                    unsigned wv_; const bool hi = (e & 1);
                    if (isctx) wv_ = (e & 1) ? pre[n][8 + (e >> 1)] : pre[n][4 + (e >> 1)];
                    else wv_ = pre[n][4 + 2 * (e & 3) + (e >> 2)];
                    const float ps = __uint_as_float(hi ? (wv_ & 0xffff0000u) : (wv_ << 16));
                    xs[e] = p + (ps - p) * (e < 4 ? m0[e & 3] : m1[e & 3]); }
                if (cv < 24) { float* dst = (cv < 8 ? A_wr + i * 64 + 8 * cv : (cv < 16 ? A_kd + i * 64 + 8 * (cv - 8) : A_v + i * 64 + 8 * (cv - 16)));
                    *(f32x4*)dst = (f32x4){xs[0], xs[1], xs[2], xs[3]}; *(f32x4*)(dst + 4) = (f32x4){xs[4], xs[5], xs[6], xs[7]}; }
                else if (cv < 36) { u32x4 w; w.x = pk2(tanh_fast(xs[0]), tanh_fast(xs[1])); w.y = pk2(tanh_fast(xs[2]), tanh_fast(xs[3])); w.z = pk2(tanh_fast(xs[4]), tanh_fast(xs[5])); w.w = pk2(tanh_fast(xs[6]), tanh_fast(xs[7]));
                    *(u32x4*)(TH_w + i * 96 + 8 * (cv - 24)) = w; }
                else { u32x4 w; w.x = pk2(xs[0], xs[1]); w.y = pk2(xs[2], xs[3]); w.z = pk2(xs[4], xs[5]); w.w = pk2(xs[6], xs[7]);
                    *(u32x4*)(TH_a + i * 96 + 8 * (cv - 36)) = w; } }
            __syncthreads();
            if (ch + 1 < NCHUNK) prefetch(ch + 1);
            if (wave < 4) { const int c = 16 * wave + fr;
              float wv[2][4];
#pragma unroll
              for (int rt = 0; rt < 2; ++rt) { f32x4 cw = {0.f, 0.f, 0.f, 0.f}, ca = {0.f, 0.f, 0.f, 0.f};
#pragma unroll
                  for (int ks = 0; ks < 3; ++ks) { const int off = (rt * 16 + fr) * 96 + ks * 32 + fq * 8;
                      const s16x8 fa = *(const s16x8*)(TH_w + off), fb = *(const s16x8*)(TH_a + off);
                      cw = MFMA16(fa, Bw[ks], cw); ca = MFMA16(fb, Ba[ks], ca); }
#pragma unroll
                  for (int j = 0; j < 4; ++j) { const int i = rt * 16 + fq * 4 + j;
                      wv[rt][j] = __expf(-0.6065306597126334f * sigm(w0c + cw[j])); A_bb[i * 64 + c] = sigm(a0c + ca[j]); } }
              float tot[2];
#pragma unroll
              for (int rt = 0; rt < 2; ++rt) { wv[rt][1] *= wv[rt][0]; wv[rt][2] *= wv[rt][1]; wv[rt][3] *= wv[rt][2];
                  float sx = wv[rt][3]; float u1 = __shfl_up(sx, 16); if (fq >= 1) sx *= u1; float u2 = __shfl_up(sx, 32); if (fq >= 2) sx *= u2;
                  float ex = __shfl_up(sx, 16); if (fq == 0) ex = 1.f;
                  tot[rt] = __shfl(sx, 48 + fr);
                  const float base = ex * (rt == 1 ? tot[0] : 1.f);
#pragma unroll
                  for (int j = 0; j < 4; ++j) GAM[(rt * 16 + fq * 4 + j) * 64 + c] = base * wv[rt][j]; } }
            __syncthreads();
            { const int i = qo >> 4, cg = qo & 15, j0 = 4 * cg;
              const f32x4 xr = *(const f32x4*)(A_wr + i * 64 + j0), xk = *(const f32x4*)(A_kd + i * 64 + j0), ic = *(const f32x4*)(A_bb + i * 64 + j0), xv = *(const f32x4*)(A_v + i * 64 + j0);
              const f32x4 kkw = *(const f32x4*)(PRM + j0), kaw = *(const f32x4*)(PRM + 64 + j0), rkw = *(const f32x4*)(PRM + 128 + j0);
              const f32x4 gi = *(const f32x4*)(GAM + i * 64 + j0), gl = *(const f32x4*)(GAM + 31 * 64 + j0);
              f32x4 gp = {1.f, 1.f, 1.f, 1.f}; if (i > 0) gp = *(const f32x4*)(GAM + (i - 1) * 64 + j0);
              const f32x4 kkr = xk * kkw;
              const float ss = red16(kkr[0] * kkr[0] + kkr[1] * kkr[1] + kkr[2] * kkr[2] + kkr[3] * kkr[3]);
              const f32x4 kk = kkr * rsqrtf(ss + 1e-6f);
              f32x4 kd, bb, at, rt_, kt, bt, ktl, btl; float sbp = 0.f;
#pragma unroll
              for (int e = 0; e < 4; ++e) { kd[e] = xk[e] * (1.f + (ic[e] - 1.f) * kaw[e]); bb[e] = kk[e] * ic[e]; sbp += xr[e] * kd[e] * rkw[e];
                  const float ig = __builtin_amdgcn_rcpf(gi[e]); at[e] = kk[e] * gp[e]; rt_[e] = xr[e] * gi[e]; kt[e] = kd[e] * ig; bt[e] = bb[e] * ig; ktl[e] = kt[e] * gl[e]; btl[e] = bt[e] * gl[e]; }
              const float sb = 0.5f * red16(sbp);
              if (cg == 0 && !isctx) SBON[((size_t)d * MLAT + rowbase + t0 + sgn * i) * 16 + h] = sb;
              uint2 o;
              o.x = pk2(at[0], at[1]); o.y = pk2(at[2], at[3]); *(uint2*)(AT + i * LK2 + j0) = o;
              o.x = pk2(rt_[0], rt_[1]); o.y = pk2(rt_[2], rt_[3]); *(uint2*)(RT + i * LK2 + j0) = o;
              o.x = pk2(kt[0], kt[1]); o.y = pk2(kt[2], kt[3]); *(uint2*)(KT + i * LK2 + j0) = o;
              o.x = pk2(bt[0], bt[1]); o.y = pk2(bt[2], bt[3]); *(uint2*)(BT + i * LK2 + j0) = o;
#pragma unroll
              for (int e = 0; e < 4; ++e) { ATT[TROW(j0 + e) + i] = f2bf(at[e]); KTT[TROW(j0 + e) + i] = f2bf(ktl[e]); BTT[TROW(j0 + e) + i] = f2bf(btl[e]); VT[TROW(j0 + e) + i] = f2bf(xv[e]); } }
            __syncthreads();
#pragma unroll
            for (int x = 0; x < 2; ++x) { const int t = 2 * wave + x, m = t >> 2, mt = (t >> 1) & 1, nt = t & 1;
                const bf16_t* Am = m < 2 ? AT : RT; const bf16_t* Bm = (m == 0 || m == 3) ? BT : KT;
                f32x4 acc = {0.f, 0.f, 0.f, 0.f};
#pragma unroll
                for (int ks = 0; ks < 2; ++ks) { const s16x8 a = *(const s16x8*)(Bm + (nt * 16 + fr) * LK2 + ks * 32 + fq * 8), bb2 = *(const s16x8*)(Am + (mt * 16 + fr) * LK2 + ks * 32 + fq * 8);
                    acc = MFMA16(a, bb2, acc); }
                const int i = mt * 16 + fr; float lv[4];
#pragma unroll
                for (int r = 0; r < 4; ++r) { const int j = nt * 16 + fq * 4 + r; lv[r] = (m < 2 ? (i > j) : (i >= j)) ? acc[r] : 0.f; }
                if (m == 0) *(f32x4*)(LM + i * LDL + nt * 16 + fq * 4) = (f32x4){lv[0], lv[1], lv[2], lv[3]};
                else { bf16_t* dstm = m == 1 ? AKM : (m == 2 ? RKM : RBM); uint2 o; o.x = pk2(lv[0], lv[1]); o.y = pk2(lv[2], lv[3]); *(uint2*)(dstm + i * LDC + nt * 16 + fq * 4) = o; } }
            if (wave < 2) { asm volatile("s_waitcnt lgkmcnt(0)" ::: "memory"); tri_inv_part1(LM, TM, (bf16_t*)(smem + R_T11T), wave, lane); }
            __syncthreads();
            if (wave == 0) tri_inv_part2(LM, TM, (const bf16_t*)(smem + R_T11T), (bf16_t*)(smem + R_XT), lane);
            else {
                const int ntile = (wave == 1) ? 2 : 1;
                for (int q2 = 0; q2 < ntile; ++q2) { const int tl = (q2 == 0) ? wave : 0; const int mt = tl >> 2, nt = tl & 3;
                    const s16x8 a = *(const s16x8*)(AKM + (mt * 16 + fr) * LDC + fq * 8), bb2 = *(const s16x8*)(VT + TROW(nt * 16 + fr) + fq * 8);
                    const f32x4 r = MFMA16(a, bb2, ((f32x4){0.f, 0.f, 0.f, 0.f}));
                    uint2 o; o.x = pk2(r[0], r[1]); o.y = pk2(r[2], r[3]); *(uint2*)(X1T + (nt * 16 + fr) * LDC + mt * 16 + fq * 4) = o; }
            }
            __syncthreads();
            const int mtu = wave >> 2, ntu = wave & 3;
            f32x4 uacc;
            { const s16x8 a = *(const s16x8*)(TM + (mtu * 16 + fr) * LDC + fq * 8), bb2 = *(const s16x8*)(X1T + (ntu * 16 + fr) * LDC + fq * 8);
              uacc = MFMA16(a, bb2, ((f32x4){0.f, 0.f, 0.f, 0.f}));
              const int kt_ = wave >> 1, it_ = wave & 1;
              const s16x8 a2 = *(const s16x8*)(ATT + TROW(kt_ * 16 + fr) + fq * 8), b2 = *(const s16x8*)(TM + (it_ * 16 + fr) * LDC + fq * 8);
              const f32x4 r = MFMA16(a2, b2, ((f32x4){0.f, 0.f, 0.f, 0.f}));
              uint2 o; o.x = pk2(r[0], r[1]); o.y = pk2(r[2], r[3]); *(uint2*)(WM + (it_ * 16 + fr) * LK2 + kt_ * 16 + fq * 4) = o; }
            __syncthreads();
            f32x4 yacc = {0.f, 0.f, 0.f, 0.f};
#pragma unroll
            for (int ks = 0; ks < 2; ++ks) { const s16x8 bs = *(const s16x8*)(ST + (ntu * 16 + fr) * LK2 + ks * 32 + fq * 8);
                const s16x8 aw = *(const s16x8*)(WM + (mtu * 16 + fr) * LK2 + ks * 32 + fq * 8), ar = *(const s16x8*)(RT + (mtu * 16 + fr) * LK2 + ks * 32 + fq * 8);
                uacc = MFMA16(aw, bs, uacc); yacc = MFMA16(ar, bs, yacc); }
            { const s16x8 a = *(const s16x8*)(RKM + (mtu * 16 + fr) * LDC + fq * 8), bb2 = *(const s16x8*)(VT + TROW(ntu * 16 + fr) + fq * 8);
              yacc = MFMA16(a, bb2, yacc);
              uint2 o; o.x = pk2(-uacc[0], -uacc[1]); o.y = pk2(-uacc[2], -uacc[3]); *(uint2*)(NUT + (ntu * 16 + fr) * LDC + mtu * 16 + fq * 4) = o; }
            __syncthreads();
            { const s16x8 a = *(const s16x8*)(RBM + (mtu * 16 + fr) * LDC + fq * 8), bb2 = *(const s16x8*)(NUT + (ntu * 16 + fr) * LDC + fq * 8);
              yacc = MFMA16(a, bb2, yacc);
              if (!isctx) { bf16_t* yp = YD + ((size_t)d * MLAT + rowbase + t0) * 1024 + h * 64 + ntu * 16 + fr;
#pragma unroll
                  for (int r = 0; r < 4; ++r) yp[(ptrdiff_t)sgn * (mtu * 16 + fq * 4 + r) * 1024] = f2bf(yacc[r]); }
              const int kt_ = wave >> 1;
              const f32x4 gl = *(const f32x4*)(GAM + 31 * 64 + kt_ * 16 + fq * 4);
              const s16x8 ak = *(const s16x8*)(KTT + TROW(kt_ * 16 + fr) + fq * 8), ab = *(const s16x8*)(BTT + TROW(kt_ * 16 + fr) + fq * 8);
#pragma unroll
              for (int x = 0; x < 2; ++x) { const int vt = 2 * (wave & 1) + x;
                  const s16x8 bv = *(const s16x8*)(VT + TROW(vt * 16 + fr) + fq * 8), bu = *(const s16x8*)(NUT + (vt * 16 + fr) * LDC + fq * 8);
                  sacc[x] = MFMA16(ak, bv, sacc[x] * gl); sacc[x] = MFMA16(ab, bu, sacc[x]);
                  uint2 o; o.x = pk2(sacc[x][0], sacc[x][1]); o.y = pk2(sacc[x][2], sacc[x][3]);
                  *(uint2*)(ST + (vt * 16 + fr) * LK2 + kt_ * 16 + fq * 4) = o; } }
            __syncthreads();
        }
    }
}


__device__ __forceinline__ void mix8_lat(const bf16_t* P1, int row, int col0, const float* mu, float (&xs)[8]) {
    const int t = row & (TL - 1), x = t & 63, y = t >> 6; const bool vl = x > 0, vr = x < 63, vu = y > 0, vd = y < 31;
    const bf16_t* pp = P1 + (size_t)row * LD1 + col0; const unsigned* pw = (const unsigned*)pp; constexpr int LW = LD1 / 2;
    const u32x4 pv = *(const u32x4*)pp;
    unsigned nb[8];
    nb[0] = vl ? pw[-LW + 0] : 0u; nb[1] = vl ? pw[-LW + 2] : 0u; nb[2] = vr ? pw[LW + 0] : 0u; nb[3] = vr ? pw[LW + 2] : 0u;
    nb[4] = vu ? pw[-64 * LW + 1] : 0u; nb[5] = vu ? pw[-64 * LW + 3] : 0u; nb[6] = vd ? pw[64 * LW + 1] : 0u; nb[7] = vd ? pw[64 * LW + 3] : 0u;
    const f32x4 m0 = *(const f32x4*)(mu + col0), m1 = *(const f32x4*)(mu + col0 + 4);
#pragma unroll
    for (int e = 0; e < 8; ++e) { const float p = __uint_as_float((e & 1) ? (pv[e >> 1] & 0xffff0000u) : (pv[e >> 1] << 16));
        const unsigned w_ = nb[2 * (e & 3) + (e >> 2)]; const float ps = __uint_as_float((e & 1) ? (w_ & 0xffff0000u) : (w_ << 16));
        xs[e] = p + (ps - p) * (e < 4 ? m0[e & 3] : m1[e & 3]); }
}
__device__ __forceinline__ void phase_sg(const Params& P) {
    const bf16_t* P1 = (const bf16_t*)(P.ws + WS_X); bf16_t* SG = (bf16_t*)(P.ws + WS_A + 32 * MiB);
    const int gt = blockIdx.x * 512 + threadIdx.x, NT = gridDim.x * 512;
    for (int s = gt; s < MLAT * 32; s += NT) { const int row = s >> 5, k8 = s & 31;
        u32x4 w = {0u, 0u, 0u, 0u};
        if (k8 < 8) { float xs[8]; mix8_lat(P1, row, 3456 + 8 * k8, P.in[8], xs);
            w.x = pk2(sigm(xs[0]), sigm(xs[1])); w.y = pk2(sigm(xs[2]), sigm(xs[3])); w.z = pk2(sigm(xs[4]), sigm(xs[5])); w.w = pk2(sigm(xs[6]), sigm(xs[7])); }
        *(u32x4*)(SG + (size_t)row * 256 + 8 * k8) = w; }
}
__device__ __forceinline__ void phase_readout_rwkv(const Params& P) {
    const bf16_t* P1 = (const bf16_t*)(P.ws + WS_X); const bf16_t* YD = (const bf16_t*)P.out; const float* SBON = (const float*)(P.ws + WS_M + MiB);
    bf16_t* OA = (bf16_t*)(P.ws + WS_A);
    const float* lnw = P.in[17]; const float* lnb = P.in[18];
    const int gt = blockIdx.x * 512 + threadIdx.x, NT = gridDim.x * 512;
    for (int s = gt; s < MLAT * 128; s += NT) { const int row = s >> 7, cv = s & 127, c0 = 8 * cv, hd = cv >> 3;
        const u32x4 y0 = *(const u32x4*)(YD + (size_t)row * 1024 + c0), y1 = *(const u32x4*)(YD + ((size_t)MLAT + row) * 1024 + c0), gg = *(const u32x4*)(OA + (size_t)row * 1024 + c0);
        float xv[8]; mix8_lat(P1, row, 2048 + c0, P.in[8], xv);
        const float sb = SBON[(size_t)row * 16 + hd] + SBON[((size_t)MLAT + row) * 16 + hd];
        const f32x4 w0 = *(const f32x4*)(lnw + c0), w1 = *(const f32x4*)(lnw + c0 + 4), b0 = *(const f32x4*)(lnb + c0), b1 = *(const f32x4*)(lnb + c0 + 4);
        float y[8], sum = 0.f;
#pragma unroll
        for (int e = 0; e < 8; ++e) { const unsigned a_ = y0[e >> 1], b_ = y1[e >> 1];
            y[e] = __uint_as_float((e & 1) ? (a_ & 0xffff0000u) : (a_ << 16)) + __uint_as_float((e & 1) ? (b_ & 0xffff0000u) : (b_ << 16)); sum += y[e]; }
        const float m = red8(sum) * (1.f / 64.f); float vs = 0.f;
#pragma unroll
        for (int e = 0; e < 8; ++e) { y[e] -= m; vs += y[e] * y[e]; }
        const float rs = rsqrtf(red8(vs) * (1.f / 64.f) + 64e-5f);
        float o[8];
#pragma unroll
        for (int e = 0; e < 8; ++e) { const unsigned g_ = gg[e >> 1]; const float gate = __uint_as_float((e & 1) ? (g_ & 0xffff0000u) : (g_ << 16));
            o[e] = (y[e] * rs * (e < 4 ? w0[e & 3] : w1[e & 3]) + (e < 4 ? b0[e & 3] : b1[e & 3]) + sb * xv[e]) * gate; }
        u32x4 w; w.x = pk2(o[0], o[1]); w.y = pk2(o[2], o[3]); w.z = pk2(o[4], o[5]); w.w = pk2(o[6], o[7]);
        *(u32x4*)(OA + (size_t)row * 1024 + c0) = w; }
}
__device__ __forceinline__ void phase_readout(const Params& P, unsigned char* smem) {
    const int tid = threadIdx.x, lane = tid & 63, wave = tid >> 6;
    const bf16_t* P1 = (const bf16_t*)(P.ws + WS_X); const bf16_t* P2 = (const bf16_t*)(P.ws + WS_D);
    const bf16_t* YD = (const bf16_t*)P.out; const bf16_t* OD = YD + (size_t)2 * MLAT * 1024;
    const float* SBON = (const float*)(P.ws + WS_M + MiB);
    bf16_t* OA = (bf16_t*)(P.ws + WS_A); bf16_t* OB = (bf16_t*)(P.ws + WS_F);
    const float* mu = P.in[8];
    { const int gw = blockIdx.x * 8 + wave, NGW = gridDim.x * 8; const float* nw = P.in[22];
      for (int row = gw; row < MLAT; row += NGW) { const int c0 = lane * 16;
        const u32x4 a0 = *(const u32x4*)(OD + (size_t)row * 1024 + c0), a1 = *(const u32x4*)(OD + (size_t)row * 1024 + c0 + 8);
        const u32x4 b0 = *(const u32x4*)(OD + ((size_t)MLAT + row) * 1024 + c0), b1 = *(const u32x4*)(OD + ((size_t)MLAT + row) * 1024 + c0 + 8);
        const u32x4 z0 = *(const u32x4*)(P2 + (size_t)row * LD2 + c0), z1 = *(const u32x4*)(P2 + (size_t)row * LD2 + c0 + 8);
        float o[16], z[16];
#pragma unroll
        for (int e = 0; e < 4; ++e) { o[2 * e] = __uint_as_float(a0[e] << 16) + __uint_as_float(b0[e] << 16); o[2 * e + 1] = __uint_as_float(a0[e] & 0xffff0000u) + __uint_as_float(b0[e] & 0xffff0000u);
            o[8 + 2 * e] = __uint_as_float(a1[e] << 16) + __uint_as_float(b1[e] << 16); o[8 + 2 * e + 1] = __uint_as_float(a1[e] & 0xffff0000u) + __uint_as_float(b1[e] & 0xffff0000u);
            z[2 * e] = __uint_as_float(z0[e] << 16); z[2 * e + 1] = __uint_as_float(z0[e] & 0xffff0000u); z[8 + 2 * e] = __uint_as_float(z1[e] << 16); z[8 + 2 * e + 1] = __uint_as_float(z1[e] & 0xffff0000u); }
        float ss = 0.f;
#pragma unroll
        for (int e = 0; e < 16; ++e) ss += o[e] * o[e];
        ss = red8(ss);
        const float rs = rsqrtf(ss * (1.f / 128.f) + 1e-6f);
        float r[16];
#pragma unroll
        for (int e = 0; e < 16; ++e) r[e] = o[e] * rs * nw[(c0 + e) & 127] * (z[e] * sigm(z[e]));
        u32x4 w0, w1;
#pragma unroll
        for (int e = 0; e < 4; ++e) { w0[e] = pk2(r[2 * e], r[2 * e + 1]); w1[e] = pk2(r[8 + 2 * e], r[8 + 2 * e + 1]); }
        *(u32x4*)(OB + (size_t)row * 1024 + c0) = w0; *(u32x4*)(OB + (size_t)row * 1024 + c0 + 8) = w1; } }
}

__global__ void __launch_bounds__(512, 2) fwd_mega(Params P) {
    extern __shared__ __attribute__((aligned(16))) unsigned char smem[];
    cg::grid_group grid = cg::this_grid();
    bf16_t* WT_IN = (bf16_t*)(P.ws + WS_A); bf16_t* WT_PA = (bf16_t*)(P.ws + WS_B); bf16_t* WT_PB = WT_PA + 2048 * 1024; bf16_t* WT_OUT = WT_PB + 2048 * 1024;
    bf16_t* P1 = (bf16_t*)(P.ws + WS_X); bf16_t* P2 = (bf16_t*)(P.ws + WS_D); bf16_t* H = (bf16_t*)P.out;
    bf16_t* OA = (bf16_t*)(P.ws + WS_A); bf16_t* OB = (bf16_t*)(P.ws + WS_F); bf16_t* MBUF = (bf16_t*)(P.ws + WS_X); bf16_t* A3 = (bf16_t*)(P.ws + WS_X);
    bf16_t* H2 = (bf16_t*)(P.ws + WS_D); bf16_t* WT_GU = (bf16_t*)(P.ws + WS_A); bf16_t* WT_DN = (bf16_t*)(P.ws + WS_F);
    const float* MOD = (const float*)(P.ws + WS_M);
#define PHASE(n) if (P.ph_lo <= (n) && (n) < P.ph_hi)
#define SEAM(n) do { if (P.coop && P.ph_lo <= (n) && (n) + 1 < P.ph_hi) grid.sync(); } while (0)
    PHASE(0) { phase_prep(P, smem); } SEAM(0);
    PHASE(1) { phase_norm1(P); } SEAM(1);
    PHASE(2) { EpiBf16Plain e1{P1, LD1}; run_gemm(smem, H, WT_IN, MALL, N1, D, e1);
               EpiBf16Plain e2{P2, LD2}; run_gemm(smem, H, WT_IN + (size_t)N1 * D, MLAT, N2, D, e2); } SEAM(2);
    PHASE(3) { phase_sg(P); phase_rwkv_chunked(P, smem); }
    PHASE(4) { phase_gdn(P, smem); } SEAM(4);
    PHASE(5) { EpiBf16Plain eg{OA, 1024}; run_gemm(smem, (const bf16_t*)(P.ws + WS_A + 32 * MiB), (const bf16_t*)(P.ws + WS_M + MiB / 2), MLAT, 1024, 256, eg); phase_readout(P, smem); } SEAM(5);
    PHASE(6) { phase_readout_rwkv(P); } SEAM(6);
    PHASE(7) { EpiGate<false> ea{MBUF, P2 + 1024}; run_gemm(smem, OA, WT_PA, MLAT, D, 1024, ea);
               EpiGate<true> eb{MBUF, P2 + 1024 + 2048}; run_gemm(smem, OB, WT_PB, MLAT, D, 1024, eb); } SEAM(7);
    PHASE(8) { EpiRes e{P.out, P.in[0], MOD + 2 * D}; run_gemm(smem, MBUF, WT_OUT, MLAT, D, D, e); } SEAM(8);
    PHASE(9) { phase_norm2(P); phase_ffn_weights(P, smem); } SEAM(9);
    PHASE(10) { EpiSwiglu e{A3}; run_gemm(smem, H2, WT_GU, MLAT, 2 * FFH, D, e); } SEAM(10);
    PHASE(11) { EpiRes e{P.out, P.out, MOD + 5 * D}; run_gemm(smem, A3, WT_DN, MLAT, D, FFH, e); } SEAM(11);
    PHASE(12) { phase_final_norm(P); }
}

#ifndef N_LAUNCH_PER_PHASE
#define N_LAUNCH_PER_PHASE 0
#endif
#ifndef PROBE_SEQ
#define PROBE_SEQ {0,1,2,3,4,5,6,7,8,9,10,11,12}
#endif
extern "C" void kernel_launch(void* const* d_in, const int* in_sizes, int n_in, void* d_out, int out_size, void* d_ws, size_t ws_size, hipStream_t stream) {
    static int grid = 0;
    if (grid == 0) {
        if (n_in != 30 || out_size != MLAT * D || ws_size < WS_END) { fprintf(stderr, "kernel_launch: unexpected shapes: n_in %d out %d ws %zu (need %zu)\n", n_in, out_size, ws_size, (size_t)WS_END); grid = -1; return; }
        int dev = 0, cus = 0, per_cu = 0;
        if (hipGetDevice(&dev) != hipSuccess || hipDeviceGetAttribute(&cus, hipDeviceAttributeMultiprocessorCount, dev) != hipSuccess) { grid = -1; return; }
        if (hipFuncSetAttribute((const void*)fwd_mega, hipFuncAttributeMaxDynamicSharedMemorySize, LDS_BYTES) != hipSuccess) { fprintf(stderr, "kernel_launch: hipFuncSetAttribute failed\n"); grid = -1; return; }
        if (hipOccupancyMaxActiveBlocksPerMultiprocessor(&per_cu, (const void*)fwd_mega, 512, LDS_BYTES) != hipSuccess || per_cu < 1) { fprintf(stderr, "kernel_launch: occupancy query gives %d\n", per_cu); grid = -1; return; }
        grid = cus * per_cu; if (grid > 256) grid = 256;
    }
    if (grid < 0) return;
    Params p{};
    for (int i = 0; i < 30; ++i) p.in[i] = (const float*)d_in[i];
    p.out = (float*)d_out; p.ws = (unsigned char*)d_ws;
#if N_LAUNCH_PER_PHASE
    { const int seq[] = PROBE_SEQ; for (int si = 0; si < (int)(sizeof(seq) / sizeof(int)); ++si) { const int ph = seq[si]; p.ph_lo = ph; p.ph_hi = ph + 1; p.coop = 0; hipLaunchKernelGGL(fwd_mega, dim3(grid), dim3(512), LDS_BYTES, stream, p); } }
#else
    p.ph_lo = 0; p.ph_hi = 13; p.coop = 1;
    void* args[] = {&p};
    hipError_t e = hipLaunchCooperativeKernel((const void*)fwd_mega, dim3(grid), dim3(512), args, LDS_BYTES, stream);
    if (e != hipSuccess) fprintf(stderr, "cooperative launch failed: %s (grid %d)\n", hipGetErrorString(e), grid);
#endif
}
```

```cpp
#include <hip/hip_runtime.h>
#include <hip/hip_cooperative_groups.h>
#include <cstdio>
#include <cstdint>
namespace cg = cooperative_groups;
namespace pg8 {
#define PG8_LAS __attribute__((address_space(3)))
typedef unsigned short bf16_t;
typedef short bf16x8 __attribute__((ext_vector_type(8)));
typedef float f32x4 __attribute__((ext_vector_type(4)));
typedef unsigned u32x4 __attribute__((ext_vector_type(4)));
constexpr int BM = 256, BK = 64, HALF = 128, HTB = HALF * BK * 2  , STAGE_BYTES = 8 * HTB, NXCD = 8, WGM = 8;

__host__ __device__ __forceinline__ int lds_byte(int r, int c) { const int st = (r >> 4) * 2 + (c >> 5), rr = r & 15, cc = c & 31, ob = rr * 64 + cc * 2; return st * 1024 + (ob ^ (((ob >> 9) & 1) << 5)); }
__host__ __device__ __forceinline__ void stage_rc(int b, int& R, int& C) { const int st = b / 1024, sb = b % 1024, swz = sb ^ (((sb >> 9) & 1) << 5); R = (st >> 1) * 16 + swz / 64; C = (st & 1) * 32 + (swz % 64) / 2; }
__host__ __device__ __forceinline__ int perm32(int rho) { const int n = rho >> 4, i = rho & 15; return 8 * (i >> 2) + 4 * n + (i & 3); }

struct Unit { int pm, pn; };
struct Gemm { const bf16_t* A; const bf16_t* Bt; int M, N, K; };

struct StaticOrder {
    int nM, nN, nwg, G, c;
    __host__ __device__ void init(int M, int N, int G_, int c_) { nM = M / BM; nN = N / BM; nwg = nM * nN; G = G_; c = c_; }
    __host__ __device__ bool next(int i, Unit& u) const {
        const long L = (long)i * G + c; if (L >= nwg) return false;
        int wgid = (int)L; { const int q = nwg / NXCD, r = nwg % NXCD, xcd = wgid % NXCD, off = wgid / NXCD; wgid = (xcd < r ? xcd * (q + 1) : r * (q + 1) + (xcd - r) * q) + off; }
        const int nig = WGM * nN, gid = wgid / nig, fm = gid * WGM, gsz = (nM - fm) < WGM ? (nM - fm) : WGM;
        u.pm = fm + ((wgid % nig) % gsz); u.pn = (wgid % nig) / gsz; return true;
    }
    __device__ __forceinline__ void a_ready(const Unit&) const {}
    __device__ __forceinline__ void done(const Unit&) const {}
};
__device__ __forceinline__ unsigned cvt_pk_bf16(float lo, float hi) { unsigned r; asm volatile("v_cvt_pk_bf16_f32 %0, %1, %2" : "=v"(r) : "v"(lo), "v"(hi)); return r; }
template <class Epi, class Sched, bool ALIGN_EPI = false, bool SP2 = false>
__device__ __forceinline__ void gemm_phase(PG8_LAS unsigned char* lds, const Gemm g, const Sched& S, const Epi& E) {
    const int tid = threadIdx.x, wid = __builtin_amdgcn_readfirstlane(tid >> 6), lane = tid & 63, wr = wid >> 2, wc = wid & 3, fr = lane & 15, fq = lane >> 4;
    const int K = g.K, nt = K / BK;
    unsigned voffA[2], voffB[2];
#pragma unroll
    for (int i = 0; i < 2; ++i) { int R, C; stage_rc(tid * 16 + i * 8192, R, C); const int Rb = Epi::PERM ? ((R & ~31) + perm32(R & 31)) : R;
        voffA[i] = (unsigned)(R * K + C) * 2u; voffB[i] = (unsigned)(Rb * K + C) * 2u; }
    const size_t kstep = (size_t)(BK * 2);
    const size_t hstep = (size_t)HALF * K * 2;
    const size_t tstep = 2 * hstep;
    const unsigned ldsw = (unsigned)wid * 1024u;
    const int aoff = lds_byte(wr * 64 + fr, fq * 8), boff = lds_byte(wc * 32 + fr, fq * 8);
#define PG8_SA(b, h) (((b) * 2 + (h)) * HTB)
#define PG8_SB(b, h) ((4 + (b) * 2 + (h)) * HTB)
#define PG8_STAGE(bufoff, gbase, voff) do { _Pragma("unroll") for (int _i = 0; _i < 2; ++_i) \
        __builtin_amdgcn_global_load_lds((const unsigned*)((const char*)(gbase) + (voff)[_i]), (PG8_LAS unsigned*)(lds + (bufoff) + ldsw + _i * 8192), 16, 0, 0); } while (0)
#define PG8_LDA(dst, b, h) do { _Pragma("unroll") for (int m = 0; m < 4; ++m) _Pragma("unroll") for (int k = 0; k < 2; ++k) dst[m][k] = *(const PG8_LAS bf16x8*)(lds + PG8_SA(b, h) + aoff + m * 2048 + k * 1024); } while (0)
#define PG8_LDB(dst, b, h) do { _Pragma("unroll") for (int n = 0; n < 2; ++n) _Pragma("unroll") for (int k = 0; k < 2; ++k) dst[n][k] = *(const PG8_LAS bf16x8*)(lds + PG8_SB(b, h) + boff + n * 2048 + k * 1024); } while (0)
#define PG8_MMA(ai, bj, At, Bt) do { __builtin_amdgcn_s_setprio(1); _Pragma("unroll") for (int m = 0; m < 4; ++m) _Pragma("unroll") for (int n = 0; n < 2; ++n) _Pragma("unroll") for (int k = 0; k < 2; ++k) \
        acc[ai][bj][m][n] = __builtin_amdgcn_mfma_f32_16x16x32_bf16(Bt[n][k], At[m][k], acc[ai][bj][m][n], 0, 0, 0); __builtin_amdgcn_s_setprio(0); } while (0)
#define PG8_WAIT_V(n) asm volatile("s_waitcnt vmcnt(" #n ")" ::: "memory")
#define PG8_WAIT_L(n) asm volatile("s_waitcnt lgkmcnt(" #n ")" ::: "memory")
#define PG8_BAR __builtin_amdgcn_s_barrier()
#define PG8_SCHED __builtin_amdgcn_sched_barrier(0)
    Unit cur, nxt; int ui = 0;
    if (!S.next(0, cur)) return;
    f32x4 acc[2][2][4][2];
#pragma unroll
    for (int a = 0; a < 2; ++a)
#pragma unroll
        for (int b = 0; b < 2; ++b)
#pragma unroll
            for (int m = 0; m < 4; ++m)
#pragma unroll
                for (int n = 0; n < 2; ++n) acc[a][b][m][n] = (f32x4){0.f, 0.f, 0.f, 0.f};
    bf16x8 At[4][2], B0[2][2], B1[2][2];
    const char* cA = (const char*)g.A + (size_t)cur.pm * tstep; const char* cB = (const char*)g.Bt + (size_t)cur.pn * tstep;
    S.a_ready(cur);
    if constexpr (SP2) {
        PG8_STAGE(PG8_SB(0, 0), cB, voffB); PG8_STAGE(PG8_SB(0, 1), cB + hstep, voffB); PG8_STAGE(PG8_SA(0, 0), cA, voffA); PG8_STAGE(PG8_SA(0, 1), cA + hstep, voffA);
        if (wr == 1) PG8_BAR;
        PG8_WAIT_V(2); PG8_BAR;
        PG8_STAGE(PG8_SB(1, 0), cB + kstep, voffB); PG8_STAGE(PG8_SA(1, 0), cA + kstep, voffA); PG8_STAGE(PG8_SB(1, 1), cB + hstep + kstep, voffB);
        PG8_WAIT_V(6); PG8_BAR;
    } else {
        PG8_STAGE(PG8_SB(0, 0), cB, voffB); PG8_STAGE(PG8_SA(0, 0), cA, voffA); PG8_STAGE(PG8_SB(0, 1), cB + hstep, voffB); PG8_STAGE(PG8_SA(0, 1), cA + hstep, voffA);
        if (wr == 1) PG8_BAR;
        PG8_WAIT_V(4); PG8_BAR;
        PG8_STAGE(PG8_SB(1, 0), cB + kstep, voffB); PG8_STAGE(PG8_SA(1, 0), cA + kstep, voffA); PG8_STAGE(PG8_SB(1, 1), cB + hstep + kstep, voffB);
        PG8_WAIT_V(6); PG8_BAR;
    }
    for (;;) {
        const bool has_next = S.next(ui + 1, nxt);
        const char* nA = has_next ? (const char*)g.A + (size_t)nxt.pm * tstep : cA; const char* nB = has_next ? (const char*)g.Bt + (size_t)nxt.pn * tstep : cB;
        for (int t = 0; t < nt; t += 2) {
            const bool last = (t == nt - 2);
            const char* a1 = cA + (size_t)(t + 1) * kstep;
            const char* a2 = last ? nA : cA + (size_t)(t + 2) * kstep; const char* b2 = last ? nB : cB + (size_t)(t + 2) * kstep;
            const char* a3 = a2 + kstep; const char* b3 = b2 + kstep;
            if (last && has_next) S.a_ready(nxt);
            if constexpr (SP2) {
            PG8_LDB(B0, 0, 0); PG8_LDB(B1, 0, 1); PG8_SCHED; PG8_LDA(At, 0, 0); PG8_STAGE(PG8_SA(1, 1), a1 + hstep, voffA);
            PG8_WAIT_V(8); PG8_WAIT_L(0); PG8_BAR; PG8_MMA(0, 0, At, B0); PG8_MMA(0, 1, At, B1); PG8_BAR; PG8_SCHED;
            PG8_LDA(At, 0, 1); PG8_STAGE(PG8_SB(0, 0), b2, voffB); PG8_STAGE(PG8_SB(0, 1), b2 + hstep, voffB); PG8_STAGE(PG8_SA(0, 0), a2, voffA);
            PG8_WAIT_V(8); PG8_WAIT_L(0); PG8_BAR; PG8_MMA(1, 0, At, B0); PG8_MMA(1, 1, At, B1); PG8_BAR; PG8_SCHED;
            PG8_LDB(B0, 1, 0); PG8_LDB(B1, 1, 1); PG8_SCHED; PG8_LDA(At, 1, 0); PG8_STAGE(PG8_SA(0, 1), a2 + hstep, voffA);
            PG8_WAIT_V(8); PG8_WAIT_L(0); PG8_BAR; PG8_MMA(0, 0, At, B0); PG8_MMA(0, 1, At, B1); PG8_BAR; PG8_SCHED;
            PG8_LDA(At, 1, 1); PG8_STAGE(PG8_SB(1, 0), b3, voffB); PG8_STAGE(PG8_SB(1, 1), b3 + hstep, voffB); PG8_STAGE(PG8_SA(1, 0), a3, voffA);
            PG8_WAIT_V(8); PG8_WAIT_L(0); PG8_BAR; PG8_MMA(1, 0, At, B0); PG8_MMA(1, 1, At, B1); PG8_BAR; PG8_SCHED;
            } else {
            PG8_LDB(B0, 0, 0); PG8_SCHED; PG8_LDA(At, 0, 0); PG8_STAGE(PG8_SA(1, 1), a1 + hstep, voffA);
            PG8_WAIT_L(8); PG8_BAR; PG8_WAIT_L(0); PG8_MMA(0, 0, At, B0); PG8_BAR; PG8_SCHED;
            PG8_LDB(B1, 0, 1); PG8_STAGE(PG8_SB(0, 0), b2, voffB);
            PG8_BAR; PG8_WAIT_L(0); PG8_MMA(0, 1, At, B1); PG8_BAR;
            PG8_LDA(At, 0, 1); PG8_STAGE(PG8_SA(0, 0), a2, voffA);
            PG8_BAR; PG8_WAIT_L(0); PG8_MMA(1, 0, At, B0); PG8_BAR; PG8_SCHED;
            PG8_STAGE(PG8_SB(0, 1), b2 + hstep, voffB);
            PG8_WAIT_V(6); PG8_BAR; PG8_MMA(1, 1, At, B1); PG8_BAR;
            PG8_LDB(B0, 1, 0); PG8_SCHED; PG8_LDA(At, 1, 0); PG8_STAGE(PG8_SA(0, 1), a2 + hstep, voffA);
            PG8_WAIT_L(8); PG8_BAR; PG8_WAIT_L(0); PG8_MMA(0, 0, At, B0); PG8_BAR; PG8_SCHED;
            PG8_LDB(B1, 1, 1); PG8_STAGE(PG8_SB(1, 0), b3, voffB);
            PG8_BAR; PG8_WAIT_L(0); PG8_MMA(0, 1, At, B1); PG8_BAR;
            PG8_LDA(At, 1, 1); PG8_STAGE(PG8_SA(1, 0), a3, voffA);
            PG8_BAR; PG8_WAIT_L(0); PG8_MMA(1, 0, At, B0); PG8_BAR; PG8_SCHED;
            PG8_STAGE(PG8_SB(1, 1), b3 + hstep, voffB);
            PG8_WAIT_V(6); PG8_BAR; PG8_MMA(1, 1, At, B1); PG8_BAR;
            }
        }
        if constexpr (ALIGN_EPI) { if (wr == 0) PG8_BAR; }
        if constexpr (!Epi::AFTER_DRAIN) { E(acc, cur, wr, wc, fr, fq); S.done(cur); }
        if (!has_next) break;
#pragma unroll
        for (int a = 0; a < 2; ++a)
#pragma unroll
            for (int b = 0; b < 2; ++b)
#pragma unroll
                for (int m = 0; m < 4; ++m)
#pragma unroll
                    for (int n = 0; n < 2; ++n) acc[a][b][m][n] = (f32x4){0.f, 0.f, 0.f, 0.f};
        cur = nxt; cA = nA; cB = nB; ++ui;
        if constexpr (ALIGN_EPI) { if (wr == 1) PG8_BAR; }
    }
    PG8_WAIT_V(0);
    if constexpr (!ALIGN_EPI) { if (wr == 0) PG8_BAR; }
    PG8_BAR;
    if constexpr (Epi::AFTER_DRAIN) { E.fused(acc, cur, wr, wc, fr, fq, lds, wid, lane); S.done(cur); }
#undef PG8_SA
#undef PG8_SB
#undef PG8_STAGE
#undef PG8_LDA
#undef PG8_LDB
#undef PG8_MMA
#undef PG8_WAIT_V
#undef PG8_WAIT_L
#undef PG8_BAR
#undef PG8_SCHED
}
}


using pg8::bf16_t; using pg8::f32x4; using pg8::u32x4; using pg8::Unit; using pg8::cvt_pk_bf16;
#define LAS __attribute__((address_space(3)))

constexpr int D = 2048, NB = 8, TL = 2048, TC = 256, MLAT = NB * TL  , MCTX = NB * TC  , MALL = MLAT + MCTX  ;
constexpr int N1 = 6656, N2 = 5120, LD1 = N1, LD2 = N2, FFH = 5632, NADA = 6 * D;
constexpr int COL_CV = 3520, COL_AB = 6592;
constexpr int LDS_BYTES = 147456;
constexpr size_t MiB = 1048576;
constexpr size_t WS_A = 0;
constexpr size_t WS_B = WS_A + 46 * MiB;
constexpr size_t WS_X = WS_B + 16 * MiB;
constexpr size_t WS_D = WS_X + 234 * MiB;
constexpr size_t WS_F = WS_D + 160 * MiB;
constexpr size_t WS_M = WS_F + 32 * MiB;
constexpr size_t WS_END = WS_M + 3 * MiB;

struct Params { const float* in[30]; float* out; unsigned char* ws; int ph_lo, ph_hi, coop, pad; };

__device__ __forceinline__ float bf2f(bf16_t b) { return __uint_as_float(((unsigned)b) << 16); }
typedef __bf16 bf16x2_t __attribute__((ext_vector_type(2)));
typedef float f32x2_t __attribute__((ext_vector_type(2)));
__device__ __forceinline__ unsigned pk2(float lo, float hi) { const f32x2_t v = {lo, hi}; return __builtin_bit_cast(unsigned, __builtin_convertvector(v, bf16x2_t)); }
__device__ __forceinline__ bf16_t f2bf(float f) { return (bf16_t)(pk2(f, 0.f) & 0xffffu); }
__device__ __forceinline__ float sigm(float x) { return __builtin_amdgcn_rcpf(1.f + __expf(-x)); }
__device__ __forceinline__ float tanh_fast(float x) { return 1.f - 2.f * __builtin_amdgcn_rcpf(1.f + __expf(2.f * x)); }
__device__ __forceinline__ float wave_sum(float v) {
#pragma unroll
    for (int o = 1; o < 64; o <<= 1) v += __shfl_xor(v, o);
    return v;
}
template <int CTRL> __device__ __forceinline__ float dppf(float x) { return __int_as_float(__builtin_amdgcn_update_dpp(0, __float_as_int(x), CTRL, 0xF, 0xF, true)); }
__device__ __forceinline__ float red8(float x) { x += dppf<0x141>(x); x += dppf<0xB1>(x); x += dppf<0x4E>(x); return x; }

struct EpiBf16Plain {
    static constexpr bool PERM = true, AFTER_DRAIN = false;
    bf16_t* O; int ldc;
    __device__ __forceinline__ void operator()(const f32x4 (&acc)[2][2][4][2], const Unit& u, int wr, int wc, int fr, int fq) const {
        const int row0 = u.pm * 256 + wr * 64 + fr, col0 = u.pn * 256 + wc * 32 + 8 * fq;
#pragma unroll
        for (int ai = 0; ai < 2; ++ai)
#pragma unroll
            for (int m = 0; m < 4; ++m) { bf16_t* rowp = O + (size_t)(row0 + ai * 128 + m * 16) * ldc + col0;
#pragma unroll
                for (int bj = 0; bj < 2; ++bj) { const f32x4 v0 = acc[ai][bj][m][0], v1 = acc[ai][bj][m][1];
                    u32x4 w; w.x = pk2(v0[0], v0[1]); w.y = pk2(v0[2], v0[3]); w.z = pk2(v1[0], v1[1]); w.w = pk2(v1[2], v1[3]);
                    *(u32x4*)(rowp + bj * 128) = w; } }
    }
};
template <bool SECOND> struct EpiGate {
    static constexpr bool PERM = true, AFTER_DRAIN = false;
    bf16_t* Mo; const bf16_t* G;
    __device__ __forceinline__ void operator()(const f32x4 (&acc)[2][2][4][2], const Unit& u, int wr, int wc, int fr, int fq) const {
        const int row0 = u.pm * 256 + wr * 64 + fr, col0 = u.pn * 256 + wc * 32 + 8 * fq;
#pragma unroll
        for (int ai = 0; ai < 2; ++ai)
#pragma unroll
            for (int m = 0; m < 4; ++m) { const size_t row = (size_t)(row0 + ai * 128 + m * 16);
#pragma unroll
                for (int bj = 0; bj < 2; ++bj) { const f32x4 v0 = acc[ai][bj][m][0], v1 = acc[ai][bj][m][1];
                    const int col = col0 + bj * 128;
                    const u32x4 g = *(const u32x4*)(G + row * LD2 + col);
                    float r[8];
                    r[0] = sigm(__uint_as_float(g.x << 16)) * v0[0]; r[1] = sigm(__uint_as_float(g.x & 0xffff0000u)) * v0[1];
                    r[2] = sigm(__uint_as_float(g.y << 16)) * v0[2]; r[3] = sigm(__uint_as_float(g.y & 0xffff0000u)) * v0[3];
                    r[4] = sigm(__uint_as_float(g.z << 16)) * v1[0]; r[5] = sigm(__uint_as_float(g.z & 0xffff0000u)) * v1[1];
                    r[6] = sigm(__uint_as_float(g.w << 16)) * v1[2]; r[7] = sigm(__uint_as_float(g.w & 0xffff0000u)) * v1[3];
                    u32x4* op = (u32x4*)(Mo + row * D + col);
                    if (SECOND) { const u32x4 o = *op;
                        r[0] += __uint_as_float(o.x << 16); r[1] += __uint_as_float(o.x & 0xffff0000u); r[2] += __uint_as_float(o.y << 16); r[3] += __uint_as_float(o.y & 0xffff0000u);
                        r[4] += __uint_as_float(o.z << 16); r[5] += __uint_as_float(o.z & 0xffff0000u); r[6] += __uint_as_float(o.w << 16); r[7] += __uint_as_float(o.w & 0xffff0000u); }
                    u32x4 w; w.x = pk2(r[0], r[1]); w.y = pk2(r[2], r[3]); w.z = pk2(r[4], r[5]); w.w = pk2(r[6], r[7]);
                    *op = w; } }
    }
};
struct EpiRes {
    static constexpr bool PERM = false, AFTER_DRAIN = false;
    float* out; const float* res; const float* gt;
    __device__ __forceinline__ void operator()(const f32x4 (&acc)[2][2][4][2], const Unit& u, int wr, int wc, int fr, int fq) const {
        const int row0 = u.pm * 256 + wr * 64 + fr, col0 = u.pn * 256 + wc * 32 + 4 * fq;
        const float* gtb = gt + (size_t)((u.pm * 256) >> 11) * NADA + col0;
        f32x4 gv[2][2];
#pragma unroll
        for (int bj = 0; bj < 2; ++bj)
#pragma unroll
            for (int n = 0; n < 2; ++n) gv[bj][n] = *(const f32x4*)(gtb + bj * 128 + n * 16);
#pragma unroll
        for (int ai = 0; ai < 2; ++ai)
#pragma unroll
            for (int m = 0; m < 4; ++m) { const size_t ro = (size_t)(row0 + ai * 128 + m * 16) * D + col0;
#pragma unroll
                for (int bj = 0; bj < 2; ++bj)
#pragma unroll
                    for (int n = 0; n < 2; ++n) { const f32x4 rv = *(const f32x4*)(res + ro + bj * 128 + n * 16);
                        *(f32x4*)(out + ro + bj * 128 + n * 16) = rv + gv[bj][n] * acc[ai][bj][m][n]; } }
    }
};
struct EpiSwiglu {
    static constexpr bool PERM = true, AFTER_DRAIN = false;
    bf16_t* O;
    __device__ __forceinline__ void operator()(const f32x4 (&acc)[2][2][4][2], const Unit& u, int wr, int wc, int fr, int fq) const {
        const int row0 = u.pm * 256 + wr * 64 + fr, col0 = u.pn * 128 + wc * 32 + 8 * fq;
#pragma unroll
        for (int ai = 0; ai < 2; ++ai)
#pragma unroll
            for (int m = 0; m < 4; ++m) { bf16_t* rowp = O + (size_t)(row0 + ai * 128 + m * 16) * FFH + col0;
                float r[8];
#pragma unroll
                for (int n = 0; n < 2; ++n)
#pragma unroll
                    for (int e = 0; e < 4; ++e) { const float g = acc[ai][0][m][n][e], up = acc[ai][1][m][n][e]; r[4 * n + e] = g * sigm(g) * up; }
                u32x4 w; w.x = pk2(r[0], r[1]); w.y = pk2(r[2], r[3]); w.z = pk2(r[4], r[5]); w.w = pk2(r[6], r[7]);
                *(u32x4*)rowp = w; }
    }
};

#ifndef GEMM_ALIGN_EPI
#define GEMM_ALIGN_EPI true
#endif
#ifndef GEMM_SP2
#define GEMM_SP2 true
#endif
template <class Epi> __device__ __forceinline__ void run_gemm(unsigned char* smem, const bf16_t* A, const bf16_t* Bt, int M, int N, int K, const Epi& E) {
    pg8::Gemm g; g.A = A; g.Bt = Bt; g.M = M; g.N = N; g.K = K;
    pg8::StaticOrder S; S.init(M, N, (int)gridDim.x, (int)blockIdx.x);
    pg8::gemm_phase<Epi, pg8::StaticOrder, GEMM_ALIGN_EPI, GEMM_SP2>((PG8_LAS unsigned char*)smem, g, S, E);
    __syncthreads();
}

__device__ __forceinline__ void transpose_item(const float* W, int K, int N, bf16_t* WT, int dst_row0, int src_col0, float* scr, int k0, int lane) {
    if (src_col0 >= 0) {
#pragma unroll 8
        for (int i = 0; i < 32; ++i) { const int kk = 2 * i + (lane >> 5); scr[kk * 33 + (lane & 31)] = W[(size_t)(k0 + kk) * N + src_col0 + (lane & 31)]; }
    } else {
#pragma unroll 8
        for (int i = 0; i < 32; ++i) { const int kk = 2 * i + (lane >> 5); scr[kk * 33 + (lane & 31)] = 0.f; }
    }
    asm volatile("s_waitcnt lgkmcnt(0)" ::: "memory");
    const int c = lane & 7;
#pragma unroll
    for (int j = 0; j < 4; ++j) { const int n = (lane >> 3) + 8 * j; const float* s = scr + (8 * c) * 33 + n;
        u32x4 o; o.x = pk2(s[0], s[33]); o.y = pk2(s[2 * 33], s[3 * 33]); o.z = pk2(s[4 * 33], s[5 * 33]); o.w = pk2(s[6 * 33], s[7 * 33]);
        *(u32x4*)(WT + (size_t)(dst_row0 + n) * K + k0 + 8 * c) = o; }
    asm volatile("s_waitcnt lgkmcnt(0)" ::: "memory");
}
__device__ __forceinline__ int win_src_col(int n0) {
    if (n0 < 6592) return n0;
    if (n0 < 6624) return 7616 + (n0 - 6592);
    if (n0 < 6656) return -1;
    const int j = n0 - 6656;
    return j < 1024 ? 6592 + j : 7648 + (j - 1024);
}

__device__ __forceinline__ void phase_prep(const Params& P, unsigned char* smem) {
    const int tid = threadIdx.x, lane = tid & 63, wave = tid >> 6;
    float* MOD = (float*)(P.ws + WS_M);
    if ((int)blockIdx.x < 192) {
        float* sT = (float*)smem;
        float* red = (float*)(smem + 98304);
        const float* c = P.in[1]; const float* cc = P.in[3];
        for (int idx = tid; idx < 9 * D; idx += 512) { const int m = idx >> 11, k = idx & 2047; const float v = m < 8 ? c[m * D + k] : cc[k]; sT[k * 12 + m] = v * sigm(v); }
        __syncthreads();
        const float* W = P.in[4]; const float* bias = P.in[5];
        for (int item = blockIdx.x; item < 192; item += gridDim.x) {
            const int n0 = item * 64, cl = tid & 15, kl = tid >> 4;
            float acc[9][4];
#pragma unroll
            for (int m = 0; m < 9; ++m)
#pragma unroll
                for (int e = 0; e < 4; ++e) acc[m][e] = 0.f;
#pragma unroll 4
            for (int kk = 0; kk < 64; ++kk) { const int k = kk * 32 + kl;
                const f32x4 w = *(const f32x4*)(W + (size_t)k * NADA + n0 + 4 * cl);
                const f32x4 s0 = *(const f32x4*)(sT + k * 12), s1 = *(const f32x4*)(sT + k * 12 + 4); const float s2 = sT[k * 12 + 8];
#pragma unroll
                for (int e = 0; e < 4; ++e) { acc[0][e] += s0[0] * w[e]; acc[1][e] += s0[1] * w[e]; acc[2][e] += s0[2] * w[e]; acc[3][e] += s0[3] * w[e];
                    acc[4][e] += s1[0] * w[e]; acc[5][e] += s1[1] * w[e]; acc[6][e] += s1[2] * w[e]; acc[7][e] += s1[3] * w[e]; acc[8][e] += s2 * w[e]; } }
#pragma unroll
            for (int m = 0; m < 9; ++m)
#pragma unroll
                for (int e = 0; e < 4; ++e) { float v = acc[m][e]; v += __shfl_xor(v, 16); v += __shfl_xor(v, 32); if ((lane >> 4) == 0) red[(wave * 9 + m) * 64 + 4 * cl + e] = v; }
            __syncthreads();
            for (int o = tid; o < 576; o += 512) { const int m = o >> 6, c2 = o & 63; float s = bias[n0 + c2];
#pragma unroll
                for (int w8 = 0; w8 < 8; ++w8) s += red[(w8 * 9 + m) * 64 + c2];
                MOD[m * NADA + n0 + c2] = s; }
            __syncthreads();
        }
    }
    __syncthreads();
    { bf16_t* G2T = (bf16_t*)(P.ws + WS_M + MiB / 2); const float* g2 = P.in[13];
      for (int s = blockIdx.x * 512 + tid; s < 1024 * 32; s += gridDim.x * 512) { const int n = s >> 5, k8 = s & 31; u32x4 w = {0u, 0u, 0u, 0u};
          if (k8 < 8) { const float* gp = g2 + (size_t)(8 * k8) * 1024 + n; w.x = pk2(gp[0], gp[1024]); w.y = pk2(gp[2048], gp[3072]); w.z = pk2(gp[4096], gp[5120]); w.w = pk2(gp[6144], gp[7168]); }
          *(u32x4*)(G2T + (size_t)n * 256 + 8 * k8) = w; } }
    float* scr = (float*)(smem + wave * 8448);
    const int gw = blockIdx.x * 8 + wave, NGW = gridDim.x * 8;
    bf16_t* WT_IN = (bf16_t*)(P.ws + WS_A); bf16_t* WT_PA = (bf16_t*)(P.ws + WS_B); bf16_t* WT_PB = WT_PA + 2048 * 1024; bf16_t* WT_OUT = WT_PB + 2048 * 1024;
    constexpr int I_IN = 368 * 32, I_PA = 64 * 16, I_OUT = 64 * 32;
    for (int it = gw; it < I_IN + 2 * I_PA + I_OUT; it += NGW) {
        int r = it;
        if (r < I_IN) { const int nb = r % 368, kb = r / 368; transpose_item(P.in[7], 2048, 11744, WT_IN, nb * 32, win_src_col(nb * 32), scr, kb * 64, lane); continue; } r -= I_IN;
        if (r < I_PA) { const int nb = r % 64, kb = r / 64; transpose_item(P.in[23], 1024, 2048, WT_PA, nb * 32, nb * 32, scr, kb * 64, lane); continue; } r -= I_PA;
        if (r < I_PA) { const int nb = r % 64, kb = r / 64; transpose_item(P.in[24], 1024, 2048, WT_PB, nb * 32, nb * 32, scr, kb * 64, lane); continue; } r -= I_PA;
        { const int nb = r % 64, kb = r / 64; transpose_item(P.in[25], 2048, 2048, WT_OUT, nb * 32, nb * 32, scr, kb * 64, lane); }
    }
}
__device__ __forceinline__ void phase_ffn_weights(const Params& P, unsigned char* smem) {
    const int tid = threadIdx.x, lane = tid & 63, wave = tid >> 6;
    float* scr = (float*)(smem + wave * 8448);
    const int gw = blockIdx.x * 8 + wave, NGW = gridDim.x * 8;
    bf16_t* WT_GU = (bf16_t*)(P.ws + WS_A); bf16_t* WT_DN = (bf16_t*)(P.ws + WS_F);
    constexpr int I_GU = 352 * 32, I_DN = 64 * 88;
    for (int it = gw; it < I_GU + I_DN; it += NGW) {
        int r = it;
        if (r < I_GU) { const int nb = r % 352, kb = r / 352; const int n0 = nb * 32, pn = n0 >> 8, cq = n0 & 255; const int src = cq < 128 ? 128 * pn + cq : FFH + 128 * pn + (cq - 128);
            transpose_item(P.in[27], 2048, 2 * FFH, WT_GU, n0, src, scr, kb * 64, lane); continue; } r -= I_GU;
        { const int nb = r % 64, kb = r / 64; transpose_item(P.in[28], FFH, 2048, WT_DN, nb * 32, nb * 32, scr, kb * 64, lane); }
    }
}

__device__ __forceinline__ void norm_mod_row(const float* src, const float* nw, const float* sh, const float* sc, bf16_t* dst, int lane) {
    f32x4 v[8]; float ss = 0.f;
#pragma unroll
    for (int j = 0; j < 8; ++j) { v[j] = *(const f32x4*)(src + (j * 64 + lane) * 4); ss += v[j][0] * v[j][0] + v[j][1] * v[j][1] + v[j][2] * v[j][2] + v[j][3] * v[j][3]; }
    const float rstd = rsqrtf(wave_sum(ss) * (1.f / D) + 1e-6f);
#pragma unroll
    for (int j = 0; j < 8; ++j) { const int c = (j * 64 + lane) * 4; const f32x4 w = *(const f32x4*)(nw + c), a = *(const f32x4*)(sh + c), b = *(const f32x4*)(sc + c);
        float o[4];
#pragma unroll
        for (int e = 0; e < 4; ++e) o[e] = (v[j][e] * rstd * w[e]) * (1.f + b[e]) + a[e];
        uint2 pk; pk.x = pk2(o[0], o[1]); pk.y = pk2(o[2], o[3]); *(uint2*)(dst + c) = pk; }
}
__device__ __forceinline__ void phase_norm1(const Params& P) {
    const int lane = threadIdx.x & 63, gw = blockIdx.x * 8 + (threadIdx.x >> 6), NGW = gridDim.x * 8;
    const float* MOD = (const float*)(P.ws + WS_M); bf16_t* H = (bf16_t*)P.out;
    for (int row = gw; row < MALL; row += NGW) {
        const float* src = row < MLAT ? P.in[0] + (size_t)row * D : P.in[2] + (size_t)(row - MLAT) * D;
        const int mr = row < MLAT ? (row >> 11) : 8;
        norm_mod_row(src, P.in[6], MOD + mr * NADA, MOD + mr * NADA + D, H + (size_t)row * D, lane);
    }
}
__device__ __forceinline__ void phase_norm2(const Params& P) {
    const int lane = threadIdx.x & 63, gw = blockIdx.x * 8 + (threadIdx.x >> 6), NGW = gridDim.x * 8;
    const float* MOD = (const float*)(P.ws + WS_M); bf16_t* H2 = (bf16_t*)(P.ws + WS_D);
    for (int row = gw; row < MLAT; row += NGW) { const int mr = row >> 11;
        norm_mod_row(P.out + (size_t)row * D, P.in[26], MOD + mr * NADA + 3 * D, MOD + mr * NADA + 4 * D, H2 + (size_t)row * D, lane); }
}
__device__ __forceinline__ void phase_final_norm(const Params& P) {
    const int lane = threadIdx.x & 63, gw = blockIdx.x * 8 + (threadIdx.x >> 6), NGW = gridDim.x * 8;
    const float* nw = P.in[29];
    for (int row = gw; row < MLAT; row += NGW) { float* src = P.out + (size_t)row * D;
        f32x4 v[8]; float ss = 0.f;
#pragma unroll
        for (int j = 0; j < 8; ++j) { v[j] = *(const f32x4*)(src + (j * 64 + lane) * 4); ss += v[j][0] * v[j][0] + v[j][1] * v[j][1] + v[j][2] * v[j][2] + v[j][3] * v[j][3]; }
        const float rstd = rsqrtf(wave_sum(ss) * (1.f / D) + 1e-6f);
#pragma unroll
        for (int j = 0; j < 8; ++j) { const int c = (j * 64 + lane) * 4; const f32x4 w = *(const f32x4*)(nw + c); *(f32x4*)(src + c) = v[j] * rstd * w; }
    }
}

__device__ __forceinline__ float mixed_load(const bf16_t* P1, int row, int t, bool isctx, int col, const float* mu) {
    const float p = bf2f(P1[(size_t)row * LD1 + col]);
    int nrow; bool valid;
    if (isctx) { if (col & 1) { valid = t < TC - 1; nrow = row + 1; } else { valid = t > 0; nrow = row - 1; } }
    else { const int m = col & 3, x = t & 63, y = t >> 6;
        if (m == 0) { valid = x > 0; nrow = row - 1; } else if (m == 1) { valid = x < 63; nrow = row + 1; }
        else if (m == 2) { valid = y > 0; nrow = row - 64; } else { valid = y < 31; nrow = row + 64; } }
    const float ps = valid ? bf2f(P1[(size_t)nrow * LD1 + col]) : 0.f;
    return p + (ps - p) * mu[col];
}


__device__ __forceinline__ void tri_inv_part1(const float* LM, bf16_t* TM, bf16_t* T11T, int blk, int lane) {
    constexpr int LDLc = 36, LDCc = 40;
    { const int c = lane & 15, o = 16 * blk; float t[16];
        const float* Lb = LM + o * LDLc + o;
#pragma unroll
        for (int i = 0; i < 16; ++i) { float a4[4] = {(i == c) ? 1.f : 0.f, 0.f, 0.f, 0.f};
#pragma unroll
            for (int j4 = 0; j4 < (i + 3) / 4; ++j4) { const f32x4 l = *(const f32x4*)(Lb + i * LDLc + 4 * j4);
#pragma unroll
                for (int x = 0; x < 4; ++x) if (4 * j4 + x < i) a4[x] -= l[x] * t[4 * j4 + x]; }
            t[i] = (a4[0] + a4[1]) + (a4[2] + a4[3]); }
        if (lane < 16) {
#pragma unroll
            for (int i = 0; i < 16; ++i) TM[(o + i) * LDCc + o + c] = f2bf(t[i]);
            if (blk == 0) { u32x4 w0, w1;
#pragma unroll
                for (int e = 0; e < 4; ++e) { w0[e] = pk2(t[2 * e], t[2 * e + 1]); w1[e] = pk2(t[8 + 2 * e], t[8 + 2 * e + 1]); }
                *(u32x4*)(T11T + c * 16) = w0; *(u32x4*)(T11T + c * 16 + 8) = w1; } }
        else if (lane < 32 && blk == 0) { const u32x4 zz = {0u, 0u, 0u, 0u}; *(u32x4*)(TM + c * LDCc + 16) = zz; *(u32x4*)(TM + c * LDCc + 24) = zz; } }
}
__device__ __forceinline__ void tri_inv_part2(const float* LM, bf16_t* TM, const bf16_t* T11T, bf16_t* XT, int lane) {
    constexpr int LDLc = 36, LDCc = 40;
    typedef short s16x8_ __attribute__((ext_vector_type(8)));
    const int fr = lane & 15, fq = lane >> 4;
    s16x8_ a = {0, 0, 0, 0, 0, 0, 0, 0}, b = {0, 0, 0, 0, 0, 0, 0, 0};
    if (fq < 2) { const f32x4 l0 = *(const f32x4*)(LM + (16 + fr) * LDLc + 8 * fq), l1 = *(const f32x4*)(LM + (16 + fr) * LDLc + 8 * fq + 4);
        u32x4 w; w.x = pk2(l0[0], l0[1]); w.y = pk2(l0[2], l0[3]); w.z = pk2(l1[0], l1[1]); w.w = pk2(l1[2], l1[3]);
        a = __builtin_bit_cast(s16x8_, w); b = *(const s16x8_*)(T11T + fr * 16 + 8 * fq); }
    const f32x4 X = __builtin_amdgcn_mfma_f32_16x16x32_bf16(a, b, ((f32x4){0.f, 0.f, 0.f, 0.f}), 0, 0, 0);
    { uint2 o; o.x = pk2(X[0], X[1]); o.y = pk2(X[2], X[3]); *(uint2*)(XT + fr * 16 + fq * 4) = o; }
    asm volatile("s_waitcnt lgkmcnt(0)" ::: "memory");
    s16x8_ a2 = {0, 0, 0, 0, 0, 0, 0, 0}, b2 = {0, 0, 0, 0, 0, 0, 0, 0};
    if (fq < 2) { a2 = *(const s16x8_*)(XT + fr * 16 + 8 * fq); b2 = *(const s16x8_*)(TM + (16 + fr) * LDCc + 16 + 8 * fq); }
    const f32x4 O = __builtin_amdgcn_mfma_f32_16x16x32_bf16(a2, b2, ((f32x4){0.f, 0.f, 0.f, 0.f}), 0, 0, 0);
    { uint2 o; o.x = pk2(-O[0], -O[1]); o.y = pk2(-O[2], -O[3]); *(uint2*)(TM + (16 + fr) * LDCc + fq * 4) = o; }
}
constexpr int CH = 32, NCHUNK = (TC + TL) / CH;
typedef short s16x8 __attribute__((ext_vector_type(8)));
__device__ __forceinline__ float red16(float x) { x += dppf<0x140>(x); x += dppf<0x141>(x); x += dppf<0xB1>(x); x += dppf<0x4E>(x); return x; }
#define TROW(r) ((r) * LDC + ((r) >> 3) * 8)
#define MFMA16(a, b, c) __builtin_amdgcn_mfma_f32_16x16x32_bf16((a), (b), (c), 0, 0, 0)

typedef short s16x4_t __attribute__((ext_vector_type(4)));
__device__ __forceinline__ __attribute__((ext_vector_type(8))) short tr_frag(const bf16_t* img, int rs, int c, int lane) {
    const int g = lane >> 4, q = (lane & 15) >> 2, p = lane & 3;
    const bf16_t* base = img + (8 * g + q) * rs + 16 * c + 4 * p;
    const s16x4_t lo = __builtin_amdgcn_ds_read_tr16_b64_v4i16((LAS s16x4_t*)base), hi = __builtin_amdgcn_ds_read_tr16_b64_v4i16((LAS s16x4_t*)(base + 4 * rs));
    return (__attribute__((ext_vector_type(8))) short){lo[0], lo[1], lo[2], lo[3], hi[0], hi[1], hi[2], hi[3]};
}
constexpr int L_WR = 0, L_KD = 8192, L_V = 16384, L_W = 24576, L_BB = 32768, L_KK = 40960, L_THW = 49152  , L_THA = 55296, L_SC = 61440  , L_PRM = 61952  ;
__device__ __forceinline__ void phase_rwkv(const Params& P, unsigned char* smem) {
    const int tid = threadIdx.x;
    const bf16_t* P1 = (const bf16_t*)(P.ws + WS_X);
    bf16_t* YD = (bf16_t*)P.out;
    float* SBON = (float*)(P.ws + WS_M + MiB);
    float* A_wr = (float*)(smem + L_WR); float* A_kd = (float*)(smem + L_KD); float* A_v = (float*)(smem + L_V); float* A_w = (float*)(smem + L_W);
    float* A_bb = (float*)(smem + L_BB); float* A_kk = (float*)(smem + L_KK); bf16_t* TH_w = (bf16_t*)(smem + L_THW); bf16_t* TH_a = (bf16_t*)(smem + L_THA); float* SC = (float*)(smem + L_SC);
    float* PRM = (float*)(smem + L_PRM);
    const float* mu = P.in[8];
    for (int it = blockIdx.x; it < 256; it += gridDim.x) {
        const int b = it >> 5, h = (it >> 1) & 15, d = it & 1;
        float S[8];
#pragma unroll
        for (int j = 0; j < 8; ++j) S[j] = 0.f;
        s16x8 Bw[3], Ba[3];
        __syncthreads();
        { const int lane = tid & 63, wave = tid >> 6; const int cB = h * 64 + 16 * (wave & 3) + (lane & 15);
#pragma unroll
          for (int ks = 0; ks < 3; ++ks)
#pragma unroll
            for (int j = 0; j < 8; ++j) { const int k = ks * 32 + (lane >> 4) * 8 + j;
                Bw[ks][j] = (short)f2bf(P.in[10][((size_t)d * 96 + k) * 1024 + cB]); Ba[ks][j] = (short)f2bf(P.in[12][((size_t)d * 96 + k) * 1024 + cB]); }
          if (tid < 64) { PRM[tid] = P.in[14][h * 64 + tid]; PRM[64 + tid] = P.in[15][h * 64 + tid]; PRM[128 + tid] = P.in[16][h * 64 + tid]; } }
        const float w0c = P.in[9][d * 1024 + h * 64 + 16 * ((tid >> 6) & 3) + (tid & 15)], a0c = P.in[11][d * 1024 + h * 64 + 16 * ((tid >> 6) & 3) + (tid & 15)];
        unsigned pre[3][12];
        auto prefetch = [&](int ch) {
            const bool isctx = ch < 8;
            const int sbase = isctx ? ch * CH : (ch - 8) * CH, Tlen = isctx ? TC : TL;
            const int rowbase = isctx ? MLAT + b * TC : b * TL;
            const int t0 = d == 0 ? sbase : Tlen - 1 - sbase, sgn = d == 0 ? 1 : -1;
            const u32x4 zz = {0u, 0u, 0u, 0u};
            int qv = tid; asm volatile("" : "+v"(qv));
#pragma unroll
            for (int n = 0; n < 3; ++n) { const int s = qv + 512 * n, i = s / 48, cv = s % 48; const int t = t0 + sgn * i;
                const int col = cv < 8 ? h * 64 + 8 * cv : (cv < 16 ? 1024 + h * 64 + 8 * (cv - 8) : (cv < 24 ? 2048 + h * 64 + 8 * (cv - 16) : (cv < 36 ? 3072 + d * 96 + 8 * (cv - 24) : 3264 + d * 96 + 8 * (cv - 36))));
                const bf16_t* pp = P1 + (size_t)(rowbase + t) * LD1 + col;
                { const u32x4 pv_ = *(const u32x4*)pp; pre[n][0] = pv_.x; pre[n][1] = pv_.y; pre[n][2] = pv_.z; pre[n][3] = pv_.w; }
                const unsigned* pw = (const unsigned*)pp; constexpr int LW = LD1 / 2;
                if (isctx) { const bool vl = t > 0, vr = t < TC - 1;
                    const u32x4 L = vl ? *(const u32x4*)(pp - LD1) : zz, R = vr ? *(const u32x4*)(pp + LD1) : zz;
                    pre[n][4] = L.x; pre[n][5] = L.y; pre[n][6] = L.z; pre[n][7] = L.w; pre[n][8] = R.x; pre[n][9] = R.y; pre[n][10] = R.z; pre[n][11] = R.w; }
                else { const int x = t & 63, y = t >> 6; const bool vl = x > 0, vr = x < 63, vu = y > 0, vd = y < 31;
                    pre[n][4] = vl ? pw[-LW + 0] : 0u; pre[n][5] = vl ? pw[-LW + 2] : 0u; pre[n][6] = vr ? pw[LW + 0] : 0u; pre[n][7] = vr ? pw[LW + 2] : 0u;
                    pre[n][8] = vu ? pw[-64 * LW + 1] : 0u; pre[n][9] = vu ? pw[-64 * LW + 3] : 0u; pre[n][10] = vd ? pw[64 * LW + 1] : 0u; pre[n][11] = vd ? pw[64 * LW + 3] : 0u; } }
        };
        prefetch(0);
        for (int ch = 0; ch < NCHUNK; ++ch) {
            int qo = tid; asm volatile("" : "+v"(qo));
            const int lane_o = qo & 63, wave_o = qo >> 6;
            const bool isctx = ch < 8;
            const int sbase = isctx ? ch * CH : (ch - 8) * CH, Tlen = isctx ? TC : TL;
            const int rowbase = isctx ? MLAT + b * TC : b * TL;
            const int t0 = d == 0 ? sbase : Tlen - 1 - sbase, sgn = d == 0 ? 1 : -1;
#pragma unroll
            for (int n = 0; n < 3; ++n) { const int s = qo + 512 * n, i = s / 48, cv = s % 48;
                const int col = cv < 8 ? h * 64 + 8 * cv : (cv < 16 ? 1024 + h * 64 + 8 * (cv - 8) : (cv < 24 ? 2048 + h * 64 + 8 * (cv - 16) : (cv < 36 ? 3072 + d * 96 + 8 * (cv - 24) : 3264 + d * 96 + 8 * (cv - 36))));
                const f32x4 m0 = *(const f32x4*)(mu + col), m1 = *(const f32x4*)(mu + col + 4);
                float xs[8];
#pragma unroll
                for (int e = 0; e < 8; ++e) { const float p = __uint_as_float((e & 1) ? (pre[n][e >> 1] & 0xffff0000u) : (pre[n][e >> 1] << 16));
                    unsigned wv_; const bool hi = (e & 1);
                    if (isctx) wv_ = (e & 1) ? pre[n][8 + (e >> 1)] : pre[n][4 + (e >> 1)];
                    else wv_ = pre[n][4 + 2 * (e & 3) + (e >> 2)];
                    const float ps = __uint_as_float(hi ? (wv_ & 0xffff0000u) : (wv_ << 16));
                    xs[e] = p + (ps - p) * (e < 4 ? m0[e & 3] : m1[e & 3]); }
                if (cv < 24) { float* dst = (cv < 8 ? A_wr + i * 64 + 8 * cv : (cv < 16 ? A_kd + i * 64 + 8 * (cv - 8) : A_v + i * 64 + 8 * (cv - 16)));
                    *(f32x4*)dst = (f32x4){xs[0], xs[1], xs[2], xs[3]}; *(f32x4*)(dst + 4) = (f32x4){xs[4], xs[5], xs[6], xs[7]}; }
                else if (cv < 36) { u32x4 w; w.x = pk2(tanhf(xs[0]), tanhf(xs[1])); w.y = pk2(tanhf(xs[2]), tanhf(xs[3])); w.z = pk2(tanhf(xs[4]), tanhf(xs[5])); w.w = pk2(tanhf(xs[6]), tanhf(xs[7]));
                    *(u32x4*)(TH_w + i * 96 + 8 * (cv - 24)) = w; }
                else { u32x4 w; w.x = pk2(xs[0], xs[1]); w.y = pk2(xs[2], xs[3]); w.z = pk2(xs[4], xs[5]); w.w = pk2(xs[6], xs[7]);
                    *(u32x4*)(TH_a + i * 96 + 8 * (cv - 36)) = w; } }
            __syncthreads();
            { const int rt = wave_o >> 2, c = 16 * (wave_o & 3) + (lane_o & 15);
              f32x4 cw = {0.f, 0.f, 0.f, 0.f}, ca = {0.f, 0.f, 0.f, 0.f};
#pragma unroll
              for (int ks = 0; ks < 3; ++ks) { const int off = (rt * 16 + (lane_o & 15)) * 96 + ks * 32 + (lane_o >> 4) * 8;
                  const s16x8 fa = *(const s16x8*)(TH_w + off), fb = *(const s16x8*)(TH_a + off);
                  cw = MFMA16(fa, Bw[ks], cw); ca = MFMA16(fb, Ba[ks], ca); }
#pragma unroll
              for (int j = 0; j < 4; ++j) { const int i = rt * 16 + (lane_o >> 4) * 4 + j;
                  A_w[i * 64 + c] = __expf(-0.6065306597126334f * sigm(w0c + cw[j])); A_bb[i * 64 + c] = sigm(a0c + ca[j]); } }
            __syncthreads();
            if (qo < 256) {
                const int i = qo >> 3, cgp = qo & 7, j0 = 8 * cgp; float xr[8], xk[8], w[8], ic[8], kkw[8], kaw[8], rkw[8];
#pragma unroll
                for (int e = 0; e < 2; ++e) { const f32x4 a = *(const f32x4*)(A_wr + i * 64 + j0 + 4 * e), b2 = *(const f32x4*)(A_kd + i * 64 + j0 + 4 * e), c2 = *(const f32x4*)(A_w + i * 64 + j0 + 4 * e),
                        d2 = *(const f32x4*)(A_bb + i * 64 + j0 + 4 * e), e2 = *(const f32x4*)(PRM + j0 + 4 * e), f2 = *(const f32x4*)(PRM + 64 + j0 + 4 * e), g2 = *(const f32x4*)(PRM + 128 + j0 + 4 * e);
#pragma unroll
                    for (int x = 0; x < 4; ++x) { xr[4 * e + x] = a[x]; xk[4 * e + x] = b2[x]; w[4 * e + x] = c2[x]; ic[4 * e + x] = d2[x]; kkw[4 * e + x] = e2[x]; kaw[4 * e + x] = f2[x]; rkw[4 * e + x] = g2[x]; } }
                float ss = 0.f;
#pragma unroll
                for (int e = 0; e < 8; ++e) { const float kr_ = xk[e] * kkw[e]; ss += kr_ * kr_; }
                ss = red8(ss); const float rn = rsqrtf(ss + 1e-6f);
                float kk[8], kd[8], bb[8], br = 0.f, kr = 0.f, sb = 0.f;
#pragma unroll
                for (int e = 0; e < 8; ++e) { kk[e] = xk[e] * kkw[e] * rn; kd[e] = xk[e] * (1.f + (ic[e] - 1.f) * kaw[e]); bb[e] = kk[e] * ic[e];
                    br += bb[e] * xr[e]; kr += kd[e] * xr[e]; sb += xr[e] * kd[e] * rkw[e]; }
                br = red8(br); kr = red8(kr); sb = 0.5f * red8(sb);
#pragma unroll
                for (int e = 0; e < 2; ++e) {
                    *(f32x4*)(A_kk + i * 64 + j0 + 4 * e) = (f32x4){kk[4 * e], kk[4 * e + 1], kk[4 * e + 2], kk[4 * e + 3]};
                    *(f32x4*)(A_wr + i * 64 + j0 + 4 * e) = (f32x4){w[4 * e] * xr[4 * e], w[4 * e + 1] * xr[4 * e + 1], w[4 * e + 2] * xr[4 * e + 2], w[4 * e + 3] * xr[4 * e + 3]};
                    *(f32x4*)(A_kd + i * 64 + j0 + 4 * e) = (f32x4){kd[4 * e], kd[4 * e + 1], kd[4 * e + 2], kd[4 * e + 3]};
                    *(f32x4*)(A_bb + i * 64 + j0 + 4 * e) = (f32x4){bb[4 * e], bb[4 * e + 1], bb[4 * e + 2], bb[4 * e + 3]}; }
                if (cgp == 0) { SC[i * 4 + 0] = br; SC[i * 4 + 1] = kr; if (!isctx) SBON[((size_t)d * MLAT + rowbase + t0 + sgn * i) * 16 + h] = sb; }
            }
            __syncthreads();
            if (ch + 1 < NCHUNK) prefetch(ch + 1);
            { const int cgp = qo & 7, row = qo >> 3, j0 = 8 * cgp;
              bf16_t* yp = YD + ((size_t)d * MLAT + rowbase + t0) * 1024 + h * 64 + row;
              for (int i = 0; i < CH; ++i) {
                  float kk8[8], wr8[8], w8[8], bb8[8], kd8[8];
#pragma unroll
                  for (int e = 0; e < 2; ++e) { const f32x4 a = *(const f32x4*)(A_kk + i * 64 + j0 + 4 * e), b2 = *(const f32x4*)(A_wr + i * 64 + j0 + 4 * e), c2 = *(const f32x4*)(A_w + i * 64 + j0 + 4 * e),
                          d2 = *(const f32x4*)(A_bb + i * 64 + j0 + 4 * e), e2 = *(const f32x4*)(A_kd + i * 64 + j0 + 4 * e);
#pragma unroll
                      for (int x = 0; x < 4; ++x) { kk8[4 * e + x] = a[x]; wr8[4 * e + x] = b2[x]; w8[4 * e + x] = c2[x]; bb8[4 * e + x] = d2[x]; kd8[4 * e + x] = e2[x]; } }
                  const float v = A_v[i * 64 + row]; const float2 sc = *(const float2*)(SC + i * 4);
                  float sa = 0.f, pp = 0.f;
#pragma unroll
                  for (int j = 0; j < 8; ++j) { sa += S[j] * kk8[j]; pp += S[j] * wr8[j]; }
                  sa = red8(sa); pp = red8(pp);
                  const float y = pp - sa * sc.x + v * sc.y;
#pragma unroll
                  for (int j = 0; j < 8; ++j) S[j] = S[j] * w8[j] - sa * bb8[j] + v * kd8[j];
                  if (!isctx && cgp == 0) yp[(ptrdiff_t)sgn * i * 1024] = f2bf(y);
              } }
            __syncthreads();
        }
    }
}

constexpr int LDK = 136, LDC = 40, LDL = 36;
constexpr int G_RAW = 0, G_CW = 23040, G_SC = 29440, G_UQ = 29952, G_WK = 29952, G_VNT = 38656, G_UK = 46336, G_TM = 46336, G_QKM = 48896, G_LM = 51456, G_UV = 62720,
              G_KA = 70912, G_QA = 79616, G_QD = 88320, G_KGT = 97024, G_KTT = 107520, G_VT = 118016, G_ST = 123264, G_GC = 140672, G_T11T = 140928, G_XT = 141440;
__device__ __forceinline__ void phase_gdn(const Params& P, unsigned char* smem) {
    const int tid = threadIdx.x;
    const bf16_t* P1 = (const bf16_t*)(P.ws + WS_X);
    bf16_t* OD = (bf16_t*)P.out + (size_t)2 * MLAT * 1024;
    bf16_t* RAW = (bf16_t*)(smem + G_RAW); float* CW = (float*)(smem + G_CW); float* GSC = (float*)(smem + G_SC); float* UQ = (float*)(smem + G_UQ); float* UK = (float*)(smem + G_UK); float* UV = (float*)(smem + G_UV);
    bf16_t* WK = (bf16_t*)(smem + G_WK); bf16_t* VNT = (bf16_t*)(smem + G_VNT); bf16_t* TM = (bf16_t*)(smem + G_TM); bf16_t* QKM = (bf16_t*)(smem + G_QKM); float* LM = (float*)(smem + G_LM);
    bf16_t* KA = (bf16_t*)(smem + G_KA); bf16_t* QA = (bf16_t*)(smem + G_QA); bf16_t* QD = (bf16_t*)(smem + G_QD); bf16_t* KGT = (bf16_t*)(smem + G_KGT); bf16_t* KTT = (bf16_t*)(smem + G_KTT);
    bf16_t* VT = (bf16_t*)(smem + G_VT); bf16_t* ST = (bf16_t*)(smem + G_ST); float* GC = (float*)(smem + G_GC);
    for (int it = blockIdx.x; it < 256; it += gridDim.x) {
        const int b = it >> 5, hg = (it >> 2) & 7, d = (it >> 1) & 1, half = it & 1;
        f32x4 sacc[4];
#pragma unroll
        for (int nt = 0; nt < 4; ++nt) sacc[nt] = (f32x4){0.f, 0.f, 0.f, 0.f};
        __syncthreads();
        float cwr[5][8];
        { const int cv = tid % 40; const int ccol = cv < 16 ? hg * 128 + 8 * cv : (cv < 32 ? 1024 + hg * 128 + 8 * (cv - 16) : 2048 + hg * 128 + half * 64 + 8 * (cv - 32));
#pragma unroll
          for (int j = 0; j < 5; ++j) { const f32x4 c0 = *(const f32x4*)(P.in[19] + j * 3072 + ccol), c1 = *(const f32x4*)(P.in[19] + j * 3072 + ccol + 4);
#pragma unroll
              for (int x = 0; x < 4; ++x) { cwr[j][x] = c0[x]; cwr[j][4 + x] = c1[x]; } } }
        for (int e = tid; e < 64 * LDK / 2; e += 512) ((unsigned*)ST)[e] = 0u;
        const float alog = -__expf(P.in[20][d * 8 + hg]), dtb = P.in[21][d * 8 + hg];
        unsigned pre[3][4]; unsigned pab = 0;
        auto prefetch = [&](int ch) {
            const bool isctx = ch < 8;
            const int sbase = isctx ? ch * CH : (ch - 8) * CH, Tlen = isctx ? TC : TL;
            const int rowbase = isctx ? MLAT + b * TC : b * TL;
            const int t0 = d == 0 ? sbase : Tlen - 1 - sbase, sgn = d == 0 ? 1 : -1;
            const int lo = d == 0 ? sbase : Tlen - sbase - CH;
            const u32x4 zz = {0u, 0u, 0u, 0u};
            int qv = tid; asm volatile("" : "+v"(qv));
#pragma unroll
            for (int n = 0; n < 3; ++n) { const int s = qv + 512 * n, wt = s / 40, cv = s % 40; const int t = lo - 2 + wt;
                const int col = COL_CV + (cv < 16 ? hg * 128 + 8 * cv : (cv < 32 ? 1024 + hg * 128 + 8 * (cv - 16) : 2048 + hg * 128 + half * 64 + 8 * (cv - 32)));
                const u32x4 gv_ = (s < 1440 && t >= 0 && t < Tlen) ? *(const u32x4*)(P1 + (size_t)(rowbase + t) * LD1 + col) : zz; pre[n][0] = gv_.x; pre[n][1] = gv_.y; pre[n][2] = gv_.z; pre[n][3] = gv_.w; }
            if (qv < CH) { const int t = t0 + sgn * qv; const bf16_t* ro = P1 + (size_t)(rowbase + t) * LD1 + COL_AB;
                pab = (unsigned)ro[d * 8 + hg] | ((unsigned)ro[16 + d * 8 + hg] << 16); }
        };
        auto consumeA = [&]() {
            int qa = tid; asm volatile("" : "+v"(qa));
#pragma unroll
            for (int n = 0; n < 3; ++n) { const int s = qa + 512 * n; if (s < 1440) *(u32x4*)(RAW + s * 8) = (u32x4){pre[n][0], pre[n][1], pre[n][2], pre[n][3]}; }
            if (qa < CH) { const float a_raw = __uint_as_float(pab << 16), b_raw = __uint_as_float(pab & 0xffff0000u);
                const float xx = a_raw + dtb; const float sp = xx > 20.f ? xx : __logf(1.f + __expf(xx));
                GSC[qa * 4 + 0] = alog * sp; GSC[qa * 4 + 1] = sigm(b_raw); }
        };
        prefetch(0);
        consumeA();
        __syncthreads();
        for (int ch = 0; ch < NCHUNK; ++ch) {
            int qo = tid; asm volatile("" : "+v"(qo));
            const int lane = qo & 63, wave = qo >> 6, fr = lane & 15, fq = lane >> 4;
            const bool isctx = ch < 8;
            const int sbase = isctx ? ch * CH : (ch - 8) * CH, Tlen = isctx ? TC : TL;
            const int rowbase = isctx ? MLAT + b * TC : b * TL;
            const int t0 = d == 0 ? sbase : Tlen - 1 - sbase, sgn = d == 0 ? 1 : -1;
            if (ch + 1 < NCHUNK) prefetch(ch + 1);
            if (qo < 480) { const int cv = qo % 40, tg = qo / 40; const int ntok = tg < 8 ? 3 : 2, tok0 = tg < 8 ? 3 * tg : 24 + 2 * (tg - 8);
                u32x4 raw[7];
#pragma unroll
                for (int r = 0; r < 7; ++r) { const int rr = tok0 + r < 36 ? tok0 + r : 35; raw[r] = *(const u32x4*)(RAW + rr * 320 + 8 * cv); }
#pragma unroll
                for (int o = 0; o < 3; ++o) if (o < ntok) { float acc[8];
#pragma unroll
                    for (int e = 0; e < 8; ++e) { float a_ = 0.f;
#pragma unroll
                        for (int j = 0; j < 5; ++j) { const unsigned w_ = raw[o + j][e >> 1]; a_ += cwr[j][e] * __uint_as_float((e & 1) ? (w_ & 0xffff0000u) : (w_ << 16)); }
                        acc[e] = a_ * sigm(a_); }
                    const int wt_ = tok0 + o, i = (d == 0 ? wt_ : CH - 1 - wt_);
                    float* dst = cv < 16 ? UQ + i * 128 + 8 * cv : (cv < 32 ? UK + i * 128 + 8 * (cv - 16) : UV + i * 64 + 8 * (cv - 32));
                    *(f32x4*)dst = (f32x4){acc[0], acc[1], acc[2], acc[3]}; *(f32x4*)(dst + 4) = (f32x4){acc[4], acc[5], acc[6], acc[7]}; } }
            if (wave == 7) { float g = lane < CH ? GSC[lane * 4] : 0.f;
#pragma unroll
                for (int o = 1; o < 32; o <<= 1) { const float t = __shfl_up(g, o); if (lane >= o) g += t; }
                if (lane < CH) GC[lane] = g; }
            __syncthreads();
            { const int i = qo >> 4, cg = qo & 15, j0 = 8 * cg;
              float qv8[8], kv8[8];
#pragma unroll
              for (int e = 0; e < 2; ++e) { const f32x4 a = *(const f32x4*)(UQ + i * 128 + j0 + 4 * e), b2 = *(const f32x4*)(UK + i * 128 + j0 + 4 * e);
#pragma unroll
                  for (int x = 0; x < 4; ++x) { qv8[4 * e + x] = a[x]; kv8[4 * e + x] = b2[x]; } }
              float sq = 0.f, sk = 0.f;
#pragma unroll
              for (int e = 0; e < 8; ++e) { sq += qv8[e] * qv8[e]; sk += kv8[e] * kv8[e]; }
              sq = red16(sq); sk = red16(sk);
              const float rq = rsqrtf(sq + 1e-6f) * 0.08838834764831845f, rk = rsqrtf(sk + 1e-6f);
              const float gci = GC[i], gcl = GC[CH - 1], beta = GSC[i * 4 + 1];
              const float eg = __expf(gci), et = __expf(gcl - gci), bg = beta * eg;
              float vv[8];
              if (cg < 8) { const f32x4 a = *(const f32x4*)(UV + i * 64 + j0), b2 = *(const f32x4*)(UV + i * 64 + j0 + 4);
#pragma unroll
                  for (int x = 0; x < 4; ++x) { vv[x] = a[x]; vv[4 + x] = b2[x]; } }
#pragma unroll
              for (int e = 0; e < 8; ++e) { qv8[e] *= rq; kv8[e] *= rk; }
              u32x4 w;
              w.x = pk2(kv8[0], kv8[1]); w.y = pk2(kv8[2], kv8[3]); w.z = pk2(kv8[4], kv8[5]); w.w = pk2(kv8[6], kv8[7]); *(u32x4*)(KA + i * LDK + j0) = w;
              w.x = pk2(qv8[0], qv8[1]); w.y = pk2(qv8[2], qv8[3]); w.z = pk2(qv8[4], qv8[5]); w.w = pk2(qv8[6], qv8[7]); *(u32x4*)(QA + i * LDK + j0) = w;
              w.x = pk2(qv8[0] * eg, qv8[1] * eg); w.y = pk2(qv8[2] * eg, qv8[3] * eg); w.z = pk2(qv8[4] * eg, qv8[5] * eg); w.w = pk2(qv8[6] * eg, qv8[7] * eg); *(u32x4*)(QD + i * LDK + j0) = w;
              w.x = pk2(kv8[0] * bg, kv8[1] * bg); w.y = pk2(kv8[2] * bg, kv8[3] * bg); w.z = pk2(kv8[4] * bg, kv8[5] * bg); w.w = pk2(kv8[6] * bg, kv8[7] * bg); *(u32x4*)(KGT + i * 144 + j0) = w;
              w.x = pk2(kv8[0] * et, kv8[1] * et); w.y = pk2(kv8[2] * et, kv8[3] * et); w.z = pk2(kv8[4] * et, kv8[5] * et); w.w = pk2(kv8[6] * et, kv8[7] * et); *(u32x4*)(KTT + i * 144 + j0) = w;
              if (cg < 8) { w.x = pk2(vv[0] * beta, vv[1] * beta); w.y = pk2(vv[2] * beta, vv[3] * beta); w.z = pk2(vv[4] * beta, vv[5] * beta); w.w = pk2(vv[6] * beta, vv[7] * beta); *(u32x4*)(VT + i * 72 + j0) = w; } }
            __syncthreads();
            { const int mt = (wave >> 1) & 1, nt = wave & 1; const bf16_t* Am = wave < 4 ? KA : QA;
              f32x4 acc = {0.f, 0.f, 0.f, 0.f};
#pragma unroll
              for (int ks = 0; ks < 4; ++ks) { const s16x8 a = *(const s16x8*)(KA + (nt * 16 + fr) * LDK + ks * 32 + fq * 8), bb = *(const s16x8*)(Am + (mt * 16 + fr) * LDK + ks * 32 + fq * 8);
                  acc = MFMA16(a, bb, acc); }
              const int i = mt * 16 + fr; const float gci = GC[i], bi = GSC[i * 4 + 1];
              const f32x4 gcj = *(const f32x4*)(GC + nt * 16 + fq * 4);
              float lv[4];
#pragma unroll
              for (int r = 0; r < 4; ++r) { const int j = nt * 16 + fq * 4 + r; const float dec = __expf(fminf(gci - gcj[r], 0.f));
                  lv[r] = wave < 4 ? ((i > j) ? bi * acc[r] * dec : 0.f) : ((i >= j) ? acc[r] * dec : 0.f); }
              if (wave < 4) *(f32x4*)(LM + i * LDL + nt * 16 + fq * 4) = (f32x4){lv[0], lv[1], lv[2], lv[3]};
              else { uint2 o; o.x = pk2(lv[0], lv[1]); o.y = pk2(lv[2], lv[3]); *(uint2*)(QKM + i * LDC + nt * 16 + fq * 4) = o; } }
            if (wave == 0 || wave == 3) { asm volatile("s_waitcnt lgkmcnt(0)" ::: "memory"); tri_inv_part1(LM, TM, (bf16_t*)(smem + G_T11T), wave == 0 ? 0 : 1, lane); }
            __syncthreads();
            if (wave == 0) tri_inv_part2(LM, TM, (const bf16_t*)(smem + G_T11T), (bf16_t*)(smem + G_XT), lane);
            __syncthreads();
            const int mtu = wave >> 2, ntu = wave & 3;
            f32x4 vacc;
            { const s16x8 a = *(const s16x8*)(TM + (mtu * 16 + fr) * LDC + fq * 8), bb = tr_frag(VT, 72, ntu, lane);
              vacc = MFMA16(a, bb, ((f32x4){0.f, 0.f, 0.f, 0.f}));
#pragma unroll
              for (int x = 0; x < 2; ++x) { const int tt = 2 * wave + x, mtk = tt >> 1, ntk = tt & 1;
                  const s16x8 a2 = tr_frag(KGT, 144, mtk, lane), b2 = *(const s16x8*)(TM + (ntk * 16 + fr) * LDC + fq * 8);
                  const f32x4 r = MFMA16(a2, b2, ((f32x4){0.f, 0.f, 0.f, 0.f}));
                  uint2 o; o.x = pk2(-r[0], -r[1]); o.y = pk2(-r[2], -r[3]);
                  *(uint2*)(WK + (ntk * 16 + fr) * LDK + mtk * 16 + fq * 4) = o; } }
            __syncthreads();
            f32x4 oacc = {0.f, 0.f, 0.f, 0.f};
#pragma unroll
            for (int ks = 0; ks < 4; ++ks) { const s16x8 bs = *(const s16x8*)(ST + (ntu * 16 + fr) * LDK + ks * 32 + fq * 8);
                const s16x8 aw = *(const s16x8*)(WK + (mtu * 16 + fr) * LDK + ks * 32 + fq * 8), aq = *(const s16x8*)(QD + (mtu * 16 + fr) * LDK + ks * 32 + fq * 8);
                vacc = MFMA16(aw, bs, vacc); oacc = MFMA16(aq, bs, oacc); }
            { uint2 o; o.x = pk2(vacc[0], vacc[1]); o.y = pk2(vacc[2], vacc[3]); *(uint2*)(VNT + (ntu * 16 + fr) * LDC + mtu * 16 + fq * 4) = o; }
            __syncthreads();
            { const s16x8 a = *(const s16x8*)(QKM + (mtu * 16 + fr) * LDC + fq * 8), bb = *(const s16x8*)(VNT + (ntu * 16 + fr) * LDC + fq * 8);
              oacc = MFMA16(a, bb, oacc);
              if (!isctx) { bf16_t* op = OD + ((size_t)d * MLAT + rowbase + t0) * 1024 + hg * 128 + half * 64 + ntu * 16 + fr;
#pragma unroll
                  for (int r = 0; r < 4; ++r) op[(ptrdiff_t)sgn * (mtu * 16 + fq * 4 + r) * 1024] = f2bf(oacc[r]); }
              const float gl = __expf(GC[CH - 1]);
              const s16x8 ak = tr_frag(KTT, 144, wave, lane);
#pragma unroll
              for (int nt = 0; nt < 4; ++nt) { const s16x8 bv = *(const s16x8*)(VNT + (nt * 16 + fr) * LDC + fq * 8);
                  sacc[nt] = MFMA16(ak, bv, sacc[nt] * gl);
                  uint2 o; o.x = pk2(sacc[nt][0], sacc[nt][1]); o.y = pk2(sacc[nt][2], sacc[nt][3]);
                  *(uint2*)(ST + (nt * 16 + fr) * LDK + wave * 16 + fq * 4) = o; } }
            if (ch + 1 < NCHUNK) consumeA();
            __syncthreads();
        }
    }
}

constexpr int LK2 = 72;
constexpr int R_WR = 0, R_KD = 8192, R_W = 16384, R_BB = 24576, R_LM = 0, R_TM = 4608, R_AKM = 7168, R_RKM = 9728, R_RBM = 12288, R_WM = 14848, R_X1T = 19456, R_NUT = 24576,
              R_V = 32768, R_THW = 40960, R_THA = 47104, R_GAM = 53248, R_PRM = 61440, R_AT = 62464, R_RT = 67072, R_KT = 71680, R_BT = 76288,
              R_ATT = 80896, R_KTT = 86144, R_BTT = 91392, R_VT = 96640, R_ST = 101888, R_T11T = 111104, R_XT = 111616;
__device__ __forceinline__ void phase_rwkv_chunked(const Params& P, unsigned char* smem) {
    const int tid = threadIdx.x;
    const bf16_t* P1 = (const bf16_t*)(P.ws + WS_X);
    bf16_t* YD = (bf16_t*)P.out;
    float* SBON = (float*)(P.ws + WS_M + MiB);
    float* A_wr = (float*)(smem + R_WR); float* A_kd = (float*)(smem + R_KD); float* A_w = (float*)(smem + R_W); float* A_bb = (float*)(smem + R_BB); float* A_v = (float*)(smem + R_V);
    bf16_t* TH_w = (bf16_t*)(smem + R_THW); bf16_t* TH_a = (bf16_t*)(smem + R_THA); float* GAM = (float*)(smem + R_GAM); float* PRM = (float*)(smem + R_PRM);
    float* LM = (float*)(smem + R_LM); bf16_t* TM = (bf16_t*)(smem + R_TM); bf16_t* AKM = (bf16_t*)(smem + R_AKM); bf16_t* RKM = (bf16_t*)(smem + R_RKM); bf16_t* RBM = (bf16_t*)(smem + R_RBM);
    bf16_t* WM = (bf16_t*)(smem + R_WM); bf16_t* X1T = (bf16_t*)(smem + R_X1T); bf16_t* NUT = (bf16_t*)(smem + R_NUT);
    bf16_t* AT = (bf16_t*)(smem + R_AT); bf16_t* RT = (bf16_t*)(smem + R_RT); bf16_t* KT = (bf16_t*)(smem + R_KT); bf16_t* BT = (bf16_t*)(smem + R_BT);
    bf16_t* ATT = (bf16_t*)(smem + R_ATT); bf16_t* KTT = (bf16_t*)(smem + R_KTT); bf16_t* BTT = (bf16_t*)(smem + R_BTT); bf16_t* VT = (bf16_t*)(smem + R_VT); bf16_t* ST = (bf16_t*)(smem + R_ST);
    const float* mu = P.in[8];
    for (int it = blockIdx.x; it < 256; it += gridDim.x) {
        const int b = it >> 5, h = (it >> 1) & 15, d = it & 1;
        f32x4 sacc[2];
        sacc[0] = (f32x4){0.f, 0.f, 0.f, 0.f}; sacc[1] = (f32x4){0.f, 0.f, 0.f, 0.f};
        s16x8 Bw[3], Ba[3];
        __syncthreads();
        { const int lane = tid & 63, wave = tid >> 6; const int cB = h * 64 + 16 * (wave & 3) + (lane & 15);
#pragma unroll
          for (int ks = 0; ks < 3; ++ks)
#pragma unroll
            for (int j = 0; j < 8; ++j) { const int k = ks * 32 + (lane >> 4) * 8 + j;
                Bw[ks][j] = (short)f2bf(P.in[10][((size_t)d * 96 + k) * 1024 + cB]); Ba[ks][j] = (short)f2bf(P.in[12][((size_t)d * 96 + k) * 1024 + cB]); }
          if (tid < 64) { PRM[tid] = P.in[14][h * 64 + tid]; PRM[64 + tid] = P.in[15][h * 64 + tid]; PRM[128 + tid] = P.in[16][h * 64 + tid]; }
          for (int e = tid; e < 64 * LK2 / 2; e += 512) ((unsigned*)ST)[e] = 0u; }
        const float w0c = P.in[9][d * 1024 + h * 64 + 16 * ((tid >> 6) & 3) + (tid & 15)], a0c = P.in[11][d * 1024 + h * 64 + 16 * ((tid >> 6) & 3) + (tid & 15)];
        unsigned pre[3][12];
        auto prefetch = [&](int ch) {
            const bool isctx = ch < 8;
            const int sbase = isctx ? ch * CH : (ch - 8) * CH, Tlen = isctx ? TC : TL;
            const int rowbase = isctx ? MLAT + b * TC : b * TL;
            const int t0 = d == 0 ? sbase : Tlen - 1 - sbase, sgn = d == 0 ? 1 : -1;
            const u32x4 zz = {0u, 0u, 0u, 0u};
            int qv = tid; asm volatile("" : "+v"(qv));
#pragma unroll
            for (int n = 0; n < 3; ++n) { const int ws = n * 8 + (qv >> 6), ln_ = qv & 63; const int L_ = (ws < 12 ? ws : (ws < 18 ? ws - 12 : ws - 18)) * 64 + ln_;
                const int i = ws < 12 ? L_ / 24 : L_ / 12, cv = ws < 12 ? L_ % 24 : (ws < 18 ? 24 + L_ % 12 : 36 + L_ % 12); const int t = t0 + sgn * i;
                const int col = cv < 8 ? h * 64 + 8 * cv : (cv < 16 ? 1024 + h * 64 + 8 * (cv - 8) : (cv < 24 ? 2048 + h * 64 + 8 * (cv - 16) : (cv < 36 ? 3072 + d * 96 + 8 * (cv - 24) : 3264 + d * 96 + 8 * (cv - 36))));
                const bf16_t* pp = P1 + (size_t)(rowbase + t) * LD1 + col;
                { const u32x4 pv_ = *(const u32x4*)pp; pre[n][0] = pv_.x; pre[n][1] = pv_.y; pre[n][2] = pv_.z; pre[n][3] = pv_.w; }
                const unsigned* pw = (const unsigned*)pp; constexpr int LW = LD1 / 2;
                if (isctx) { const bool vl = t > 0, vr = t < TC - 1;
                    const u32x4 L = vl ? *(const u32x4*)(pp - LD1) : zz, R = vr ? *(const u32x4*)(pp + LD1) : zz;
                    pre[n][4] = L.x; pre[n][5] = L.y; pre[n][6] = L.z; pre[n][7] = L.w; pre[n][8] = R.x; pre[n][9] = R.y; pre[n][10] = R.z; pre[n][11] = R.w; }
                else { const int x = t & 63, y = t >> 6; const bool vl = x > 0, vr = x < 63, vu = y > 0, vd = y < 31;
                    pre[n][4] = vl ? pw[-LW + 0] : 0u; pre[n][5] = vl ? pw[-LW + 2] : 0u; pre[n][6] = vr ? pw[LW + 0] : 0u; pre[n][7] = vr ? pw[LW + 2] : 0u;
                    pre[n][8] = vu ? pw[-64 * LW + 1] : 0u; pre[n][9] = vu ? pw[-64 * LW + 3] : 0u; pre[n][10] = vd ? pw[64 * LW + 1] : 0u; pre[n][11] = vd ? pw[64 * LW + 3] : 0u; } }
        };
        prefetch(0);
        for (int ch = 0; ch < NCHUNK; ++ch) {
            int qo = tid; asm volatile("" : "+v"(qo));
            const int lane = qo & 63, wave = qo >> 6, fr = lane & 15, fq = lane >> 4;
            const bool isctx = ch < 8;
            const int sbase = isctx ? ch * CH : (ch - 8) * CH, Tlen = isctx ? TC : TL;
            const int rowbase = isctx ? MLAT + b * TC : b * TL;
            const int t0 = d == 0 ? sbase : Tlen - 1 - sbase, sgn = d == 0 ? 1 : -1;
#pragma unroll
            for (int n = 0; n < 3; ++n) { const int ws = n * 8 + wave; const int L_ = (ws < 12 ? ws : (ws < 18 ? ws - 12 : ws - 18)) * 64 + lane;
                const int i = ws < 12 ? L_ / 24 : L_ / 12, cv = ws < 12 ? L_ % 24 : (ws < 18 ? 24 + L_ % 12 : 36 + L_ % 12);
                const int col = cv < 8 ? h * 64 + 8 * cv : (cv < 16 ? 1024 + h * 64 + 8 * (cv - 8) : (cv < 24 ? 2048 + h * 64 + 8 * (cv - 16) : (cv < 36 ? 3072 + d * 96 + 8 * (cv - 24) : 3264 + d * 96 + 8 * (cv - 36))));
                const f32x4 m0 = *(const f32x4*)(mu + col), m1 = *(const f32x4*)(mu + col + 4);
                float xs[8];
#pragma unroll
                for (int e = 0; e < 8; ++e) { const float p = __uint_as_float((e & 1) ? (pre[n][e >> 1] & 0xffff0000u) : (pre[n][e >> 1] << 16));
                    unsigned wv_; const bool hi = (e & 1);
                    if (isctx) wv_ = (e & 1) ? pre[n][8 + (e >> 1)] : pre[n][4 + (e >> 1)];
                    else wv_ = pre[n][4 + 2 * (e & 3) + (e >> 2)];
                    const float ps = __uint_as_float(hi ? (wv_ & 0xffff0000u) : (wv_ << 16));
                    xs[e] = p + (ps - p) * (e < 4 ? m0[e & 3] : m1[e & 3]); }
                if (cv < 24) { float* dst = (cv < 8 ? A_wr + i * 64 + 8 * cv : (cv < 16 ? A_kd + i * 64 + 8 * (cv - 8) : A_v + i * 64 + 8 * (cv - 16)));
                    *(f32x4*)dst = (f32x4){xs[0], xs[1], xs[2], xs[3]}; *(f32x4*)(dst + 4) = (f32x4){xs[4], xs[5], xs[6], xs[7]}; }
                else if (cv < 36) { u32x4 w; w.x = pk2(tanh_fast(xs[0]), tanh_fast(xs[1])); w.y = pk2(tanh_fast(xs[2]), tanh_fast(xs[3])); w.z = pk2(tanh_fast(xs[4]), tanh_fast(xs[5])); w.w = pk2(tanh_fast(xs[6]), tanh_fast(xs[7]));
                    *(u32x4*)(TH_w + i * 96 + 8 * (cv - 24)) = w; }
                else { u32x4 w; w.x = pk2(xs[0], xs[1]); w.y = pk2(xs[2], xs[3]); w.z = pk2(xs[4], xs[5]); w.w = pk2(xs[6], xs[7]);
                    *(u32x4*)(TH_a + i * 96 + 8 * (cv - 36)) = w; } }
            __syncthreads();
            if (ch + 1 < NCHUNK) prefetch(ch + 1);
            if (wave < 4) { const int c = 16 * wave + fr;
              float wv[2][4];
#pragma unroll
              for (int rt = 0; rt < 2; ++rt) { f32x4 cw = {0.f, 0.f, 0.f, 0.f}, ca = {0.f, 0.f, 0.f, 0.f};
#pragma unroll
                  for (int ks = 0; ks < 3; ++ks) { const int off = (rt * 16 + fr) * 96 + ks * 32 + fq * 8;
                      const s16x8 fa = *(const s16x8*)(TH_w + off), fb = *(const s16x8*)(TH_a + off);
                      cw = MFMA16(fa, Bw[ks], cw); ca = MFMA16(fb, Ba[ks], ca); }
#pragma unroll
                  for (int j = 0; j < 4; ++j) { const int i = rt * 16 + fq * 4 + j;
                      wv[rt][j] = __expf(-0.6065306597126334f * sigm(w0c + cw[j])); A_bb[i * 64 + c] = sigm(a0c + ca[j]); } }
              float tot[2];
#pragma unroll
              for (int rt = 0; rt < 2; ++rt) { wv[rt][1] *= wv[rt][0]; wv[rt][2] *= wv[rt][1]; wv[rt][3] *= wv[rt][2];
                  float sx = wv[rt][3]; float u1 = __shfl_up(sx, 16); if (fq >= 1) sx *= u1; float u2 = __shfl_up(sx, 32); if (fq >= 2) sx *= u2;
                  float ex = __shfl_up(sx, 16); if (fq == 0) ex = 1.f;
                  tot[rt] = __shfl(sx, 48 + fr);
                  const float base = ex * (rt == 1 ? tot[0] : 1.f);
#pragma unroll
                  for (int j = 0; j < 4; ++j) GAM[(rt * 16 + fq * 4 + j) * 64 + c] = base * wv[rt][j]; } }
            __syncthreads();
            { const int i = qo >> 4, cg = qo & 15, j0 = 4 * cg;
              const f32x4 xr = *(const f32x4*)(A_wr + i * 64 + j0), xk = *(const f32x4*)(A_kd + i * 64 + j0), ic = *(const f32x4*)(A_bb + i * 64 + j0), xv = *(const f32x4*)(A_v + i * 64 + j0);
              const f32x4 kkw = *(const f32x4*)(PRM + j0), kaw = *(const f32x4*)(PRM + 64 + j0), rkw = *(const f32x4*)(PRM + 128 + j0);
              const f32x4 gi = *(const f32x4*)(GAM + i * 64 + j0), gl = *(const f32x4*)(GAM + 31 * 64 + j0);
              f32x4 gp = {1.f, 1.f, 1.f, 1.f}; if (i > 0) gp = *(const f32x4*)(GAM + (i - 1) * 64 + j0);
              const f32x4 kkr = xk * kkw;
              const float ss = red16(kkr[0] * kkr[0] + kkr[1] * kkr[1] + kkr[2] * kkr[2] + kkr[3] * kkr[3]);
              const f32x4 kk = kkr * rsqrtf(ss + 1e-6f);
              f32x4 kd, bb, at, rt_, kt, bt, ktl, btl; float sbp = 0.f;
#pragma unroll
              for (int e = 0; e < 4; ++e) { kd[e] = xk[e] * (1.f + (ic[e] - 1.f) * kaw[e]); bb[e] = kk[e] * ic[e]; sbp += xr[e] * kd[e] * rkw[e];
                  const float ig = __builtin_amdgcn_rcpf(gi[e]); at[e] = kk[e] * gp[e]; rt_[e] = xr[e] * gi[e]; kt[e] = kd[e] * ig; bt[e] = bb[e] * ig; ktl[e] = kt[e] * gl[e]; btl[e] = bt[e] * gl[e]; }
              const float sb = 0.5f * red16(sbp);
              if (cg == 0 && !isctx) SBON[((size_t)d * MLAT + rowbase + t0 + sgn * i) * 16 + h] = sb;
              uint2 o;
              o.x = pk2(at[0], at[1]); o.y = pk2(at[2], at[3]); *(uint2*)(AT + i * LK2 + j0) = o;
              o.x = pk2(rt_[0], rt_[1]); o.y = pk2(rt_[2], rt_[3]); *(uint2*)(RT + i * LK2 + j0) = o;
              o.x = pk2(kt[0], kt[1]); o.y = pk2(kt[2], kt[3]); *(uint2*)(KT + i * LK2 + j0) = o;
              o.x = pk2(bt[0], bt[1]); o.y = pk2(bt[2], bt[3]); *(uint2*)(BT + i * LK2 + j0) = o;
              o.x = pk2(ktl[0], ktl[1]); o.y = pk2(ktl[2], ktl[3]); *(uint2*)(KTT + i * LK2 + j0) = o;
              o.x = pk2(btl[0], btl[1]); o.y = pk2(btl[2], btl[3]); *(uint2*)(BTT + i * LK2 + j0) = o;
              o.x = pk2(xv[0], xv[1]); o.y = pk2(xv[2], xv[3]); *(uint2*)(VT + i * LK2 + j0) = o; }
            __syncthreads();
#pragma unroll
            for (int x = 0; x < 2; ++x) { const int t = 2 * wave + x, m = t >> 2, mt = (t >> 1) & 1, nt = t & 1;
                const bf16_t* Am = m < 2 ? AT : RT; const bf16_t* Bm = (m == 0 || m == 3) ? BT : KT;
                f32x4 acc = {0.f, 0.f, 0.f, 0.f};
#pragma unroll
                for (int ks = 0; ks < 2; ++ks) { const s16x8 a = *(const s16x8*)(Bm + (nt * 16 + fr) * LK2 + ks * 32 + fq * 8), bb2 = *(const s16x8*)(Am + (mt * 16 + fr) * LK2 + ks * 32 + fq * 8);
                    acc = MFMA16(a, bb2, acc); }
                const int i = mt * 16 + fr; float lv[4];
#pragma unroll
                for (int r = 0; r < 4; ++r) { const int j = nt * 16 + fq * 4 + r; lv[r] = (m < 2 ? (i > j) : (i >= j)) ? acc[r] : 0.f; }
                if (m == 0) *(f32x4*)(LM + i * LDL + nt * 16 + fq * 4) = (f32x4){lv[0], lv[1], lv[2], lv[3]};
                else { bf16_t* dstm = m == 1 ? AKM : (m == 2 ? RKM : RBM); uint2 o; o.x = pk2(lv[0], lv[1]); o.y = pk2(lv[2], lv[3]); *(uint2*)(dstm + i * LDC + nt * 16 + fq * 4) = o; } }
            if (wave < 2) { asm volatile("s_waitcnt lgkmcnt(0)" ::: "memory"); tri_inv_part1(LM, TM, (bf16_t*)(smem + R_T11T), wave, lane); }
            __syncthreads();
            if (wave == 0) tri_inv_part2(LM, TM, (const bf16_t*)(smem + R_T11T), (bf16_t*)(smem + R_XT), lane);
            else {
                const int ntile = (wave == 1) ? 2 : 1;
                for (int q2 = 0; q2 < ntile; ++q2) { const int tl = (q2 == 0) ? wave : 0; const int mt = tl >> 2, nt = tl & 3;
                    const s16x8 a = *(const s16x8*)(AKM + (mt * 16 + fr) * LDC + fq * 8), bb2 = tr_frag(VT, LK2, nt, lane);
                    const f32x4 r = MFMA16(a, bb2, ((f32x4){0.f, 0.f, 0.f, 0.f}));
                    uint2 o; o.x = pk2(r[0], r[1]); o.y = pk2(r[2], r[3]); *(uint2*)(X1T + (nt * 16 + fr) * LDC + mt * 16 + fq * 4) = o; }
            }
            __syncthreads();
            const int mtu = wave >> 2, ntu = wave & 3;
            f32x4 uacc;
            { const s16x8 a = *(const s16x8*)(TM + (mtu * 16 + fr) * LDC + fq * 8), bb2 = *(const s16x8*)(X1T + (ntu * 16 + fr) * LDC + fq * 8);
              uacc = MFMA16(a, bb2, ((f32x4){0.f, 0.f, 0.f, 0.f}));
              const int kt_ = wave >> 1, it_ = wave & 1;
              const s16x8 a2 = tr_frag(AT, LK2, kt_, lane), b2 = *(const s16x8*)(TM + (it_ * 16 + fr) * LDC + fq * 8);
              const f32x4 r = MFMA16(a2, b2, ((f32x4){0.f, 0.f, 0.f, 0.f}));
              uint2 o; o.x = pk2(r[0], r[1]); o.y = pk2(r[2], r[3]); *(uint2*)(WM + (it_ * 16 + fr) * LK2 + kt_ * 16 + fq * 4) = o; }
            __syncthreads();
            f32x4 yacc = {0.f, 0.f, 0.f, 0.f};
#pragma unroll
            for (int ks = 0; ks < 2; ++ks) { const s16x8 bs = *(const s16x8*)(ST + (ntu * 16 + fr) * LK2 + ks * 32 + fq * 8);
                const s16x8 aw = *(const s16x8*)(WM + (mtu * 16 + fr) * LK2 + ks * 32 + fq * 8), ar = *(const s16x8*)(RT + (mtu * 16 + fr) * LK2 + ks * 32 + fq * 8);
                uacc = MFMA16(aw, bs, uacc); yacc = MFMA16(ar, bs, yacc); }
            { const s16x8 a = *(const s16x8*)(RKM + (mtu * 16 + fr) * LDC + fq * 8), bb2 = tr_frag(VT, LK2, ntu, lane);
              yacc = MFMA16(a, bb2, yacc);
              uint2 o; o.x = pk2(-uacc[0], -uacc[1]); o.y = pk2(-uacc[2], -uacc[3]); *(uint2*)(NUT + (ntu * 16 + fr) * LDC + mtu * 16 + fq * 4) = o; }
            __syncthreads();
            { const s16x8 a = *(const s16x8*)(RBM + (mtu * 16 + fr) * LDC + fq * 8), bb2 = *(const s16x8*)(NUT + (ntu * 16 + fr) * LDC + fq * 8);
              yacc = MFMA16(a, bb2, yacc);
              if (!isctx) { bf16_t* yp = YD + ((size_t)d * MLAT + rowbase + t0) * 1024 + h * 64 + ntu * 16 + fr;
#pragma unroll
                  for (int r = 0; r < 4; ++r) yp[(ptrdiff_t)sgn * (mtu * 16 + fq * 4 + r) * 1024] = f2bf(yacc[r]); }
              const int kt_ = wave >> 1;
              const f32x4 gl = *(const f32x4*)(GAM + 31 * 64 + kt_ * 16 + fq * 4);
              const s16x8 ak = tr_frag(KTT, LK2, kt_, lane), ab = tr_frag(BTT, LK2, kt_, lane);
#pragma unroll
              for (int x = 0; x < 2; ++x) { const int vt = 2 * (wave & 1) + x;
                  const s16x8 bv = tr_frag(VT, LK2, vt, lane), bu = *(const s16x8*)(NUT + (vt * 16 + fr) * LDC + fq * 8);
                  sacc[x] = MFMA16(ak, bv, sacc[x] * gl); sacc[x] = MFMA16(ab, bu, sacc[x]);
                  uint2 o; o.x = pk2(sacc[x][0], sacc[x][1]); o.y = pk2(sacc[x][2], sacc[x][3]);
                  *(uint2*)(ST + (vt * 16 + fr) * LK2 + kt_ * 16 + fq * 4) = o; } }
            __syncthreads();
        }
    }
}


__device__ __forceinline__ void mix8_lat(const bf16_t* P1, int row, int col0, const float* mu, float (&xs)[8]) {
    const int t = row & (TL - 1), x = t & 63, y = t >> 6; const bool vl = x > 0, vr = x < 63, vu = y > 0, vd = y < 31;
    const bf16_t* pp = P1 + (size_t)row * LD1 + col0; const unsigned* pw = (const unsigned*)pp; constexpr int LW = LD1 / 2;
    const u32x4 pv = *(const u32x4*)pp;
    unsigned nb[8];
    nb[0] = vl ? pw[-LW + 0] : 0u; nb[1] = vl ? pw[-LW + 2] : 0u; nb[2] = vr ? pw[LW + 0] : 0u; nb[3] = vr ? pw[LW + 2] : 0u;
    nb[4] = vu ? pw[-64 * LW + 1] : 0u; nb[5] = vu ? pw[-64 * LW + 3] : 0u; nb[6] = vd ? pw[64 * LW + 1] : 0u; nb[7] = vd ? pw[64 * LW + 3] : 0u;
    const f32x4 m0 = *(const f32x4*)(mu + col0), m1 = *(const f32x4*)(mu + col0 + 4);
#pragma unroll
    for (int e = 0; e < 8; ++e) { const float p = __uint_as_float((e & 1) ? (pv[e >> 1] & 0xffff0000u) : (pv[e >> 1] << 16));
        const unsigned w_ = nb[2 * (e & 3) + (e >> 2)]; const float ps = __uint_as_float((e & 1) ? (w_ & 0xffff0000u) : (w_ << 16));
        xs[e] = p + (ps - p) * (e < 4 ? m0[e & 3] : m1[e & 3]); }
}
__device__ __forceinline__ void phase_sg(const Params& P) {
    const bf16_t* P1 = (const bf16_t*)(P.ws + WS_X); bf16_t* SG = (bf16_t*)(P.ws + WS_A + 32 * MiB);
    const int gt = blockIdx.x * 512 + threadIdx.x, NT = gridDim.x * 512;
    for (int s = gt; s < MLAT * 32; s += NT) { const int row = s >> 5, k8 = s & 31;
        u32x4 w = {0u, 0u, 0u, 0u};
        if (k8 < 8) { float xs[8]; mix8_lat(P1, row, 3456 + 8 * k8, P.in[8], xs);
            w.x = pk2(sigm(xs[0]), sigm(xs[1])); w.y = pk2(sigm(xs[2]), sigm(xs[3])); w.z = pk2(sigm(xs[4]), sigm(xs[5])); w.w = pk2(sigm(xs[6]), sigm(xs[7])); }
        *(u32x4*)(SG + (size_t)row * 256 + 8 * k8) = w; }
}
__device__ __forceinline__ void phase_readout_rwkv(const Params& P) {
    const bf16_t* P1 = (const bf16_t*)(P.ws + WS_X); const bf16_t* YD = (const bf16_t*)P.out; const float* SBON = (const float*)(P.ws + WS_M + MiB);
    bf16_t* OA = (bf16_t*)(P.ws + WS_A);
    const float* lnw = P.in[17]; const float* lnb = P.in[18];
    const int gt = blockIdx.x * 512 + threadIdx.x, NT = gridDim.x * 512;
    for (int s = gt; s < MLAT * 128; s += NT) { const int row = s >> 7, cv = s & 127, c0 = 8 * cv, hd = cv >> 3;
        const u32x4 y0 = *(const u32x4*)(YD + (size_t)row * 1024 + c0), y1 = *(const u32x4*)(YD + ((size_t)MLAT + row) * 1024 + c0), gg = *(const u32x4*)(OA + (size_t)row * 1024 + c0);
        float xv[8]; mix8_lat(P1, row, 2048 + c0, P.in[8], xv);
        const float sb = SBON[(size_t)row * 16 + hd] + SBON[((size_t)MLAT + row) * 16 + hd];
        const f32x4 w0 = *(const f32x4*)(lnw + c0), w1 = *(const f32x4*)(lnw + c0 + 4), b0 = *(const f32x4*)(lnb + c0), b1 = *(const f32x4*)(lnb + c0 + 4);
        float y[8], sum = 0.f;
#pragma unroll
        for (int e = 0; e < 8; ++e) { const unsigned a_ = y0[e >> 1], b_ = y1[e >> 1];
            y[e] = __uint_as_float((e & 1) ? (a_ & 0xffff0000u) : (a_ << 16)) + __uint_as_float((e & 1) ? (b_ & 0xffff0000u) : (b_ << 16)); sum += y[e]; }
        const float m = red8(sum) * (1.f / 64.f); float vs = 0.f;
#pragma unroll
        for (int e = 0; e < 8; ++e) { y[e] -= m; vs += y[e] * y[e]; }
        const float rs = rsqrtf(red8(vs) * (1.f / 64.f) + 64e-5f);
        float o[8];
#pragma unroll
        for (int e = 0; e < 8; ++e) { const unsigned g_ = gg[e >> 1]; const float gate = __uint_as_float((e & 1) ? (g_ & 0xffff0000u) : (g_ << 16));
            o[e] = (y[e] * rs * (e < 4 ? w0[e & 3] : w1[e & 3]) + (e < 4 ? b0[e & 3] : b1[e & 3]) + sb * xv[e]) * gate; }
        u32x4 w; w.x = pk2(o[0], o[1]); w.y = pk2(o[2], o[3]); w.z = pk2(o[4], o[5]); w.w = pk2(o[6], o[7]);
        *(u32x4*)(OA + (size_t)row * 1024 + c0) = w; }
}
__device__ __forceinline__ void phase_readout(const Params& P, unsigned char* smem) {
    const int tid = threadIdx.x, lane = tid & 63, wave = tid >> 6;
    const bf16_t* P1 = (const bf16_t*)(P.ws + WS_X); const bf16_t* P2 = (const bf16_t*)(P.ws + WS_D);
    const bf16_t* YD = (const bf16_t*)P.out; const bf16_t* OD = YD + (size_t)2 * MLAT * 1024;
    const float* SBON = (const float*)(P.ws + WS_M + MiB);
    bf16_t* OA = (bf16_t*)(P.ws + WS_A); bf16_t* OB = (bf16_t*)(P.ws + WS_F);
    const float* mu = P.in[8];
    { const int gw = blockIdx.x * 8 + wave, NGW = gridDim.x * 8; const float* nw = P.in[22];
      for (int row = gw; row < MLAT; row += NGW) { const int c0 = lane * 16;
        const u32x4 a0 = *(const u32x4*)(OD + (size_t)row * 1024 + c0), a1 = *(const u32x4*)(OD + (size_t)row * 1024 + c0 + 8);
        const u32x4 b0 = *(const u32x4*)(OD + ((size_t)MLAT + row) * 1024 + c0), b1 = *(const u32x4*)(OD + ((size_t)MLAT + row) * 1024 + c0 + 8);
        const u32x4 z0 = *(const u32x4*)(P2 + (size_t)row * LD2 + c0), z1 = *(const u32x4*)(P2 + (size_t)row * LD2 + c0 + 8);
        float o[16], z[16];
#pragma unroll
        for (int e = 0; e < 4; ++e) { o[2 * e] = __uint_as_float(a0[e] << 16) + __uint_as_float(b0[e] << 16); o[2 * e + 1] = __uint_as_float(a0[e] & 0xffff0000u) + __uint_as_float(b0[e] & 0xffff0000u);
            o[8 + 2 * e] = __uint_as_float(a1[e] << 16) + __uint_as_float(b1[e] << 16); o[8 + 2 * e + 1] = __uint_as_float(a1[e] & 0xffff0000u) + __uint_as_float(b1[e] & 0xffff0000u);
            z[2 * e] = __uint_as_float(z0[e] << 16); z[2 * e + 1] = __uint_as_float(z0[e] & 0xffff0000u); z[8 + 2 * e] = __uint_as_float(z1[e] << 16); z[8 + 2 * e + 1] = __uint_as_float(z1[e] & 0xffff0000u); }
        float ss = 0.f;
#pragma unroll
        for (int e = 0; e < 16; ++e) ss += o[e] * o[e];
        ss = red8(ss);
        const float rs = rsqrtf(ss * (1.f / 128.f) + 1e-6f);
        float r[16];
#pragma unroll
        for (int e = 0; e < 16; ++e) r[e] = o[e] * rs * nw[(c0 + e) & 127] * (z[e] * sigm(z[e]));
        u32x4 w0, w1;
#pragma unroll
        for (int e = 0; e < 4; ++e) { w0[e] = pk2(r[2 * e], r[2 * e + 1]); w1[e] = pk2(r[8 + 2 * e], r[8 + 2 * e + 1]); }
        *(u32x4*)(OB + (size_t)row * 1024 + c0) = w0; *(u32x4*)(OB + (size_t)row * 1024 + c0 + 8) = w1; } }
}

__global__ void __launch_bounds__(512, 2) fwd_mega(Params P) {
    extern __shared__ __attribute__((aligned(16))) unsigned char smem[];
    cg::grid_group grid = cg::this_grid();
    bf16_t* WT_IN = (bf16_t*)(P.ws + WS_A); bf16_t* WT_PA = (bf16_t*)(P.ws + WS_B); bf16_t* WT_PB = WT_PA + 2048 * 1024; bf16_t* WT_OUT = WT_PB + 2048 * 1024;
    bf16_t* P1 = (bf16_t*)(P.ws + WS_X); bf16_t* P2 = (bf16_t*)(P.ws + WS_D); bf16_t* H = (bf16_t*)P.out;
    bf16_t* OA = (bf16_t*)(P.ws + WS_A); bf16_t* OB = (bf16_t*)(P.ws + WS_F); bf16_t* MBUF = (bf16_t*)(P.ws + WS_X); bf16_t* A3 = (bf16_t*)(P.ws + WS_X);
    bf16_t* H2 = (bf16_t*)(P.ws + WS_D); bf16_t* WT_GU = (bf16_t*)(P.ws + WS_A); bf16_t* WT_DN = (bf16_t*)(P.ws + WS_F);
    const float* MOD = (const float*)(P.ws + WS_M);
#define PHASE(n) if (P.ph_lo <= (n) && (n) < P.ph_hi)
#define SEAM(n) do { if (P.coop && P.ph_lo <= (n) && (n) + 1 < P.ph_hi) grid.sync(); } while (0)
    PHASE(0) { phase_prep(P, smem); } SEAM(0);
    PHASE(1) { phase_norm1(P); } SEAM(1);
    PHASE(2) { EpiBf16Plain e1{P1, LD1}; run_gemm(smem, H, WT_IN, MALL, N1, D, e1);
               EpiBf16Plain e2{P2, LD2}; run_gemm(smem, H, WT_IN + (size_t)N1 * D, MLAT, N2, D, e2); } SEAM(2);
    PHASE(3) { phase_sg(P); phase_rwkv_chunked(P, smem); }
    PHASE(4) { phase_gdn(P, smem); } SEAM(4);
    PHASE(5) { EpiBf16Plain eg{OA, 1024}; run_gemm(smem, (const bf16_t*)(P.ws + WS_A + 32 * MiB), (const bf16_t*)(P.ws + WS_M + MiB / 2), MLAT, 1024, 256, eg); phase_readout(P, smem); } SEAM(5);
    PHASE(6) { phase_readout_rwkv(P); } SEAM(6);
    PHASE(7) { EpiGate<false> ea{MBUF, P2 + 1024}; run_gemm(smem, OA, WT_PA, MLAT, D, 1024, ea);
               EpiGate<true> eb{MBUF, P2 + 1024 + 2048}; run_gemm(smem, OB, WT_PB, MLAT, D, 1024, eb); } SEAM(7);
    PHASE(8) { EpiRes e{P.out, P.in[0], MOD + 2 * D}; run_gemm(smem, MBUF, WT_OUT, MLAT, D, D, e); } SEAM(8);
    PHASE(9) { phase_norm2(P); phase_ffn_weights(P, smem); } SEAM(9);
    PHASE(10) { EpiSwiglu e{A3}; run_gemm(smem, H2, WT_GU, MLAT, 2 * FFH, D, e); } SEAM(10);
    PHASE(11) { EpiRes e{P.out, P.out, MOD + 5 * D}; run_gemm(smem, A3, WT_DN, MLAT, D, FFH, e); } SEAM(11);
    PHASE(12) { phase_final_norm(P); }
}

#ifndef N_LAUNCH_PER_PHASE
#define N_LAUNCH_PER_PHASE 0
#endif
#ifndef PROBE_SEQ
#define PROBE_SEQ {0,1,2,3,4,5,6,7,8,9,10,11,12}
#endif
extern "C" void kernel_launch(void* const* d_in, const int* in_sizes, int n_in, void* d_out, int out_size, void* d_ws, size_t ws_size, hipStream_t stream) {
    static int grid = 0;
    if (grid == 0) {
        if (n_in != 30 || out_size != MLAT * D || ws_size < WS_END) { fprintf(stderr, "kernel_launch: unexpected shapes: n_in %d out %d ws %zu (need %zu)\n", n_in, out_size, ws_size, (size_t)WS_END); grid = -1; return; }
        int dev = 0, cus = 0, per_cu = 0;
        if (hipGetDevice(&dev) != hipSuccess || hipDeviceGetAttribute(&cus, hipDeviceAttributeMultiprocessorCount, dev) != hipSuccess) { grid = -1; return; }
        if (hipFuncSetAttribute((const void*)fwd_mega, hipFuncAttributeMaxDynamicSharedMemorySize, LDS_BYTES) != hipSuccess) { fprintf(stderr, "kernel_launch: hipFuncSetAttribute failed\n"); grid = -1; return; }
        if (hipOccupancyMaxActiveBlocksPerMultiprocessor(&per_cu, (const void*)fwd_mega, 512, LDS_BYTES) != hipSuccess || per_cu < 1) { fprintf(stderr, "kernel_launch: occupancy query gives %d\n", per_cu); grid = -1; return; }
        grid = cus * per_cu; if (grid > 256) grid = 256;
    }
    if (grid < 0) return;
    Params p{};
    for (int i = 0; i < 30; ++i) p.in[i] = (const float*)d_in[i];
    p.out = (float*)d_out; p.ws = (unsigned char*)d_ws;
#if N_LAUNCH_PER_PHASE
    { const int seq[] = PROBE_SEQ; for (int si = 0; si < (int)(sizeof(seq) / sizeof(int)); ++si) { const int ph = seq[si]; p.ph_lo = ph; p.ph_hi = ph + 1; p.coop = 0; hipLaunchKernelGGL(fwd_mega, dim3(grid), dim3(512), LDS_BYTES, stream, p); } }
#else
    p.ph_lo = 0; p.ph_hi = 13; p.coop = 1;
    void* args[] = {&p};
    hipError_t e = hipLaunchCooperativeKernel((const void*)fwd_mega, dim3(grid), dim3(512), args, LDS_BYTES, stream);
    if (e != hipSuccess) fprintf(stderr, "cooperative launch failed: %s (grid %d)\n", hipGetErrorString(e), grid);
#endif
}
```

```cpp
#include <hip/hip_runtime.h>
#include <hip/hip_cooperative_groups.h>
#include <cstdio>
#include <cstdint>
namespace cg = cooperative_groups;
namespace pg8 {
#define PG8_LAS __attribute__((address_space(3)))
typedef unsigned short bf16_t;
typedef short bf16x8 __attribute__((ext_vector_type(8)));
typedef float f32x4 __attribute__((ext_vector_type(4)));
typedef unsigned u32x4 __attribute__((ext_vector_type(4)));
constexpr int BM = 256, BK = 64, HALF = 128, HTB = HALF * BK * 2  , STAGE_BYTES = 8 * HTB, NXCD = 8, WGM = 4;

__host__ __device__ __forceinline__ int lds_byte(int r, int c) { const int st = (r >> 4) * 2 + (c >> 5), rr = r & 15, cc = c & 31, ob = rr * 64 + cc * 2; return st * 1024 + (ob ^ (((ob >> 9) & 1) << 5)); }
__host__ __device__ __forceinline__ void stage_rc(int b, int& R, int& C) { const int st = b / 1024, sb = b % 1024, swz = sb ^ (((sb >> 9) & 1) << 5); R = (st >> 1) * 16 + swz / 64; C = (st & 1) * 32 + (swz % 64) / 2; }
__host__ __device__ __forceinline__ int perm32(int rho) { const int n = rho >> 4, i = rho & 15; return 8 * (i >> 2) + 4 * n + (i & 3); }

struct Unit { int pm, pn; };
struct Gemm { const bf16_t* A; const bf16_t* Bt; int M, N, K; };

struct StaticOrder {
    int nM, nN, nwg, G, c;
    __host__ __device__ void init(int M, int N, int G_, int c_) { nM = M / BM; nN = N / BM; nwg = nM * nN; G = G_; c = c_; }
    __host__ __device__ bool next(int i, Unit& u) const {
        const long L = (long)i * G + c; if (L >= nwg) return false;
        int wgid = (int)L; { const int q = nwg / NXCD, r = nwg % NXCD, xcd = wgid % NXCD, off = wgid / NXCD; wgid = (xcd < r ? xcd * (q + 1) : r * (q + 1) + (xcd - r) * q) + off; }
        const int nig = WGM * nN, gid = wgid / nig, fm = gid * WGM, gsz = (nM - fm) < WGM ? (nM - fm) : WGM;
        u.pm = fm + ((wgid % nig) % gsz); u.pn = (wgid % nig) / gsz; return true;
    }
    __device__ __forceinline__ void a_ready(const Unit&) const {}
    __device__ __forceinline__ void done(const Unit&) const {}
};
__device__ __forceinline__ unsigned cvt_pk_bf16(float lo, float hi) { unsigned r; asm volatile("v_cvt_pk_bf16_f32 %0, %1, %2" : "=v"(r) : "v"(lo), "v"(hi)); return r; }
template <class Epi, class Sched, bool ALIGN_EPI = false, bool SP2 = false>
__device__ __forceinline__ void gemm_phase(PG8_LAS unsigned char* lds, const Gemm g, const Sched& S, const Epi& E) {
    const int tid = threadIdx.x, wid = __builtin_amdgcn_readfirstlane(tid >> 6), lane = tid & 63, wr = wid >> 2, wc = wid & 3, fr = lane & 15, fq = lane >> 4;
    const int K = g.K, nt = K / BK;
    unsigned voffA[2], voffB[2];
#pragma unroll
    for (int i = 0; i < 2; ++i) { int R, C; stage_rc(tid * 16 + i * 8192, R, C); const int Rb = Epi::PERM ? ((R & ~31) + perm32(R & 31)) : R;
        voffA[i] = (unsigned)(R * K + C) * 2u; voffB[i] = (unsigned)(Rb * K + C) * 2u; }
    const size_t kstep = (size_t)(BK * 2);
    const size_t hstep = (size_t)HALF * K * 2;
    const size_t tstep = 2 * hstep;
    const unsigned ldsw = (unsigned)wid * 1024u;
    const int aoff = lds_byte(wr * 64 + fr, fq * 8), boff = lds_byte(wc * 32 + fr, fq * 8);
#define PG8_SA(b, h) (((b) * 2 + (h)) * HTB)
#define PG8_SB(b, h) ((4 + (b) * 2 + (h)) * HTB)
#define PG8_STAGE(bufoff, gbase, voff) do { _Pragma("unroll") for (int _i = 0; _i < 2; ++_i) \
        __builtin_amdgcn_global_load_lds((const unsigned*)((const char*)(gbase) + (voff)[_i]), (PG8_LAS unsigned*)(lds + (bufoff) + ldsw + _i * 8192), 16, 0, 0); } while (0)
#define PG8_LDA(dst, b, h) do { _Pragma("unroll") for (int m = 0; m < 4; ++m) _Pragma("unroll") for (int k = 0; k < 2; ++k) dst[m][k] = *(const PG8_LAS bf16x8*)(lds + PG8_SA(b, h) + aoff + m * 2048 + k * 1024); } while (0)
#define PG8_LDB(dst, b, h) do { _Pragma("unroll") for (int n = 0; n < 2; ++n) _Pragma("unroll") for (int k = 0; k < 2; ++k) dst[n][k] = *(const PG8_LAS bf16x8*)(lds + PG8_SB(b, h) + boff + n * 2048 + k * 1024); } while (0)
#define PG8_MMA(ai, bj, At, Bt) do { __builtin_amdgcn_s_setprio(1); _Pragma("unroll") for (int m = 0; m < 4; ++m) _Pragma("unroll") for (int n = 0; n < 2; ++n) _Pragma("unroll") for (int k = 0; k < 2; ++k) \
        acc[ai][bj][m][n] = __builtin_amdgcn_mfma_f32_16x16x32_bf16(Bt[n][k], At[m][k], acc[ai][bj][m][n], 0, 0, 0); __builtin_amdgcn_s_setprio(0); } while (0)
#define PG8_WAIT_V(n) asm volatile("s_waitcnt vmcnt(" #n ")" ::: "memory")
#define PG8_WAIT_L(n) asm volatile("s_waitcnt lgkmcnt(" #n ")" ::: "memory")
#define PG8_BAR __builtin_amdgcn_s_barrier()
#define PG8_SCHED __builtin_amdgcn_sched_barrier(0)
    Unit cur, nxt; int ui = 0;
    if (!S.next(0, cur)) return;
    f32x4 acc[2][2][4][2];
#pragma unroll
    for (int a = 0; a < 2; ++a)
#pragma unroll
        for (int b = 0; b < 2; ++b)
#pragma unroll
            for (int m = 0; m < 4; ++m)
#pragma unroll
                for (int n = 0; n < 2; ++n) acc[a][b][m][n] = (f32x4){0.f, 0.f, 0.f, 0.f};
    bf16x8 At[4][2], B0[2][2], B1[2][2];
    const char* cA = (const char*)g.A + (size_t)cur.pm * tstep; const char* cB = (const char*)g.Bt + (size_t)cur.pn * tstep;
    S.a_ready(cur);
    if constexpr (SP2) {
        PG8_STAGE(PG8_SB(0, 0), cB, voffB); PG8_STAGE(PG8_SB(0, 1), cB + hstep, voffB); PG8_STAGE(PG8_SA(0, 0), cA, voffA); PG8_STAGE(PG8_SA(0, 1), cA + hstep, voffA);
        if (wr == 1) PG8_BAR;
        PG8_WAIT_V(2); PG8_BAR;
        PG8_STAGE(PG8_SB(1, 0), cB + kstep, voffB); PG8_STAGE(PG8_SA(1, 0), cA + kstep, voffA); PG8_STAGE(PG8_SB(1, 1), cB + hstep + kstep, voffB);
        PG8_WAIT_V(6); PG8_BAR;
    } else {
        PG8_STAGE(PG8_SB(0, 0), cB, voffB); PG8_STAGE(PG8_SA(0, 0), cA, voffA); PG8_STAGE(PG8_SB(0, 1), cB + hstep, voffB); PG8_STAGE(PG8_SA(0, 1), cA + hstep, voffA);
        if (wr == 1) PG8_BAR;
        PG8_WAIT_V(4); PG8_BAR;
        PG8_STAGE(PG8_SB(1, 0), cB + kstep, voffB); PG8_STAGE(PG8_SA(1, 0), cA + kstep, voffA); PG8_STAGE(PG8_SB(1, 1), cB + hstep + kstep, voffB);
        PG8_WAIT_V(6); PG8_BAR;
    }
    for (;;) {
        const bool has_next = S.next(ui + 1, nxt);
        const char* nA = has_next ? (const char*)g.A + (size_t)nxt.pm * tstep : cA; const char* nB = has_next ? (const char*)g.Bt + (size_t)nxt.pn * tstep : cB;
        for (int t = 0; t < nt; t += 2) {
            const bool last = (t == nt - 2);
            const char* a1 = cA + (size_t)(t + 1) * kstep;
            const char* a2 = last ? nA : cA + (size_t)(t + 2) * kstep; const char* b2 = last ? nB : cB + (size_t)(t + 2) * kstep;
            const char* a3 = a2 + kstep; const char* b3 = b2 + kstep;
            if (last && has_next) S.a_ready(nxt);
            if constexpr (SP2) {
            PG8_LDB(B0, 0, 0); PG8_LDB(B1, 0, 1); PG8_SCHED; PG8_LDA(At, 0, 0); PG8_STAGE(PG8_SA(1, 1), a1 + hstep, voffA);
            PG8_WAIT_V(8); PG8_WAIT_L(0); PG8_BAR; PG8_MMA(0, 0, At, B0); PG8_MMA(0, 1, At, B1); PG8_BAR; PG8_SCHED;
            PG8_LDA(At, 0, 1); PG8_STAGE(PG8_SB(0, 0), b2, voffB); PG8_STAGE(PG8_SB(0, 1), b2 + hstep, voffB); PG8_STAGE(PG8_SA(0, 0), a2, voffA);
            PG8_WAIT_V(8); PG8_WAIT_L(0); PG8_BAR; PG8_MMA(1, 0, At, B0); PG8_MMA(1, 1, At, B1); PG8_BAR; PG8_SCHED;
            PG8_LDB(B0, 1, 0); PG8_LDB(B1, 1, 1); PG8_SCHED; PG8_LDA(At, 1, 0); PG8_STAGE(PG8_SA(0, 1), a2 + hstep, voffA);
            PG8_WAIT_V(8); PG8_WAIT_L(0); PG8_BAR; PG8_MMA(0, 0, At, B0); PG8_MMA(0, 1, At, B1); PG8_BAR; PG8_SCHED;
            PG8_LDA(At, 1, 1); PG8_STAGE(PG8_SB(1, 0), b3, voffB); PG8_STAGE(PG8_SB(1, 1), b3 + hstep, voffB); PG8_STAGE(PG8_SA(1, 0), a3, voffA);
            PG8_WAIT_V(8); PG8_WAIT_L(0); PG8_BAR; PG8_MMA(1, 0, At, B0); PG8_MMA(1, 1, At, B1); PG8_BAR; PG8_SCHED;
            } else {
            PG8_LDB(B0, 0, 0); PG8_SCHED; PG8_LDA(At, 0, 0); PG8_STAGE(PG8_SA(1, 1), a1 + hstep, voffA);
            PG8_WAIT_L(8); PG8_BAR; PG8_WAIT_L(0); PG8_MMA(0, 0, At, B0); PG8_BAR; PG8_SCHED;
            PG8_LDB(B1, 0, 1); PG8_STAGE(PG8_SB(0, 0), b2, voffB);
            PG8_BAR; PG8_WAIT_L(0); PG8_MMA(0, 1, At, B1); PG8_BAR;
            PG8_LDA(At, 0, 1); PG8_STAGE(PG8_SA(0, 0), a2, voffA);
            PG8_BAR; PG8_WAIT_L(0); PG8_MMA(1, 0, At, B0); PG8_BAR; PG8_SCHED;
            PG8_STAGE(PG8_SB(0, 1), b2 + hstep, voffB);
            PG8_WAIT_V(6); PG8_BAR; PG8_MMA(1, 1, At, B1); PG8_BAR;
            PG8_LDB(B0, 1, 0); PG8_SCHED; PG8_LDA(At, 1, 0); PG8_STAGE(PG8_SA(0, 1), a2 + hstep, voffA);
            PG8_WAIT_L(8); PG8_BAR; PG8_WAIT_L(0); PG8_MMA(0, 0, At, B0); PG8_BAR; PG8_SCHED;
            PG8_LDB(B1, 1, 1); PG8_STAGE(PG8_SB(1, 0), b3, voffB);
            PG8_BAR; PG8_WAIT_L(0); PG8_MMA(0, 1, At, B1); PG8_BAR;
            PG8_LDA(At, 1, 1); PG8_STAGE(PG8_SA(1, 0), a3, voffA);
            PG8_BAR; PG8_WAIT_L(0); PG8_MMA(1, 0, At, B0); PG8_BAR; PG8_SCHED;
            PG8_STAGE(PG8_SB(1, 1), b3 + hstep, voffB);
            PG8_WAIT_V(6); PG8_BAR; PG8_MMA(1, 1, At, B1); PG8_BAR;
            }
        }
        if constexpr (ALIGN_EPI) { if (wr == 0) PG8_BAR; }
        if constexpr (!Epi::AFTER_DRAIN) { E(acc, cur, wr, wc, fr, fq); S.done(cur); }
        if (!has_next) break;
#pragma unroll
        for (int a = 0; a < 2; ++a)
#pragma unroll
            for (int b = 0; b < 2; ++b)
#pragma unroll
                for (int m = 0; m < 4; ++m)
#pragma unroll
                    for (int n = 0; n < 2; ++n) acc[a][b][m][n] = (f32x4){0.f, 0.f, 0.f, 0.f};
        cur = nxt; cA = nA; cB = nB; ++ui;
        if constexpr (ALIGN_EPI) { if (wr == 1) PG8_BAR; }
    }
    PG8_WAIT_V(0);
    if constexpr (!ALIGN_EPI) { if (wr == 0) PG8_BAR; }
    PG8_BAR;
    if constexpr (Epi::AFTER_DRAIN) { E.fused(acc, cur, wr, wc, fr, fq, lds, wid, lane); S.done(cur); }
#undef PG8_SA
#undef PG8_SB
#undef PG8_STAGE
#undef PG8_LDA
#undef PG8_LDB
#undef PG8_MMA
#undef PG8_WAIT_V
#undef PG8_WAIT_L
#undef PG8_BAR
#undef PG8_SCHED
}
}


using pg8::bf16_t; using pg8::f32x4; using pg8::u32x4; using pg8::Unit; using pg8::cvt_pk_bf16;
#define LAS __attribute__((address_space(3)))

constexpr int D = 2048, NB = 8, TL = 2048, TC = 256, MLAT = NB * TL  , MCTX = NB * TC  , MALL = MLAT + MCTX  ;
constexpr int N1 = 6656, N2 = 5120, LD1 = N1, LD2 = N2, FFH = 5632, NADA = 6 * D;
constexpr int COL_CV = 3520, COL_AB = 6592;
constexpr int LDS_BYTES = 147456;
constexpr size_t MiB = 1048576;
constexpr size_t WS_A = 0;
constexpr size_t WS_B = WS_A + 46 * MiB;
constexpr size_t WS_X = WS_B + 16 * MiB;
constexpr size_t WS_D = WS_X + 234 * MiB;
constexpr size_t WS_F = WS_D + 160 * MiB;
constexpr size_t WS_M = WS_F + 32 * MiB;
constexpr size_t WS_END = WS_M + 3 * MiB;

struct Params { const float* in[30]; float* out; unsigned char* ws; int ph_lo, ph_hi, coop, pad; };

__device__ __forceinline__ float bf2f(bf16_t b) { return __uint_as_float(((unsigned)b) << 16); }
typedef __bf16 bf16x2_t __attribute__((ext_vector_type(2)));
typedef float f32x2_t __attribute__((ext_vector_type(2)));
__device__ __forceinline__ unsigned pk2(float lo, float hi) { const f32x2_t v = {lo, hi}; return __builtin_bit_cast(unsigned, __builtin_convertvector(v, bf16x2_t)); }
__device__ __forceinline__ bf16_t f2bf(float f) { return (bf16_t)(pk2(f, 0.f) & 0xffffu); }
__device__ __forceinline__ float sigm(float x) { return __builtin_amdgcn_rcpf(1.f + __expf(-x)); }
__device__ __forceinline__ float tanh_fast(float x) { return 1.f - 2.f * __builtin_amdgcn_rcpf(1.f + __expf(2.f * x)); }
__device__ __forceinline__ float wave_sum(float v) {
#pragma unroll
    for (int o = 1; o < 64; o <<= 1) v += __shfl_xor(v, o);
    return v;
}
template <int CTRL> __device__ __forceinline__ float dppf(float x) { return __int_as_float(__builtin_amdgcn_update_dpp(0, __float_as_int(x), CTRL, 0xF, 0xF, true)); }
__device__ __forceinline__ float red8(float x) { x += dppf<0x141>(x); x += dppf<0xB1>(x); x += dppf<0x4E>(x); return x; }

struct EpiBf16Plain {
    static constexpr bool PERM = true, AFTER_DRAIN = false;
    bf16_t* O; int ldc;
    __device__ __forceinline__ void operator()(const f32x4 (&acc)[2][2][4][2], const Unit& u, int wr, int wc, int fr, int fq) const {
        const int row0 = u.pm * 256 + wr * 64 + fr, col0 = u.pn * 256 + wc * 32 + 8 * fq;
#pragma unroll
        for (int ai = 0; ai < 2; ++ai)
#pragma unroll
            for (int m = 0; m < 4; ++m) { bf16_t* rowp = O + (size_t)(row0 + ai * 128 + m * 16) * ldc + col0;
#pragma unroll
                for (int bj = 0; bj < 2; ++bj) { const f32x4 v0 = acc[ai][bj][m][0], v1 = acc[ai][bj][m][1];
                    u32x4 w; w.x = pk2(v0[0], v0[1]); w.y = pk2(v0[2], v0[3]); w.z = pk2(v1[0], v1[1]); w.w = pk2(v1[2], v1[3]);
                    *(u32x4*)(rowp + bj * 128) = w; } }
    }
};
template <bool SECOND> struct EpiGate {
    static constexpr bool PERM = true, AFTER_DRAIN = false;
    bf16_t* Mo; const bf16_t* G;
    __device__ __forceinline__ void operator()(const f32x4 (&acc)[2][2][4][2], const Unit& u, int wr, int wc, int fr, int fq) const {
        const int row0 = u.pm * 256 + wr * 64 + fr, col0 = u.pn * 256 + wc * 32 + 8 * fq;
#pragma unroll
        for (int ai = 0; ai < 2; ++ai)
#pragma unroll
            for (int m = 0; m < 4; ++m) { const size_t row = (size_t)(row0 + ai * 128 + m * 16);
#pragma unroll
                for (int bj = 0; bj < 2; ++bj) { const f32x4 v0 = acc[ai][bj][m][0], v1 = acc[ai][bj][m][1];
                    const int col = col0 + bj * 128;
                    const u32x4 g = *(const u32x4*)(G + row * LD2 + col);
                    float r[8];
                    r[0] = sigm(__uint_as_float(g.x << 16)) * v0[0]; r[1] = sigm(__uint_as_float(g.x & 0xffff0000u)) * v0[1];
                    r[2] = sigm(__uint_as_float(g.y << 16)) * v0[2]; r[3] = sigm(__uint_as_float(g.y & 0xffff0000u)) * v0[3];
                    r[4] = sigm(__uint_as_float(g.z << 16)) * v1[0]; r[5] = sigm(__uint_as_float(g.z & 0xffff0000u)) * v1[1];
                    r[6] = sigm(__uint_as_float(g.w << 16)) * v1[2]; r[7] = sigm(__uint_as_float(g.w & 0xffff0000u)) * v1[3];
                    u32x4* op = (u32x4*)(Mo + row * D + col);
                    if (SECOND) { const u32x4 o = *op;
                        r[0] += __uint_as_float(o.x << 16); r[1] += __uint_as_float(o.x & 0xffff0000u); r[2] += __uint_as_float(o.y << 16); r[3] += __uint_as_float(o.y & 0xffff0000u);
                        r[4] += __uint_as_float(o.z << 16); r[5] += __uint_as_float(o.z & 0xffff0000u); r[6] += __uint_as_float(o.w << 16); r[7] += __uint_as_float(o.w & 0xffff0000u); }
                    u32x4 w; w.x = pk2(r[0], r[1]); w.y = pk2(r[2], r[3]); w.z = pk2(r[4], r[5]); w.w = pk2(r[6], r[7]);
                    *op = w; } }
    }
};
struct EpiRes {
    static constexpr bool PERM = false, AFTER_DRAIN = false;
    float* out; const float* res; const float* gt;
    __device__ __forceinline__ void operator()(const f32x4 (&acc)[2][2][4][2], const Unit& u, int wr, int wc, int fr, int fq) const {
        const int row0 = u.pm * 256 + wr * 64 + fr, col0 = u.pn * 256 + wc * 32 + 4 * fq;
        const float* gtb = gt + (size_t)((u.pm * 256) >> 11) * NADA + col0;
        f32x4 gv[2][2];
#pragma unroll
        for (int bj = 0; bj < 2; ++bj)
#pragma unroll
            for (int n = 0; n < 2; ++n) gv[bj][n] = *(const f32x4*)(gtb + bj * 128 + n * 16);
#pragma unroll
        for (int ai = 0; ai < 2; ++ai)
#pragma unroll
            for (int m = 0; m < 4; ++m) { const size_t ro = (size_t)(row0 + ai * 128 + m * 16) * D + col0;
#pragma unroll
                for (int bj = 0; bj < 2; ++bj)
#pragma unroll
                    for (int n = 0; n < 2; ++n) { const f32x4 rv = *(const f32x4*)(res + ro + bj * 128 + n * 16);
                        *(f32x4*)(out + ro + bj * 128 + n * 16) = rv + gv[bj][n] * acc[ai][bj][m][n]; } }
    }
};
struct EpiSwiglu {
    static constexpr bool PERM = true, AFTER_DRAIN = false;
    bf16_t* O;
    __device__ __forceinline__ void operator()(const f32x4 (&acc)[2][2][4][2], const Unit& u, int wr, int wc, int fr, int fq) const {
        const int row0 = u.pm * 256 + wr * 64 + fr, col0 = u.pn * 128 + wc * 32 + 8 * fq;
#pragma unroll
        for (int ai = 0; ai < 2; ++ai)
#pragma unroll
            for (int m = 0; m < 4; ++m) { bf16_t* rowp = O + (size_t)(row0 + ai * 128 + m * 16) * FFH + col0;
                float r[8];
#pragma unroll
                for (int n = 0; n < 2; ++n)
#pragma unroll
                    for (int e = 0; e < 4; ++e) { const float g = acc[ai][0][m][n][e], up = acc[ai][1][m][n][e]; r[4 * n + e] = g * sigm(g) * up; }
                u32x4 w; w.x = pk2(r[0], r[1]); w.y = pk2(r[2], r[3]); w.z = pk2(r[4], r[5]); w.w = pk2(r[6], r[7]);
                *(u32x4*)rowp = w; }
    }
};

#ifndef GEMM_ALIGN_EPI
#define GEMM_ALIGN_EPI true
#endif
#ifndef GEMM_SP2
#define GEMM_SP2 true
#endif
template <class Epi> __device__ __forceinline__ void run_gemm(unsigned char* smem, const bf16_t* A, const bf16_t* Bt, int M, int N, int K, const Epi& E) {
    pg8::Gemm g; g.A = A; g.Bt = Bt; g.M = M; g.N = N; g.K = K;
    pg8::StaticOrder S; S.init(M, N, (int)gridDim.x, (int)blockIdx.x);
    pg8::gemm_phase<Epi, pg8::StaticOrder, GEMM_ALIGN_EPI, GEMM_SP2>((PG8_LAS unsigned char*)smem, g, S, E);
    __syncthreads();
}

__device__ __forceinline__ void transpose_item(const float* W, int K, int N, bf16_t* WT, int dst_row0, int src_col0, float* scr, int k0, int lane) {
    if (src_col0 >= 0) {
#pragma unroll 8
        for (int i = 0; i < 32; ++i) { const int kk = 2 * i + (lane >> 5); scr[kk * 33 + (lane & 31)] = W[(size_t)(k0 + kk) * N + src_col0 + (lane & 31)]; }
    } else {
#pragma unroll 8
        for (int i = 0; i < 32; ++i) { const int kk = 2 * i + (lane >> 5); scr[kk * 33 + (lane & 31)] = 0.f; }
    }
    asm volatile("s_waitcnt lgkmcnt(0)" ::: "memory");
    const int c = lane & 7;
#pragma unroll
    for (int j = 0; j < 4; ++j) { const int n = (lane >> 3) + 8 * j; const float* s = scr + (8 * c) * 33 + n;
        u32x4 o; o.x = pk2(s[0], s[33]); o.y = pk2(s[2 * 33], s[3 * 33]); o.z = pk2(s[4 * 33], s[5 * 33]); o.w = pk2(s[6 * 33], s[7 * 33]);
        *(u32x4*)(WT + (size_t)(dst_row0 + n) * K + k0 + 8 * c) = o; }
    asm volatile("s_waitcnt lgkmcnt(0)" ::: "memory");
}
__device__ __forceinline__ int win_src_col(int n0) {
    if (n0 < 6592) return n0;
    if (n0 < 6624) return 7616 + (n0 - 6592);
    if (n0 < 6656) return -1;
    const int j = n0 - 6656;
    return j < 1024 ? 6592 + j : 7648 + (j - 1024);
}

__device__ __forceinline__ void phase_prep(const Params& P, unsigned char* smem) {
    const int tid = threadIdx.x, lane = tid & 63, wave = tid >> 6;
    float* MOD = (float*)(P.ws + WS_M);
    if ((int)blockIdx.x < 192) {
        float* sT = (float*)smem;
        float* red = (float*)(smem + 98304);
        const float* c = P.in[1]; const float* cc = P.in[3];
        for (int idx = tid; idx < 9 * D; idx += 512) { const int m = idx >> 11, k = idx & 2047; const float v = m < 8 ? c[m * D + k] : cc[k]; sT[k * 12 + m] = v * sigm(v); }
        __syncthreads();
        const float* W = P.in[4]; const float* bias = P.in[5];
        for (int item = blockIdx.x; item < 192; item += gridDim.x) {
            const int n0 = item * 64, cl = tid & 15, kl = tid >> 4;
            float acc[9][4];
#pragma unroll
            for (int m = 0; m < 9; ++m)
#pragma unroll
                for (int e = 0; e < 4; ++e) acc[m][e] = 0.f;
#pragma unroll 4
            for (int kk = 0; kk < 64; ++kk) { const int k = kk * 32 + kl;
                const f32x4 w = *(const f32x4*)(W + (size_t)k * NADA + n0 + 4 * cl);
                const f32x4 s0 = *(const f32x4*)(sT + k * 12), s1 = *(const f32x4*)(sT + k * 12 + 4); const float s2 = sT[k * 12 + 8];
#pragma unroll
                for (int e = 0; e < 4; ++e) { acc[0][e] += s0[0] * w[e]; acc[1][e] += s0[1] * w[e]; acc[2][e] += s0[2] * w[e]; acc[3][e] += s0[3] * w[e];
                    acc[4][e] += s1[0] * w[e]; acc[5][e] += s1[1] * w[e]; acc[6][e] += s1[2] * w[e]; acc[7][e] += s1[3] * w[e]; acc[8][e] += s2 * w[e]; } }
#pragma unroll
            for (int m = 0; m < 9; ++m)
#pragma unroll
                for (int e = 0; e < 4; ++e) { float v = acc[m][e]; v += __shfl_xor(v, 16); v += __shfl_xor(v, 32); if ((lane >> 4) == 0) red[(wave * 9 + m) * 64 + 4 * cl + e] = v; }
            __syncthreads();
            for (int o = tid; o < 576; o += 512) { const int m = o >> 6, c2 = o & 63; float s = bias[n0 + c2];
#pragma unroll
                for (int w8 = 0; w8 < 8; ++w8) s += red[(w8 * 9 + m) * 64 + c2];
                MOD[m * NADA + n0 + c2] = s; }
            __syncthreads();
        }
    }
    __syncthreads();
    { bf16_t* G2T = (bf16_t*)(P.ws + WS_M + MiB / 2); const float* g2 = P.in[13];
      for (int s = blockIdx.x * 512 + tid; s < 1024 * 32; s += gridDim.x * 512) { const int n = s >> 5, k8 = s & 31; u32x4 w = {0u, 0u, 0u, 0u};
          if (k8 < 8) { const float* gp = g2 + (size_t)(8 * k8) * 1024 + n; w.x = pk2(gp[0], gp[1024]); w.y = pk2(gp[2048], gp[3072]); w.z = pk2(gp[4096], gp[5120]); w.w = pk2(gp[6144], gp[7168]); }
          *(u32x4*)(G2T + (size_t)n * 256 + 8 * k8) = w; } }
    float* scr = (float*)(smem + wave * 8448);
    const int gw = blockIdx.x * 8 + wave, NGW = gridDim.x * 8;
    bf16_t* WT_IN = (bf16_t*)(P.ws + WS_A); bf16_t* WT_PA = (bf16_t*)(P.ws + WS_B); bf16_t* WT_PB = WT_PA + 2048 * 1024; bf16_t* WT_OUT = WT_PB + 2048 * 1024;
    constexpr int I_IN = 368 * 32, I_PA = 64 * 16, I_OUT = 64 * 32;
    for (int it = gw; it < I_IN + 2 * I_PA + I_OUT; it += NGW) {
        int r = it;
        if (r < I_IN) { const int nb = r % 368, kb = r / 368; transpose_item(P.in[7], 2048, 11744, WT_IN, nb * 32, win_src_col(nb * 32), scr, kb * 64, lane); continue; } r -= I_IN;
        if (r < I_PA) { const int nb = r % 64, kb = r / 64; transpose_item(P.in[23], 1024, 2048, WT_PA, nb * 32, nb * 32, scr, kb * 64, lane); continue; } r -= I_PA;
        if (r < I_PA) { const int nb = r % 64, kb = r / 64; transpose_item(P.in[24], 1024, 2048, WT_PB, nb * 32, nb * 32, scr, kb * 64, lane); continue; } r -= I_PA;
        { const int nb = r % 64, kb = r / 64; transpose_item(P.in[25], 2048, 2048, WT_OUT, nb * 32, nb * 32, scr, kb * 64, lane); }
    }
}
__device__ __forceinline__ void phase_ffn_weights(const Params& P, unsigned char* smem) {
    const int tid = threadIdx.x, lane = tid & 63, wave = tid >> 6;
    float* scr = (float*)(smem + wave * 8448);
    const int gw = blockIdx.x * 8 + wave, NGW = gridDim.x * 8;
    bf16_t* WT_GU = (bf16_t*)(P.ws + WS_A); bf16_t* WT_DN = (bf16_t*)(P.ws + WS_F);
    constexpr int I_GU = 352 * 32, I_DN = 64 * 88;
    for (int it = gw; it < I_GU + I_DN; it += NGW) {
        int r = it;
        if (r < I_GU) { const int nb = r % 352, kb = r / 352; const int n0 = nb * 32, pn = n0 >> 8, cq = n0 & 255; const int src = cq < 128 ? 128 * pn + cq : FFH + 128 * pn + (cq - 128);
            transpose_item(P.in[27], 2048, 2 * FFH, WT_GU, n0, src, scr, kb * 64, lane); continue; } r -= I_GU;
        { const int nb = r % 64, kb = r / 64; transpose_item(P.in[28], FFH, 2048, WT_DN, nb * 32, nb * 32, scr, kb * 64, lane); }
    }
}

__device__ __forceinline__ void norm_mod_row(const float* src, const float* nw, const float* sh, const float* sc, bf16_t* dst, int lane) {
    f32x4 v[8]; float ss = 0.f;
#pragma unroll
    for (int j = 0; j < 8; ++j) { v[j] = *(const f32x4*)(src + (j * 64 + lane) * 4); ss += v[j][0] * v[j][0] + v[j][1] * v[j][1] + v[j][2] * v[j][2] + v[j][3] * v[j][3]; }
    const float rstd = rsqrtf(wave_sum(ss) * (1.f / D) + 1e-6f);
#pragma unroll
    for (int j = 0; j < 8; ++j) { const int c = (j * 64 + lane) * 4; const f32x4 w = *(const f32x4*)(nw + c), a = *(const f32x4*)(sh + c), b = *(const f32x4*)(sc + c);
        float o[4];
#pragma unroll
        for (int e = 0; e < 4; ++e) o[e] = (v[j][e] * rstd * w[e]) * (1.f + b[e]) + a[e];
        uint2 pk; pk.x = pk2(o[0], o[1]); pk.y = pk2(o[2], o[3]); *(uint2*)(dst + c) = pk; }
}
__device__ __forceinline__ void phase_norm1(const Params& P) {
    const int lane = threadIdx.x & 63, gw = blockIdx.x * 8 + (threadIdx.x >> 6), NGW = gridDim.x * 8;
    const float* MOD = (const float*)(P.ws + WS_M); bf16_t* H = (bf16_t*)P.out;
    for (int row = gw; row < MALL; row += NGW) {
        const float* src = row < MLAT ? P.in[0] + (size_t)row * D : P.in[2] + (size_t)(row - MLAT) * D;
        const int mr = row < MLAT ? (row >> 11) : 8;
        norm_mod_row(src, P.in[6], MOD + mr * NADA, MOD + mr * NADA + D, H + (size_t)row * D, lane);
    }
}
__device__ __forceinline__ void phase_norm2(const Params& P) {
    const int lane = threadIdx.x & 63, gw = blockIdx.x * 8 + (threadIdx.x >> 6), NGW = gridDim.x * 8;
    const float* MOD = (const float*)(P.ws + WS_M); bf16_t* H2 = (bf16_t*)(P.ws + WS_D);
    for (int row = gw; row < MLAT; row += NGW) { const int mr = row >> 11;
        norm_mod_row(P.out + (size_t)row * D, P.in[26], MOD + mr * NADA + 3 * D, MOD + mr * NADA + 4 * D, H2 + (size_t)row * D, lane); }
}
__device__ __forceinline__ void phase_final_norm(const Params& P) {
    const int lane = threadIdx.x & 63, gw = blockIdx.x * 8 + (threadIdx.x >> 6), NGW = gridDim.x * 8;
    const float* nw = P.in[29];
    for (int row = gw; row < MLAT; row += NGW) { float* src = P.out + (size_t)row * D;
        f32x4 v[8]; float ss = 0.f;
#pragma unroll
        for (int j = 0; j < 8; ++j) { v[j] = *(const f32x4*)(src + (j * 64 + lane) * 4); ss += v[j][0] * v[j][0] + v[j][1] * v[j][1] + v[j][2] * v[j][2] + v[j][3] * v[j][3]; }
        const float rstd = rsqrtf(wave_sum(ss) * (1.f / D) + 1e-6f);
#pragma unroll
        for (int j = 0; j < 8; ++j) { const int c = (j * 64 + lane) * 4; const f32x4 w = *(const f32x4*)(nw + c); *(f32x4*)(src + c) = v[j] * rstd * w; }
    }
}

__device__ __forceinline__ float mixed_load(const bf16_t* P1, int row, int t, bool isctx, int col, const float* mu) {
    const float p = bf2f(P1[(size_t)row * LD1 + col]);
    int nrow; bool valid;
    if (isctx) { if (col & 1) { valid = t < TC - 1; nrow = row + 1; } else { valid = t > 0; nrow = row - 1; } }
    else { const int m = col & 3, x = t & 63, y = t >> 6;
        if (m == 0) { valid = x > 0; nrow = row - 1; } else if (m == 1) { valid = x < 63; nrow = row + 1; }
        else if (m == 2) { valid = y > 0; nrow = row - 64; } else { valid = y < 31; nrow = row + 64; } }
    const float ps = valid ? bf2f(P1[(size_t)nrow * LD1 + col]) : 0.f;
    return p + (ps - p) * mu[col];
}


__device__ __forceinline__ void tri_inv_part1(const float* LM, bf16_t* TM, bf16_t* T11T, int blk, int lane) {
    constexpr int LDLc = 36, LDCc = 40;
    { const int c = lane & 15, o = 16 * blk; float t[16];
        const float* Lb = LM + o * LDLc + o;
#pragma unroll
        for (int i = 0; i < 16; ++i) { float a4[4] = {(i == c) ? 1.f : 0.f, 0.f, 0.f, 0.f};
#pragma unroll
            for (int j4 = 0; j4 < (i + 3) / 4; ++j4) { const f32x4 l = *(const f32x4*)(Lb + i * LDLc + 4 * j4);
#pragma unroll
                for (int x = 0; x < 4; ++x) if (4 * j4 + x < i) a4[x] -= l[x] * t[4 * j4 + x]; }
            t[i] = (a4[0] + a4[1]) + (a4[2] + a4[3]); }
        if (lane < 16) {
#pragma unroll
            for (int i = 0; i < 16; ++i) TM[(o + i) * LDCc + o + c] = f2bf(t[i]);
            if (blk == 0) { u32x4 w0, w1;
#pragma unroll
                for (int e = 0; e < 4; ++e) { w0[e] = pk2(t[2 * e], t[2 * e + 1]); w1[e] = pk2(t[8 + 2 * e], t[8 + 2 * e + 1]); }
                *(u32x4*)(T11T + c * 16) = w0; *(u32x4*)(T11T + c * 16 + 8) = w1; } }
        else if (lane < 32 && blk == 0) { const u32x4 zz = {0u, 0u, 0u, 0u}; *(u32x4*)(TM + c * LDCc + 16) = zz; *(u32x4*)(TM + c * LDCc + 24) = zz; } }
}
__device__ __forceinline__ void tri_inv_part2(const float* LM, bf16_t* TM, const bf16_t* T11T, bf16_t* XT, int lane) {
    constexpr int LDLc = 36, LDCc = 40;
    typedef short s16x8_ __attribute__((ext_vector_type(8)));
    const int fr = lane & 15, fq = lane >> 4;
    s16x8_ a = {0, 0, 0, 0, 0, 0, 0, 0}, b = {0, 0, 0, 0, 0, 0, 0, 0};
    if (fq < 2) { const f32x4 l0 = *(const f32x4*)(LM + (16 + fr) * LDLc + 8 * fq), l1 = *(const f32x4*)(LM + (16 + fr) * LDLc + 8 * fq + 4);
        u32x4 w; w.x = pk2(l0[0], l0[1]); w.y = pk2(l0[2], l0[3]); w.z = pk2(l1[0], l1[1]); w.w = pk2(l1[2], l1[3]);
        a = __builtin_bit_cast(s16x8_, w); b = *(const s16x8_*)(T11T + fr * 16 + 8 * fq); }
    const f32x4 X = __builtin_amdgcn_mfma_f32_16x16x32_bf16(a, b, ((f32x4){0.f, 0.f, 0.f, 0.f}), 0, 0, 0);
    { uint2 o; o.x = pk2(X[0], X[1]); o.y = pk2(X[2], X[3]); *(uint2*)(XT + fr * 16 + fq * 4) = o; }
    asm volatile("s_waitcnt lgkmcnt(0)" ::: "memory");
    s16x8_ a2 = {0, 0, 0, 0, 0, 0, 0, 0}, b2 = {0, 0, 0, 0, 0, 0, 0, 0};
    if (fq < 2) { a2 = *(const s16x8_*)(XT + fr * 16 + 8 * fq); b2 = *(const s16x8_*)(TM + (16 + fr) * LDCc + 16 + 8 * fq); }
    const f32x4 O = __builtin_amdgcn_mfma_f32_16x16x32_bf16(a2, b2, ((f32x4){0.f, 0.f, 0.f, 0.f}), 0, 0, 0);
    { uint2 o; o.x = pk2(-O[0], -O[1]); o.y = pk2(-O[2], -O[3]); *(uint2*)(TM + (16 + fr) * LDCc + fq * 4) = o; }
}
constexpr int CH = 32, NCHUNK = (TC + TL) / CH;
typedef short s16x8 __attribute__((ext_vector_type(8)));
__device__ __forceinline__ float red16(float x) { x += dppf<0x140>(x); x += dppf<0x141>(x); x += dppf<0xB1>(x); x += dppf<0x4E>(x); return x; }
#define TROW(r) ((r) * LDC + ((r) >> 3) * 8)
#define MFMA16(a, b, c) __builtin_amdgcn_mfma_f32_16x16x32_bf16((a), (b), (c), 0, 0, 0)

typedef short s16x4_t __attribute__((ext_vector_type(4)));
__device__ __forceinline__ __attribute__((ext_vector_type(8))) short tr_frag(const bf16_t* img, int rs, int c, int lane) {
    const int g = lane >> 4, q = (lane & 15) >> 2, p = lane & 3;
    const bf16_t* base = img + (8 * g + q) * rs + 16 * c + 4 * p;
    const s16x4_t lo = __builtin_amdgcn_ds_read_tr16_b64_v4i16((LAS s16x4_t*)base), hi = __builtin_amdgcn_ds_read_tr16_b64_v4i16((LAS s16x4_t*)(base + 4 * rs));
    return (__attribute__((ext_vector_type(8))) short){lo[0], lo[1], lo[2], lo[3], hi[0], hi[1], hi[2], hi[3]};
}
constexpr int L_WR = 0, L_KD = 8192, L_V = 16384, L_W = 24576, L_BB = 32768, L_KK = 40960, L_THW = 49152  , L_THA = 55296, L_SC = 61440  , L_PRM = 61952  ;
__device__ __forceinline__ void phase_rwkv(const Params& P, unsigned char* smem) {
    const int tid = threadIdx.x;
    const bf16_t* P1 = (const bf16_t*)(P.ws + WS_X);
    bf16_t* YD = (bf16_t*)P.out;
    float* SBON = (float*)(P.ws + WS_M + MiB);
    float* A_wr = (float*)(smem + L_WR); float* A_kd = (float*)(smem + L_KD); float* A_v = (float*)(smem + L_V); float* A_w = (float*)(smem + L_W);
    float* A_bb = (float*)(smem + L_BB); float* A_kk = (float*)(smem + L_KK); bf16_t* TH_w = (bf16_t*)(smem + L_THW); bf16_t* TH_a = (bf16_t*)(smem + L_THA); float* SC = (float*)(smem + L_SC);
    float* PRM = (float*)(smem + L_PRM);
    const float* mu = P.in[8];
    for (int it = blockIdx.x; it < 256; it += gridDim.x) {
        const int b = it >> 5, h = (it >> 1) & 15, d = it & 1;
        float S[8];
#pragma unroll
        for (int j = 0; j < 8; ++j) S[j] = 0.f;
        s16x8 Bw[3], Ba[3];
        __syncthreads();
        { const int lane = tid & 63, wave = tid >> 6; const int cB = h * 64 + 16 * (wave & 3) + (lane & 15);
#pragma unroll
          for (int ks = 0; ks < 3; ++ks)
#pragma unroll
            for (int j = 0; j < 8; ++j) { const int k = ks * 32 + (lane >> 4) * 8 + j;
                Bw[ks][j] = (short)f2bf(P.in[10][((size_t)d * 96 + k) * 1024 + cB]); Ba[ks][j] = (short)f2bf(P.in[12][((size_t)d * 96 + k) * 1024 + cB]); }
          if (tid < 64) { PRM[tid] = P.in[14][h * 64 + tid]; PRM[64 + tid] = P.in[15][h * 64 + tid]; PRM[128 + tid] = P.in[16][h * 64 + tid]; } }
        const float w0c = P.in[9][d * 1024 + h * 64 + 16 * ((tid >> 6) & 3) + (tid & 15)], a0c = P.in[11][d * 1024 + h * 64 + 16 * ((tid >> 6) & 3) + (tid & 15)];
        unsigned pre[3][12];
        auto prefetch = [&](int ch) {
            const bool isctx = ch < 8;
            const int sbase = isctx ? ch * CH : (ch - 8) * CH, Tlen = isctx ? TC : TL;
            const int rowbase = isctx ? MLAT + b * TC : b * TL;
            const int t0 = d == 0 ? sbase : Tlen - 1 - sbase, sgn = d == 0 ? 1 : -1;
            const u32x4 zz = {0u, 0u, 0u, 0u};
            int qv = tid; asm volatile("" : "+v"(qv));
#pragma unroll
            for (int n = 0; n < 3; ++n) { const int s = qv + 512 * n, i = s / 48, cv = s % 48; const int t = t0 + sgn * i;
                const int col = cv < 8 ? h * 64 + 8 * cv : (cv < 16 ? 1024 + h * 64 + 8 * (cv - 8) : (cv < 24 ? 2048 + h * 64 + 8 * (cv - 16) : (cv < 36 ? 3072 + d * 96 + 8 * (cv - 24) : 3264 + d * 96 + 8 * (cv - 36))));
                const bf16_t* pp = P1 + (size_t)(rowbase + t) * LD1 + col;
                { const u32x4 pv_ = *(const u32x4*)pp; pre[n][0] = pv_.x; pre[n][1] = pv_.y; pre[n][2] = pv_.z; pre[n][3] = pv_.w; }
                const unsigned* pw = (const unsigned*)pp; constexpr int LW = LD1 / 2;
                if (isctx) { const bool vl = t > 0, vr = t < TC - 1;
                    const u32x4 L = vl ? *(const u32x4*)(pp - LD1) : zz, R = vr ? *(const u32x4*)(pp + LD1) : zz;
                    pre[n][4] = L.x; pre[n][5] = L.y; pre[n][6] = L.z; pre[n][7] = L.w; pre[n][8] = R.x; pre[n][9] = R.y; pre[n][10] = R.z; pre[n][11] = R.w; }
                else { const int x = t & 63, y = t >> 6; const bool vl = x > 0, vr = x < 63, vu = y > 0, vd = y < 31;
                    pre[n][4] = vl ? pw[-LW + 0] : 0u; pre[n][5] = vl ? pw[-LW + 2] : 0u; pre[n][6] = vr ? pw[LW + 0] : 0u; pre[n][7] = vr ? pw[LW + 2] : 0u;
                    pre[n][8] = vu ? pw[-64 * LW + 1] : 0u; pre[n][9] = vu ? pw[-64 * LW + 3] : 0u; pre[n][10] = vd ? pw[64 * LW + 1] : 0u; pre[n][11] = vd ? pw[64 * LW + 3] : 0u; } }
        };
        prefetch(0);
        for (int ch = 0; ch < NCHUNK; ++ch) {
            int qo = tid; asm volatile("" : "+v"(qo));
            const int lane_o = qo & 63, wave_o = qo >> 6;
            const bool isctx = ch < 8;
            const int sbase = isctx ? ch * CH : (ch - 8) * CH, Tlen = isctx ? TC : TL;
            const int rowbase = isctx ? MLAT + b * TC : b * TL;
            const int t0 = d == 0 ? sbase : Tlen - 1 - sbase, sgn = d == 0 ? 1 : -1;
#pragma unroll
            for (int n = 0; n < 3; ++n) { const int s = qo + 512 * n, i = s / 48, cv = s % 48;
                const int col = cv < 8 ? h * 64 + 8 * cv : (cv < 16 ? 1024 + h * 64 + 8 * (cv - 8) : (cv < 24 ? 2048 + h * 64 + 8 * (cv - 16) : (cv < 36 ? 3072 + d * 96 + 8 * (cv - 24) : 3264 + d * 96 + 8 * (cv - 36))));
                const f32x4 m0 = *(const f32x4*)(mu + col), m1 = *(const f32x4*)(mu + col + 4);
                float xs[8];
#pragma unroll
                for (int e = 0; e < 8; ++e) { const float p = __uint_as_float((e & 1) ? (pre[n][e >> 1] & 0xffff0000u) : (pre[n][e >> 1] << 16));
                    unsigned wv_; const bool hi = (e & 1);
                    if (isctx) wv_ = (e & 1) ? pre[n][8 + (e >> 1)] : pre[n][4 + (e >> 1)];
                    else wv_ = pre[n][4 + 2 * (e & 3) + (e >> 2)];
                    const float ps = __uint_as_float(hi ? (wv_ & 0xffff0000u) : (wv_ << 16));
                    xs[e] = p + (ps - p) * (e < 4 ? m0[e & 3] : m1[e & 3]); }
                if (cv < 24) { float* dst = (cv < 8 ? A_wr + i * 64 + 8 * cv : (cv < 16 ? A_kd + i * 64 + 8 * (cv - 8) : A_v + i * 64 + 8 * (cv - 16)));
                    *(f32x4*)dst = (f32x4){xs[0], xs[1], xs[2], xs[3]}; *(f32x4*)(dst + 4) = (f32x4){xs[4], xs[5], xs[6], xs[7]}; }
                else if (cv < 36) { u32x4 w; w.x = pk2(tanhf(xs[0]), tanhf(xs[1])); w.y = pk2(tanhf(xs[2]), tanhf(xs[3])); w.z = pk2(tanhf(xs[4]), tanhf(xs[5])); w.w = pk2(tanhf(xs[6]), tanhf(xs[7]));
                    *(u32x4*)(TH_w + i * 96 + 8 * (cv - 24)) = w; }
                else { u32x4 w; w.x = pk2(xs[0], xs[1]); w.y = pk2(xs[2], xs[3]); w.z = pk2(xs[4], xs[5]); w.w = pk2(xs[6], xs[7]);
                    *(u32x4*)(TH_a + i * 96 + 8 * (cv - 36)) = w; } }
            __syncthreads();
            { const int rt = wave_o >> 2, c = 16 * (wave_o & 3) + (lane_o & 15);
              f32x4 cw = {0.f, 0.f, 0.f, 0.f}, ca = {0.f, 0.f, 0.f, 0.f};
#pragma unroll
              for (int ks = 0; ks < 3; ++ks) { const int off = (rt * 16 + (lane_o & 15)) * 96 + ks * 32 + (lane_o >> 4) * 8;
                  const s16x8 fa = *(const s16x8*)(TH_w + off), fb = *(const s16x8*)(TH_a + off);
                  cw = MFMA16(fa, Bw[ks], cw); ca = MFMA16(fb, Ba[ks], ca); }
#pragma unroll
              for (int j = 0; j < 4; ++j) { const int i = rt * 16 + (lane_o >> 4) * 4 + j;
                  A_w[i * 64 + c] = __expf(-0.6065306597126334f * sigm(w0c + cw[j])); A_bb[i * 64 + c] = sigm(a0c + ca[j]); } }
            __syncthreads();
            if (qo < 256) {
                const int i = qo >> 3, cgp = qo & 7, j0 = 8 * cgp; float xr[8], xk[8], w[8], ic[8], kkw[8], kaw[8], rkw[8];
#pragma unroll
                for (int e = 0; e < 2; ++e) { const f32x4 a = *(const f32x4*)(A_wr + i * 64 + j0 + 4 * e), b2 = *(const f32x4*)(A_kd + i * 64 + j0 + 4 * e), c2 = *(const f32x4*)(A_w + i * 64 + j0 + 4 * e),
                        d2 = *(const f32x4*)(A_bb + i * 64 + j0 + 4 * e), e2 = *(const f32x4*)(PRM + j0 + 4 * e), f2 = *(const f32x4*)(PRM + 64 + j0 + 4 * e), g2 = *(const f32x4*)(PRM + 128 + j0 + 4 * e);
#pragma unroll
                    for (int x = 0; x < 4; ++x) { xr[4 * e + x] = a[x]; xk[4 * e + x] = b2[x]; w[4 * e + x] = c2[x]; ic[4 * e + x] = d2[x]; kkw[4 * e + x] = e2[x]; kaw[4 * e + x] = f2[x]; rkw[4 * e + x] = g2[x]; } }
                float ss = 0.f;
#pragma unroll
                for (int e = 0; e < 8; ++e) { const float kr_ = xk[e] * kkw[e]; ss += kr_ * kr_; }
                ss = red8(ss); const float rn = rsqrtf(ss + 1e-6f);
                float kk[8], kd[8], bb[8], br = 0.f, kr = 0.f, sb = 0.f;
#pragma unroll
                for (int e = 0; e < 8; ++e) { kk[e] = xk[e] * kkw[e] * rn; kd[e] = xk[e] * (1.f + (ic[e] - 1.f) * kaw[e]); bb[e] = kk[e] * ic[e];
                    br += bb[e] * xr[e]; kr += kd[e] * xr[e]; sb += xr[e] * kd[e] * rkw[e]; }
                br = red8(br); kr = red8(kr); sb = 0.5f * red8(sb);
#pragma unroll
                for (int e = 0; e < 2; ++e) {
                    *(f32x4*)(A_kk + i * 64 + j0 + 4 * e) = (f32x4){kk[4 * e], kk[4 * e + 1], kk[4 * e + 2], kk[4 * e + 3]};
                    *(f32x4*)(A_wr + i * 64 + j0 + 4 * e) = (f32x4){w[4 * e] * xr[4 * e], w[4 * e + 1] * xr[4 * e + 1], w[4 * e + 2] * xr[4 * e + 2], w[4 * e + 3] * xr[4 * e + 3]};
                    *(f32x4*)(A_kd + i * 64 + j0 + 4 * e) = (f32x4){kd[4 * e], kd[4 * e + 1], kd[4 * e + 2], kd[4 * e + 3]};
                    *(f32x4*)(A_bb + i * 64 + j0 + 4 * e) = (f32x4){bb[4 * e], bb[4 * e + 1], bb[4 * e + 2], bb[4 * e + 3]}; }
                if (cgp == 0) { SC[i * 4 + 0] = br; SC[i * 4 + 1] = kr; if (!isctx) SBON[((size_t)d * MLAT + rowbase + t0 + sgn * i) * 16 + h] = sb; }
            }
            __syncthreads();
            if (ch + 1 < NCHUNK) prefetch(ch + 1);
            { const int cgp = qo & 7, row = qo >> 3, j0 = 8 * cgp;
              bf16_t* yp = YD + ((size_t)d * MLAT + rowbase + t0) * 1024 + h * 64 + row;
              for (int i = 0; i < CH; ++i) {
                  float kk8[8], wr8[8], w8[8], bb8[8], kd8[8];
#pragma unroll
                  for (int e = 0; e < 2; ++e) { const f32x4 a = *(const f32x4*)(A_kk + i * 64 + j0 + 4 * e), b2 = *(const f32x4*)(A_wr + i * 64 + j0 + 4 * e), c2 = *(const f32x4*)(A_w + i * 64 + j0 + 4 * e),
                          d2 = *(const f32x4*)(A_bb + i * 64 + j0 + 4 * e), e2 = *(const f32x4*)(A_kd + i * 64 + j0 + 4 * e);
#pragma unroll
                      for (int x = 0; x < 4; ++x) { kk8[4 * e + x] = a[x]; wr8[4 * e + x] = b2[x]; w8[4 * e + x] = c2[x]; bb8[4 * e + x] = d2[x]; kd8[4 * e + x] = e2[x]; } }
                  const float v = A_v[i * 64 + row]; const float2 sc = *(const float2*)(SC + i * 4);
                  float sa = 0.f, pp = 0.f;
#pragma unroll
                  for (int j = 0; j < 8; ++j) { sa += S[j] * kk8[j]; pp += S[j] * wr8[j]; }
                  sa = red8(sa); pp = red8(pp);
                  const float y = pp - sa * sc.x + v * sc.y;
#pragma unroll
                  for (int j = 0; j < 8; ++j) S[j] = S[j] * w8[j] - sa * bb8[j] + v * kd8[j];
                  if (!isctx && cgp == 0) yp[(ptrdiff_t)sgn * i * 1024] = f2bf(y);
              } }
            __syncthreads();
        }
    }
}

constexpr int LDK = 136, LDC = 40, LDL = 36;
constexpr int G_RAW = 0, G_CW = 23040, G_SC = 29440, G_UQ = 29952, G_WK = 29952, G_VNT = 38656, G_UK = 46336, G_TM = 46336, G_QKM = 48896, G_LM = 51456, G_UV = 62720,
              G_KA = 70912, G_QA = 79616, G_QD = 88320, G_KGT = 97024, G_KTT = 107520, G_VT = 118016, G_ST = 123264, G_GC = 140672, G_T11T = 140928, G_XT = 141440;
__device__ __forceinline__ void phase_gdn(const Params& P, unsigned char* smem) {
    const int tid = threadIdx.x;
    const bf16_t* P1 = (const bf16_t*)(P.ws + WS_X);
    bf16_t* OD = (bf16_t*)P.out + (size_t)2 * MLAT * 1024;
    bf16_t* RAW = (bf16_t*)(smem + G_RAW); float* CW = (float*)(smem + G_CW); float* GSC = (float*)(smem + G_SC); float* UQ = (float*)(smem + G_UQ); float* UK = (float*)(smem + G_UK); float* UV = (float*)(smem + G_UV);
    bf16_t* WK = (bf16_t*)(smem + G_WK); bf16_t* VNT = (bf16_t*)(smem + G_VNT); bf16_t* TM = (bf16_t*)(smem + G_TM); bf16_t* QKM = (bf16_t*)(smem + G_QKM); float* LM = (float*)(smem + G_LM);
    bf16_t* KA = (bf16_t*)(smem + G_KA); bf16_t* QA = (bf16_t*)(smem + G_QA); bf16_t* QD = (bf16_t*)(smem + G_QD); bf16_t* KGT = (bf16_t*)(smem + G_KGT); bf16_t* KTT = (bf16_t*)(smem + G_KTT);
    bf16_t* VT = (bf16_t*)(smem + G_VT); bf16_t* ST = (bf16_t*)(smem + G_ST); float* GC = (float*)(smem + G_GC);
    for (int it = blockIdx.x; it < 256; it += gridDim.x) {
        const int b = it >> 5, hg = (it >> 2) & 7, d = (it >> 1) & 1, half = it & 1;
        f32x4 sacc[4];
#pragma unroll
        for (int nt = 0; nt < 4; ++nt) sacc[nt] = (f32x4){0.f, 0.f, 0.f, 0.f};
        __syncthreads();
        float cwr[5][8];
        { const int cv = tid % 40; const int ccol = cv < 16 ? hg * 128 + 8 * cv : (cv < 32 ? 1024 + hg * 128 + 8 * (cv - 16) : 2048 + hg * 128 + half * 64 + 8 * (cv - 32));
#pragma unroll
          for (int j = 0; j < 5; ++j) { const f32x4 c0 = *(const f32x4*)(P.in[19] + j * 3072 + ccol), c1 = *(const f32x4*)(P.in[19] + j * 3072 + ccol + 4);
#pragma unroll
              for (int x = 0; x < 4; ++x) { cwr[j][x] = c0[x]; cwr[j][4 + x] = c1[x]; } } }
        for (int e = tid; e < 64 * LDK / 2; e += 512) ((unsigned*)ST)[e] = 0u;
        const float alog = -__expf(P.in[20][d * 8 + hg]), dtb = P.in[21][d * 8 + hg];
        unsigned pre[3][4]; unsigned pab = 0;
        auto prefetch = [&](int ch) {
            const bool isctx = ch < 8;
            const int sbase = isctx ? ch * CH : (ch - 8) * CH, Tlen = isctx ? TC : TL;
            const int rowbase = isctx ? MLAT + b * TC : b * TL;
            const int t0 = d == 0 ? sbase : Tlen - 1 - sbase, sgn = d == 0 ? 1 : -1;
            const int lo = d == 0 ? sbase : Tlen - sbase - CH;
            const u32x4 zz = {0u, 0u, 0u, 0u};
            int qv = tid; asm volatile("" : "+v"(qv));
#pragma unroll
            for (int n = 0; n < 3; ++n) { const int s = qv + 512 * n, wt = s / 40, cv = s % 40; const int t = lo - 2 + wt;
                const int col = COL_CV + (cv < 16 ? hg * 128 + 8 * cv : (cv < 32 ? 1024 + hg * 128 + 8 * (cv - 16) : 2048 + hg * 128 + half * 64 + 8 * (cv - 32)));
                const u32x4 gv_ = (s < 1440 && t >= 0 && t < Tlen) ? *(const u32x4*)(P1 + (size_t)(rowbase + t) * LD1 + col) : zz; pre[n][0] = gv_.x; pre[n][1] = gv_.y; pre[n][2] = gv_.z; pre[n][3] = gv_.w; }
            if (qv < CH) { const int t = t0 + sgn * qv; const bf16_t* ro = P1 + (size_t)(rowbase + t) * LD1 + COL_AB;
                pab = (unsigned)ro[d * 8 + hg] | ((unsigned)ro[16 + d * 8 + hg] << 16); }
        };
        auto consumeA = [&]() {
            int qa = tid; asm volatile("" : "+v"(qa));
#pragma unroll
            for (int n = 0; n < 3; ++n) { const int s = qa + 512 * n; if (s < 1440) *(u32x4*)(RAW + s * 8) = (u32x4){pre[n][0], pre[n][1], pre[n][2], pre[n][3]}; }
            if (qa < CH) { const float a_raw = __uint_as_float(pab << 16), b_raw = __uint_as_float(pab & 0xffff0000u);
                const float xx = a_raw + dtb; const float sp = xx > 20.f ? xx : __logf(1.f + __expf(xx));
                GSC[qa * 4 + 0] = alog * sp; GSC[qa * 4 + 1] = sigm(b_raw); }
        };
        prefetch(0);
        consumeA();
        __syncthreads();
        for (int ch = 0; ch < NCHUNK; ++ch) {
            int qo = tid; asm volatile("" : "+v"(qo));
            const int lane = qo & 63, wave = qo >> 6, fr = lane & 15, fq = lane >> 4;
            const bool isctx = ch < 8;
            const int sbase = isctx ? ch * CH : (ch - 8) * CH, Tlen = isctx ? TC : TL;
            const int rowbase = isctx ? MLAT + b * TC : b * TL;
            const int t0 = d == 0 ? sbase : Tlen - 1 - sbase, sgn = d == 0 ? 1 : -1;
            if (ch + 1 < NCHUNK) prefetch(ch + 1);
            if (qo < 480) { const int cv = qo % 40, tg = qo / 40; const int ntok = tg < 8 ? 3 : 2, tok0 = tg < 8 ? 3 * tg : 24 + 2 * (tg - 8);
                u32x4 raw[7];
#pragma unroll
                for (int r = 0; r < 7; ++r) { const int rr = tok0 + r < 36 ? tok0 + r : 35; raw[r] = *(const u32x4*)(RAW + rr * 320 + 8 * cv); }
#pragma unroll
                for (int o = 0; o < 3; ++o) if (o < ntok) { float acc[8];
#pragma unroll
                    for (int e = 0; e < 8; ++e) { float a_ = 0.f;
#pragma unroll
                        for (int j = 0; j < 5; ++j) { const unsigned w_ = raw[o + j][e >> 1]; a_ += cwr[j][e] * __uint_as_float((e & 1) ? (w_ & 0xffff0000u) : (w_ << 16)); }
                        acc[e] = a_ * sigm(a_); }
                    const int wt_ = tok0 + o, i = (d == 0 ? wt_ : CH - 1 - wt_);
                    float* dst = cv < 16 ? UQ + i * 128 + 8 * cv : (cv < 32 ? UK + i * 128 + 8 * (cv - 16) : UV + i * 64 + 8 * (cv - 32));
                    *(f32x4*)dst = (f32x4){acc[0], acc[1], acc[2], acc[3]}; *(f32x4*)(dst + 4) = (f32x4){acc[4], acc[5], acc[6], acc[7]}; } }
            if (wave == 7) { float g = lane < CH ? GSC[lane * 4] : 0.f;
#pragma unroll
                for (int o = 1; o < 32; o <<= 1) { const float t = __shfl_up(g, o); if (lane >= o) g += t; }
                if (lane < CH) GC[lane] = g; }
            __syncthreads();
            { const int i = qo >> 4, cg = qo & 15, j0 = 8 * cg;
              float qv8[8], kv8[8];
#pragma unroll
              for (int e = 0; e < 2; ++e) { const f32x4 a = *(const f32x4*)(UQ + i * 128 + j0 + 4 * e), b2 = *(const f32x4*)(UK + i * 128 + j0 + 4 * e);
#pragma unroll
                  for (int x = 0; x < 4; ++x) { qv8[4 * e + x] = a[x]; kv8[4 * e + x] = b2[x]; } }
              float sq = 0.f, sk = 0.f;
#pragma unroll
              for (int e = 0; e < 8; ++e) { sq += qv8[e] * qv8[e]; sk += kv8[e] * kv8[e]; }
              sq = red16(sq); sk = red16(sk);
              const float rq = rsqrtf(sq + 1e-6f) * 0.08838834764831845f, rk = rsqrtf(sk + 1e-6f);
              const float gci = GC[i], gcl = GC[CH - 1], beta = GSC[i * 4 + 1];
              const float eg = __expf(gci), et = __expf(gcl - gci), bg = beta * eg;
              float vv[8];
              if (cg < 8) { const f32x4 a = *(const f32x4*)(UV + i * 64 + j0), b2 = *(const f32x4*)(UV + i * 64 + j0 + 4);
#pragma unroll
                  for (int x = 0; x < 4; ++x) { vv[x] = a[x]; vv[4 + x] = b2[x]; } }
#pragma unroll
              for (int e = 0; e < 8; ++e) { qv8[e] *= rq; kv8[e] *= rk; }
              u32x4 w;
              w.x = pk2(kv8[0], kv8[1]); w.y = pk2(kv8[2], kv8[3]); w.z = pk2(kv8[4], kv8[5]); w.w = pk2(kv8[6], kv8[7]); *(u32x4*)(KA + i * LDK + j0) = w;
              w.x = pk2(qv8[0], qv8[1]); w.y = pk2(qv8[2], qv8[3]); w.z = pk2(qv8[4], qv8[5]); w.w = pk2(qv8[6], qv8[7]); *(u32x4*)(QA + i * LDK + j0) = w;
              w.x = pk2(qv8[0] * eg, qv8[1] * eg); w.y = pk2(qv8[2] * eg, qv8[3] * eg); w.z = pk2(qv8[4] * eg, qv8[5] * eg); w.w = pk2(qv8[6] * eg, qv8[7] * eg); *(u32x4*)(QD + i * LDK + j0) = w;
              w.x = pk2(kv8[0] * bg, kv8[1] * bg); w.y = pk2(kv8[2] * bg, kv8[3] * bg); w.z = pk2(kv8[4] * bg, kv8[5] * bg); w.w = pk2(kv8[6] * bg, kv8[7] * bg); *(u32x4*)(KGT + i * 144 + j0) = w;
              w.x = pk2(kv8[0] * et, kv8[1] * et); w.y = pk2(kv8[2] * et, kv8[3] * et); w.z = pk2(kv8[4] * et, kv8[5] * et); w.w = pk2(kv8[6] * et, kv8[7] * et); *(u32x4*)(KTT + i * 144 + j0) = w;
              if (cg < 8) { w.x = pk2(vv[0] * beta, vv[1] * beta); w.y = pk2(vv[2] * beta, vv[3] * beta); w.z = pk2(vv[4] * beta, vv[5] * beta); w.w = pk2(vv[6] * beta, vv[7] * beta); *(u32x4*)(VT + i * 72 + j0) = w; } }
            __syncthreads();
            { const int mt = (wave >> 1) & 1, nt = wave & 1; const bf16_t* Am = wave < 4 ? KA : QA;
              f32x4 acc = {0.f, 0.f, 0.f, 0.f};
#pragma unroll
              for (int ks = 0; ks < 4; ++ks) { const s16x8 a = *(const s16x8*)(KA + (nt * 16 + fr) * LDK + ks * 32 + fq * 8), bb = *(const s16x8*)(Am + (mt * 16 + fr) * LDK + ks * 32 + fq * 8);
                  acc = MFMA16(a, bb, acc); }
              const int i = mt * 16 + fr; const float gci = GC[i], bi = GSC[i * 4 + 1];
              const f32x4 gcj = *(const f32x4*)(GC + nt * 16 + fq * 4);
              float lv[4];
#pragma unroll
              for (int r = 0; r < 4; ++r) { const int j = nt * 16 + fq * 4 + r; const float dec = __expf(fminf(gci - gcj[r], 0.f));
                  lv[r] = wave < 4 ? ((i > j) ? bi * acc[r] * dec : 0.f) : ((i >= j) ? acc[r] * dec : 0.f); }
              if (wave < 4) *(f32x4*)(LM + i * LDL + nt * 16 + fq * 4) = (f32x4){lv[0], lv[1], lv[2], lv[3]};
              else { uint2 o; o.x = pk2(lv[0], lv[1]); o.y = pk2(lv[2], lv[3]); *(uint2*)(QKM + i * LDC + nt * 16 + fq * 4) = o; } }
            if (wave == 0 || wave == 3) { asm volatile("s_waitcnt lgkmcnt(0)" ::: "memory"); tri_inv_part1(LM, TM, (bf16_t*)(smem + G_T11T), wave == 0 ? 0 : 1, lane); }
            __syncthreads();
            if (wave == 0) tri_inv_part2(LM, TM, (const bf16_t*)(smem + G_T11T), (bf16_t*)(smem + G_XT), lane);
            __syncthreads();
            const int mtu = wave >> 2, ntu = wave & 3;
            f32x4 vacc;
            { const s16x8 a = *(const s16x8*)(TM + (mtu * 16 + fr) * LDC + fq * 8), bb = tr_frag(VT, 72, ntu, lane);
              vacc = MFMA16(a, bb, ((f32x4){0.f, 0.f, 0.f, 0.f}));
#pragma unroll
              for (int x = 0; x < 2; ++x) { const int tt = 2 * wave + x, mtk = tt >> 1, ntk = tt & 1;
                  const s16x8 a2 = tr_frag(KGT, 144, mtk, lane), b2 = *(const s16x8*)(TM + (ntk * 16 + fr) * LDC + fq * 8);
                  const f32x4 r = MFMA16(a2, b2, ((f32x4){0.f, 0.f, 0.f, 0.f}));
                  uint2 o; o.x = pk2(-r[0], -r[1]); o.y = pk2(-r[2], -r[3]);
                  *(uint2*)(WK + (ntk * 16 + fr) * LDK + mtk * 16 + fq * 4) = o; } }
            __syncthreads();
            f32x4 oacc = {0.f, 0.f, 0.f, 0.f};
#pragma unroll
            for (int ks = 0; ks < 4; ++ks) { const s16x8 bs = *(const s16x8*)(ST + (ntu * 16 + fr) * LDK + ks * 32 + fq * 8);
                const s16x8 aw = *(const s16x8*)(WK + (mtu * 16 + fr) * LDK + ks * 32 + fq * 8), aq = *(const s16x8*)(QD + (mtu * 16 + fr) * LDK + ks * 32 + fq * 8);
                vacc = MFMA16(aw, bs, vacc); oacc = MFMA16(aq, bs, oacc); }
            { uint2 o; o.x = pk2(vacc[0], vacc[1]); o.y = pk2(vacc[2], vacc[3]); *(uint2*)(VNT + (ntu * 16 + fr) * LDC + mtu * 16 + fq * 4) = o; }
            __syncthreads();
            { const s16x8 a = *(const s16x8*)(QKM + (mtu * 16 + fr) * LDC + fq * 8), bb = *(const s16x8*)(VNT + (ntu * 16 + fr) * LDC + fq * 8);
              oacc = MFMA16(a, bb, oacc);
              if (!isctx) { bf16_t* op = OD + ((size_t)d * MLAT + rowbase + t0) * 1024 + hg * 128 + half * 64 + ntu * 16 + fr;
#pragma unroll
                  for (int r = 0; r < 4; ++r) op[(ptrdiff_t)sgn * (mtu * 16 + fq * 4 + r) * 1024] = f2bf(oacc[r]); }
              const float gl = __expf(GC[CH - 1]);
              const s16x8 ak = tr_frag(KTT, 144, wave, lane);
#pragma unroll
              for (int nt = 0; nt < 4; ++nt) { const s16x8 bv = *(const s16x8*)(VNT + (nt * 16 + fr) * LDC + fq * 8);
                  sacc[nt] = MFMA16(ak, bv, sacc[nt] * gl);
                  uint2 o; o.x = pk2(sacc[nt][0], sacc[nt][1]); o.y = pk2(sacc[nt][2], sacc[nt][3]);
                  *(uint2*)(ST + (nt * 16 + fr) * LDK + wave * 16 + fq * 4) = o; } }
            if (ch + 1 < NCHUNK) consumeA();
            __syncthreads();
        }
    }
}

constexpr int LK2 = 72;
constexpr int R_WR = 0, R_KD = 8192, R_W = 16384, R_BB = 24576, R_LM = 0, R_TM = 4608, R_AKM = 7168, R_RKM = 9728, R_RBM = 12288, R_WM = 14848, R_X1T = 19456, R_NUT = 24576,
              R_V = 32768, R_THW = 40960, R_THA = 47104, R_GAM = 53248, R_PRM = 61440, R_AT = 62464, R_RT = 67072, R_KT = 71680, R_BT = 76288,
              R_ATT = 80896, R_KTT = 86144, R_BTT = 91392, R_VT = 96640, R_ST = 101888, R_T11T = 111104, R_XT = 111616;
__device__ __forceinline__ void phase_rwkv_chunked(const Params& P, unsigned char* smem) {
    const int tid = threadIdx.x;
    const bf16_t* P1 = (const bf16_t*)(P.ws + WS_X);
    bf16_t* YD = (bf16_t*)P.out;
    float* SBON = (float*)(P.ws + WS_M + MiB);
    float* A_wr = (float*)(smem + R_WR); float* A_kd = (float*)(smem + R_KD); float* A_w = (float*)(smem + R_W); float* A_bb = (float*)(smem + R_BB); float* A_v = (float*)(smem + R_V);
    bf16_t* TH_w = (bf16_t*)(smem + R_THW); bf16_t* TH_a = (bf16_t*)(smem + R_THA); float* GAM = (float*)(smem + R_GAM); float* PRM = (float*)(smem + R_PRM);
    float* LM = (float*)(smem + R_LM); bf16_t* TM = (bf16_t*)(smem + R_TM); bf16_t* AKM = (bf16_t*)(smem + R_AKM); bf16_t* RKM = (bf16_t*)(smem + R_RKM); bf16_t* RBM = (bf16_t*)(smem + R_RBM);
    bf16_t* WM = (bf16_t*)(smem + R_WM); bf16_t* X1T = (bf16_t*)(smem + R_X1T); bf16_t* NUT = (bf16_t*)(smem + R_NUT);
    bf16_t* AT = (bf16_t*)(smem + R_AT); bf16_t* RT = (bf16_t*)(smem + R_RT); bf16_t* KT = (bf16_t*)(smem + R_KT); bf16_t* BT = (bf16_t*)(smem + R_BT);
    bf16_t* ATT = (bf16_t*)(smem + R_ATT); bf16_t* KTT = (bf16_t*)(smem + R_KTT); bf16_t* BTT = (bf16_t*)(smem + R_BTT); bf16_t* VT = (bf16_t*)(smem + R_VT); bf16_t* ST = (bf16_t*)(smem + R_ST);
    const float* mu = P.in[8];
    for (int it = blockIdx.x; it < 256; it += gridDim.x) {
        const int b = it >> 5, h = (it >> 1) & 15, d = it & 1;
        f32x4 sacc[2];
        sacc[0] = (f32x4){0.f, 0.f, 0.f, 0.f}; sacc[1] = (f32x4){0.f, 0.f, 0.f, 0.f};
        s16x8 Bw[3], Ba[3];
        __syncthreads();
        { const int lane = tid & 63, wave = tid >> 6; const int cB = h * 64 + 16 * (wave & 3) + (lane & 15);
#pragma unroll
          for (int ks = 0; ks < 3; ++ks)
#pragma unroll
            for (int j = 0; j < 8; ++j) { const int k = ks * 32 + (lane >> 4) * 8 + j;
                Bw[ks][j] = (short)f2bf(P.in[10][((size_t)d * 96 + k) * 1024 + cB]); Ba[ks][j] = (short)f2bf(P.in[12][((size_t)d * 96 + k) * 1024 + cB]); }
          if (tid < 64) { PRM[tid] = P.in[14][h * 64 + tid]; PRM[64 + tid] = P.in[15][h * 64 + tid]; PRM[128 + tid] = P.in[16][h * 64 + tid]; }
          for (int e = tid; e < 64 * LK2 / 2; e += 512) ((unsigned*)ST)[e] = 0u; }
        const float w0c = P.in[9][d * 1024 + h * 64 + 16 * ((tid >> 6) & 3) + (tid & 15)], a0c = P.in[11][d * 1024 + h * 64 + 16 * ((tid >> 6) & 3) + (tid & 15)];
        unsigned pre[3][12];
        auto prefetch = [&](int ch) {
            const bool isctx = ch < 8;
            const int sbase = isctx ? ch * CH : (ch - 8) * CH, Tlen = isctx ? TC : TL;
            const int rowbase = isctx ? MLAT + b * TC : b * TL;
            const int t0 = d == 0 ? sbase : Tlen - 1 - sbase, sgn = d == 0 ? 1 : -1;
            const u32x4 zz = {0u, 0u, 0u, 0u};
            int qv = tid; asm volatile("" : "+v"(qv));
#pragma unroll
            for (int n = 0; n < 3; ++n) { const int ws = n * 8 + (qv >> 6), ln_ = qv & 63; const int L_ = (ws < 12 ? ws : (ws < 18 ? ws - 12 : ws - 18)) * 64 + ln_;
                const int i = ws < 12 ? L_ / 24 : L_ / 12, cv = ws < 12 ? L_ % 24 : (ws < 18 ? 24 + L_ % 12 : 36 + L_ % 12); const int t = t0 + sgn * i;
                const int col = cv < 8 ? h * 64 + 8 * cv : (cv < 16 ? 1024 + h * 64 + 8 * (cv - 8) : (cv < 24 ? 2048 + h * 64 + 8 * (cv - 16) : (cv < 36 ? 3072 + d * 96 + 8 * (cv - 24) : 3264 + d * 96 + 8 * (cv - 36))));
                const bf16_t* pp = P1 + (size_t)(rowbase + t) * LD1 + col;
                { const u32x4 pv_ = *(const u32x4*)pp; pre[n][0] = pv_.x; pre[n][1] = pv_.y; pre[n][2] = pv_.z; pre[n][3] = pv_.w; }
                const unsigned* pw = (const unsigned*)pp; constexpr int LW = LD1 / 2;
                if (isctx) { const bool vl = t > 0, vr = t < TC - 1;
                    const u32x4 L = vl ? *(const u32x4*)(pp - LD1) : zz, R = vr ? *(const u32x4*)(pp + LD1) : zz;
                    pre[n][4] = L.x; pre[n][5] = L.y; pre[n][6] = L.z; pre[n][7] = L.w; pre[n][8] = R.x; pre[n][9] = R.y; pre[n][10] = R.z; pre[n][11] = R.w; }
                else { const int x = t & 63, y = t >> 6; const bool vl = x > 0, vr = x < 63, vu = y > 0, vd = y < 31;
                    pre[n][4] = vl ? pw[-LW + 0] : 0u; pre[n][5] = vl ? pw[-LW + 2] : 0u; pre[n][6] = vr ? pw[LW + 0] : 0u; pre[n][7] = vr ? pw[LW + 2] : 0u;
                    pre[n][8] = vu ? pw[-64 * LW + 1] : 0u; pre[n][9] = vu ? pw[-64 * LW + 3] : 0u; pre[n][10] = vd ? pw[64 * LW + 1] : 0u; pre[n][11] = vd ? pw[64 * LW + 3] : 0u; } }
        };
        prefetch(0);
        for (int ch = 0; ch < NCHUNK; ++ch) {
            int qo = tid; asm volatile("" : "+v"(qo));
            const int lane = qo & 63, wave = qo >> 6, fr = lane & 15, fq = lane >> 4;
            const bool isctx = ch < 8;
            const int sbase = isctx ? ch * CH : (ch - 8) * CH, Tlen = isctx ? TC : TL;
            const int rowbase = isctx ? MLAT + b * TC : b * TL;
            const int t0 = d == 0 ? sbase : Tlen - 1 - sbase, sgn = d == 0 ? 1 : -1;
#pragma unroll
            for (int n = 0; n < 3; ++n) { const int ws = n * 8 + wave; const int L_ = (ws < 12 ? ws : (ws < 18 ? ws - 12 : ws - 18)) * 64 + lane;
                const int i = ws < 12 ? L_ / 24 : L_ / 12, cv = ws < 12 ? L_ % 24 : (ws < 18 ? 24 + L_ % 12 : 36 + L_ % 12);
                const int col = cv < 8 ? h * 64 + 8 * cv : (cv < 16 ? 1024 + h * 64 + 8 * (cv - 8) : (cv < 24 ? 2048 + h * 64 + 8 * (cv - 16) : (cv < 36 ? 3072 + d * 96 + 8 * (cv - 24) : 3264 + d * 96 + 8 * (cv - 36))));
                const f32x4 m0 = *(const f32x4*)(mu + col), m1 = *(const f32x4*)(mu + col + 4);
                float xs[8];
#pragma unroll
                for (int e = 0; e < 8; ++e) { const float p = __uint_as_float((e & 1) ? (pre[n][e >> 1] & 0xffff0000u) : (pre[n][e >> 1] << 16));
                    unsigned wv_; const bool hi = (e & 1);
                    if (isctx) wv_ = (e & 1) ? pre[n][8 + (e >> 1)] : pre[n][4 + (e >> 1)];
                    else wv_ = pre[n][4 + 2 * (e & 3) + (e >> 2)];
                    const float ps = __uint_as_float(hi ? (wv_ & 0xffff0000u) : (wv_ << 16));
                    xs[e] = p + (ps - p) * (e < 4 ? m0[e & 3] : m1[e & 3]); }
                if (cv < 24) { float* dst = (cv < 8 ? A_wr + i * 64 + 8 * cv : (cv < 16 ? A_kd + i * 64 + 8 * (cv - 8) : A_v + i * 64 + 8 * (cv - 16)));
                    *(f32x4*)dst = (f32x4){xs[0], xs[1], xs[2], xs[3]}; *(f32x4*)(dst + 4) = (f32x4){xs[4], xs[5], xs[6], xs[7]}; }
                else if (cv < 36) { u32x4 w; w.x = pk2(tanh_fast(xs[0]), tanh_fast(xs[1])); w.y = pk2(tanh_fast(xs[2]), tanh_fast(xs[3])); w.z = pk2(tanh_fast(xs[4]), tanh_fast(xs[5])); w.w = pk2(tanh_fast(xs[6]), tanh_fast(xs[7]));
                    *(u32x4*)(TH_w + i * 96 + 8 * (cv - 24)) = w; }
                else { u32x4 w; w.x = pk2(xs[0], xs[1]); w.y = pk2(xs[2], xs[3]); w.z = pk2(xs[4], xs[5]); w.w = pk2(xs[6], xs[7]);
                    *(u32x4*)(TH_a + i * 96 + 8 * (cv - 36)) = w; } }
            __syncthreads();
            if (ch + 1 < NCHUNK) prefetch(ch + 1);
            if (wave < 4) { const int c = 16 * wave + fr;
              float wv[2][4];
#pragma unroll
              for (int rt = 0; rt < 2; ++rt) { f32x4 cw = {0.f, 0.f, 0.f, 0.f}, ca = {0.f, 0.f, 0.f, 0.f};
#pragma unroll
                  for (int ks = 0; ks < 3; ++ks) { const int off = (rt * 16 + fr) * 96 + ks * 32 + fq * 8;
                      const s16x8 fa = *(const s16x8*)(TH_w + off), fb = *(const s16x8*)(TH_a + off);
                      cw = MFMA16(fa, Bw[ks], cw); ca = MFMA16(fb, Ba[ks], ca); }
#pragma unroll
                  for (int j = 0; j < 4; ++j) { const int i = rt * 16 + fq * 4 + j;
                      wv[rt][j] = __expf(-0.6065306597126334f * sigm(w0c + cw[j])); A_bb[i * 64 + c] = sigm(a0c + ca[j]); } }
              float tot[2];
#pragma unroll
              for (int rt = 0; rt < 2; ++rt) { wv[rt][1] *= wv[rt][0]; wv[rt][2] *= wv[rt][1]; wv[rt][3] *= wv[rt][2];
                  float sx = wv[rt][3]; float u1 = __shfl_up(sx, 16); if (fq >= 1) sx *= u1; float u2 = __shfl_up(sx, 32); if (fq >= 2) sx *= u2;
                  float ex = __shfl_up(sx, 16); if (fq == 0) ex = 1.f;
                  tot[rt] = __shfl(sx, 48 + fr);
                  const float base = ex * (rt == 1 ? tot[0] : 1.f);
#pragma unroll
                  for (int j = 0; j < 4; ++j) GAM[(rt * 16 + fq * 4 + j) * 64 + c] = base * wv[rt][j]; } }
            __syncthreads();
            { const int i = qo >> 4, cg = qo & 15, j0 = 4 * cg;
              const f32x4 xr = *(const f32x4*)(A_wr + i * 64 + j0), xk = *(const f32x4*)(A_kd + i * 64 + j0), ic = *(const f32x4*)(A_bb + i * 64 + j0), xv = *(const f32x4*)(A_v + i * 64 + j0);
              const f32x4 kkw = *(const f32x4*)(PRM + j0), kaw = *(const f32x4*)(PRM + 64 + j0), rkw = *(const f32x4*)(PRM + 128 + j0);
              const f32x4 gi = *(const f32x4*)(GAM + i * 64 + j0), gl = *(const f32x4*)(GAM + 31 * 64 + j0);
              f32x4 gp = {1.f, 1.f, 1.f, 1.f}; if (i > 0) gp = *(const f32x4*)(GAM + (i - 1) * 64 + j0);
              const f32x4 kkr = xk * kkw;
              const float ss = red16(kkr[0] * kkr[0] + kkr[1] * kkr[1] + kkr[2] * kkr[2] + kkr[3] * kkr[3]);
              const f32x4 kk = kkr * rsqrtf(ss + 1e-6f);
              f32x4 kd, bb, at, rt_, kt, bt, ktl, btl; float sbp = 0.f;
#pragma unroll
              for (int e = 0; e < 4; ++e) { kd[e] = xk[e] * (1.f + (ic[e] - 1.f) * kaw[e]); bb[e] = kk[e] * ic[e]; sbp += xr[e] * kd[e] * rkw[e];
                  const float ig = __builtin_amdgcn_rcpf(gi[e]); at[e] = kk[e] * gp[e]; rt_[e] = xr[e] * gi[e]; kt[e] = kd[e] * ig; bt[e] = bb[e] * ig; ktl[e] = kt[e] * gl[e]; btl[e] = bt[e] * gl[e]; }
              const float sb = 0.5f * red16(sbp);
              if (cg == 0 && !isctx) SBON[((size_t)d * MLAT + rowbase + t0 + sgn * i) * 16 + h] = sb;
              uint2 o;
              o.x = pk2(at[0], at[1]); o.y = pk2(at[2], at[3]); *(uint2*)(AT + i * LK2 + j0) = o;
              o.x = pk2(rt_[0], rt_[1]); o.y = pk2(rt_[2], rt_[3]); *(uint2*)(RT + i * LK2 + j0) = o;
              o.x = pk2(kt[0], kt[1]); o.y = pk2(kt[2], kt[3]); *(uint2*)(KT + i * LK2 + j0) = o;
              o.x = pk2(bt[0], bt[1]); o.y = pk2(bt[2], bt[3]); *(uint2*)(BT + i * LK2 + j0) = o;
              o.x = pk2(ktl[0], ktl[1]); o.y = pk2(ktl[2], ktl[3]); *(uint2*)(KTT + i * LK2 + j0) = o;
              o.x = pk2(btl[0], btl[1]); o.y = pk2(btl[2], btl[3]); *(uint2*)(BTT + i * LK2 + j0) = o;
              o.x = pk2(xv[0], xv[1]); o.y = pk2(xv[2], xv[3]); *(uint2*)(VT + i * LK2 + j0) = o; }
            __syncthreads();
#pragma unroll
            for (int x = 0; x < 2; ++x) { const int t = 2 * wave + x, m = t >> 2, mt = (t >> 1) & 1, nt = t & 1;
                const bf16_t* Am = m < 2 ? AT : RT; const bf16_t* Bm = (m == 0 || m == 3) ? BT : KT;
                f32x4 acc = {0.f, 0.f, 0.f, 0.f};
#pragma unroll
                for (int ks = 0; ks < 2; ++ks) { const s16x8 a = *(const s16x8*)(Bm + (nt * 16 + fr) * LK2 + ks * 32 + fq * 8), bb2 = *(const s16x8*)(Am + (mt * 16 + fr) * LK2 + ks * 32 + fq * 8);
                    acc = MFMA16(a, bb2, acc); }
                const int i = mt * 16 + fr; float lv[4];
#pragma unroll
                for (int r = 0; r < 4; ++r) { const int j = nt * 16 + fq * 4 + r; lv[r] = (m < 2 ? (i > j) : (i >= j)) ? acc[r] : 0.f; }
                if (m == 0) *(f32x4*)(LM + i * LDL + nt * 16 + fq * 4) = (f32x4){lv[0], lv[1], lv[2], lv[3]};
                else { bf16_t* dstm = m == 1 ? AKM : (m == 2 ? RKM : RBM); uint2 o; o.x = pk2(lv[0], lv[1]); o.y = pk2(lv[2], lv[3]); *(uint2*)(dstm + i * LDC + nt * 16 + fq * 4) = o; } }
            if (wave < 2) { asm volatile("s_waitcnt lgkmcnt(0)" ::: "memory"); tri_inv_part1(LM, TM, (bf16_t*)(smem + R_T11T), wave, lane); }
            __syncthreads();
            if (wave == 0) tri_inv_part2(LM, TM, (const bf16_t*)(smem + R_T11T), (bf16_t*)(smem + R_XT), lane);
            else {
                const int ntile = (wave == 1) ? 2 : 1;
                for (int q2 = 0; q2 < ntile; ++q2) { const int tl = (q2 == 0) ? wave : 0; const int mt = tl >> 2, nt = tl & 3;
                    const s16x8 a = *(const s16x8*)(AKM + (mt * 16 + fr) * LDC + fq * 8), bb2 = tr_frag(VT, LK2, nt, lane);
                    const f32x4 r = MFMA16(a, bb2, ((f32x4){0.f, 0.f, 0.f, 0.f}));
                    uint2 o; o.x = pk2(r[0], r[1]); o.y = pk2(r[2], r[3]); *(uint2*)(X1T + (nt * 16 + fr) * LDC + mt * 16 + fq * 4) = o; }
            }
            __syncthreads();
            const int mtu = wave >> 2, ntu = wave & 3;
            f32x4 uacc;
            { const s16x8 a = *(const s16x8*)(TM + (mtu * 16 + fr) * LDC + fq * 8), bb2 = *(const s16x8*)(X1T + (ntu * 16 + fr) * LDC + fq * 8);
              uacc = MFMA16(a, bb2, ((f32x4){0.f, 0.f, 0.f, 0.f}));
              const int kt_ = wave >> 1, it_ = wave & 1;
              const s16x8 a2 = tr_frag(AT, LK2, kt_, lane), b2 = *(const s16x8*)(TM + (it_ * 16 + fr) * LDC + fq * 8);
              const f32x4 r = MFMA16(a2, b2, ((f32x4){0.f, 0.f, 0.f, 0.f}));
              uint2 o; o.x = pk2(r[0], r[1]); o.y = pk2(r[2], r[3]); *(uint2*)(WM + (it_ * 16 + fr) * LK2 + kt_ * 16 + fq * 4) = o; }
            __syncthreads();
            f32x4 yacc = {0.f, 0.f, 0.f, 0.f};
#pragma unroll
            for (int ks = 0; ks < 2; ++ks) { const s16x8 bs = *(const s16x8*)(ST + (ntu * 16 + fr) * LK2 + ks * 32 + fq * 8);
                const s16x8 aw = *(const s16x8*)(WM + (mtu * 16 + fr) * LK2 + ks * 32 + fq * 8), ar = *(const s16x8*)(RT + (mtu * 16 + fr) * LK2 + ks * 32 + fq * 8);
                uacc = MFMA16(aw, bs, uacc); yacc = MFMA16(ar, bs, yacc); }
            { const s16x8 a = *(const s16x8*)(RKM + (mtu * 16 + fr) * LDC + fq * 8), bb2 = tr_frag(VT, LK2, ntu, lane);
              yacc = MFMA16(a, bb2, yacc);
              uint2 o; o.x = pk2(-uacc[0], -uacc[1]); o.y = pk2(-uacc[2], -uacc[3]); *(uint2*)(NUT + (ntu * 16 + fr) * LDC + mtu * 16 + fq * 4) = o; }
            __syncthreads();
            { const s16x8 a = *(const s16x8*)(RBM + (mtu * 16 + fr) * LDC + fq * 8), bb2 = *(const s16x8*)(NUT + (ntu * 16 + fr) * LDC + fq * 8);
              yacc = MFMA16(a, bb2, yacc);
              if (!isctx) { bf16_t* yp = YD + ((size_t)d * MLAT + rowbase + t0) * 1024 + h * 64 + ntu * 16 + fr;
#pragma unroll
                  for (int r = 0; r < 4; ++r) yp[(ptrdiff_t)sgn * (mtu * 16 + fq * 4 + r) * 1024] = f2bf(yacc[r]); }
              const int kt_ = wave >> 1;
              const f32x4 gl = *(const f32x4*)(GAM + 31 * 64 + kt_ * 16 + fq * 4);
              const s16x8 ak = tr_frag(KTT, LK2, kt_, lane), ab = tr_frag(BTT, LK2, kt_, lane);
#pragma unroll
              for (int x = 0; x < 2; ++x) { const int vt = 2 * (wave & 1) + x;
                  const s16x8 bv = tr_frag(VT, LK2, vt, lane), bu = *(const s16x8*)(NUT + (vt * 16 + fr) * LDC + fq * 8);
                  sacc[x] = MFMA16(ak, bv, sacc[x] * gl); sacc[x] = MFMA16(ab, bu, sacc[x]);
                  uint2 o; o.x = pk2(sacc[x][0], sacc[x][1]); o.y = pk2(sacc[x][2], sacc[x][3]);
                  *(uint2*)(ST + (vt * 16 + fr) * LK2 + kt_ * 16 + fq * 4) = o; } }
            __syncthreads();
        }
    }
}


__device__ __forceinline__ void mix8_lat(const bf16_t* P1, int row, int col0, const float* mu, float (&xs)[8]) {
    const int t = row & (TL - 1), x = t & 63, y = t >> 6; const bool vl = x > 0, vr = x < 63, vu = y > 0, vd = y < 31;
    const bf16_t* pp = P1 + (size_t)row * LD1 + col0; const unsigned* pw = (const unsigned*)pp; constexpr int LW = LD1 / 2;
    const u32x4 pv = *(const u32x4*)pp;
    unsigned nb[8];
    nb[0] = vl ? pw[-LW + 0] : 0u; nb[1] = vl ? pw[-LW + 2] : 0u; nb[2] = vr ? pw[LW + 0] : 0u; nb[3] = vr ? pw[LW + 2] : 0u;
    nb[4] = vu ? pw[-64 * LW + 1] : 0u; nb[5] = vu ? pw[-64 * LW + 3] : 0u; nb[6] = vd ? pw[64 * LW + 1] : 0u; nb[7] = vd ? pw[64 * LW + 3] : 0u;
    const f32x4 m0 = *(const f32x4*)(mu + col0), m1 = *(const f32x4*)(mu + col0 + 4);
#pragma unroll
    for (int e = 0; e < 8; ++e) { const float p = __uint_as_float((e & 1) ? (pv[e >> 1] & 0xffff0000u) : (pv[e >> 1] << 16));
        const unsigned w_ = nb[2 * (e & 3) + (e >> 2)]; const float ps = __uint_as_float((e & 1) ? (w_ & 0xffff0000u) : (w_ << 16));
        xs[e] = p + (ps - p) * (e < 4 ? m0[e & 3] : m1[e & 3]); }
}
__device__ __forceinline__ void phase_sg(const Params& P) {
    const bf16_t* P1 = (const bf16_t*)(P.ws + WS_X); bf16_t* SG = (bf16_t*)(P.ws + WS_A + 32 * MiB);
    const int gt = blockIdx.x * 512 + threadIdx.x, NT = gridDim.x * 512;
    for (int s = gt; s < MLAT * 32; s += NT) { const int row = s >> 5, k8 = s & 31;
        u32x4 w = {0u, 0u, 0u, 0u};
        if (k8 < 8) { float xs[8]; mix8_lat(P1, row, 3456 + 8 * k8, P.in[8], xs);
            w.x = pk2(sigm(xs[0]), sigm(xs[1])); w.y = pk2(sigm(xs[2]), sigm(xs[3])); w.z = pk2(sigm(xs[4]), sigm(xs[5])); w.w = pk2(sigm(xs[6]), sigm(xs[7])); }
        *(u32x4*)(SG + (size_t)row * 256 + 8 * k8) = w; }
}
__device__ __forceinline__ void phase_readout_rwkv(const Params& P) {
    const bf16_t* P1 = (const bf16_t*)(P.ws + WS_X); const bf16_t* YD = (const bf16_t*)P.out; const float* SBON = (const float*)(P.ws + WS_M + MiB);
    bf16_t* OA = (bf16_t*)(P.ws + WS_A);
    const float* lnw = P.in[17]; const float* lnb = P.in[18];
    const int gt = blockIdx.x * 512 + threadIdx.x, NT = gridDim.x * 512;
    for (int s = gt; s < MLAT * 128; s += NT) { const int row = s >> 7, cv = s & 127, c0 = 8 * cv, hd = cv >> 3;
        const u32x4 y0 = *(const u32x4*)(YD + (size_t)row * 1024 + c0), y1 = *(const u32x4*)(YD + ((size_t)MLAT + row) * 1024 + c0), gg = *(const u32x4*)(OA + (size_t)row * 1024 + c0);
        float xv[8]; mix8_lat(P1, row, 2048 + c0, P.in[8], xv);
        const float sb = SBON[(size_t)row * 16 + hd] + SBON[((size_t)MLAT + row) * 16 + hd];
        const f32x4 w0 = *(const f32x4*)(lnw + c0), w1 = *(const f32x4*)(lnw + c0 + 4), b0 = *(const f32x4*)(lnb + c0), b1 = *(const f32x4*)(lnb + c0 + 4);
        float y[8], sum = 0.f;
#pragma unroll
        for (int e = 0; e < 8; ++e) { const unsigned a_ = y0[e >> 1], b_ = y1[e >> 1];
            y[e] = __uint_as_float((e & 1) ? (a_ & 0xffff0000u) : (a_ << 16)) + __uint_as_float((e & 1) ? (b_ & 0xffff0000u) : (b_ << 16)); sum += y[e]; }
        const float m = red8(sum) * (1.f / 64.f); float vs = 0.f;
#pragma unroll
        for (int e = 0; e < 8; ++e) { y[e] -= m; vs += y[e] * y[e]; }
        const float rs = rsqrtf(red8(vs) * (1.f / 64.f) + 64e-5f);
        float o[8];
#pragma unroll
        for (int e = 0; e < 8; ++e) { const unsigned g_ = gg[e >> 1]; const float gate = __uint_as_float((e & 1) ? (g_ & 0xffff0000u) : (g_ << 16));
            o[e] = (y[e] * rs * (e < 4 ? w0[e & 3] : w1[e & 3]) + (e < 4 ? b0[e & 3] : b1[e & 3]) + sb * xv[e]) * gate; }
        u32x4 w; w.x = pk2(o[0], o[1]); w.y = pk2(o[2], o[3]); w.z = pk2(o[4], o[5]); w.w = pk2(o[6], o[7]);
        *(u32x4*)(OA + (size_t)row * 1024 + c0) = w; }
}
__device__ __forceinline__ void phase_readout(const Params& P, unsigned char* smem) {
    const int tid = threadIdx.x, lane = tid & 63, wave = tid >> 6;
    const bf16_t* P1 = (const bf16_t*)(P.ws + WS_X); const bf16_t* P2 = (const bf16_t*)(P.ws + WS_D);
    const bf16_t* YD = (const bf16_t*)P.out; const bf16_t* OD = YD + (size_t)2 * MLAT * 1024;
    const float* SBON = (const float*)(P.ws + WS_M + MiB);
    bf16_t* OA = (bf16_t*)(P.ws + WS_A); bf16_t* OB = (bf16_t*)(P.ws + WS_F);
    const float* mu = P.in[8];
    { const int gw = blockIdx.x * 8 + wave, NGW = gridDim.x * 8; const float* nw = P.in[22];
      for (int row = gw; row < MLAT; row += NGW) { const int c0 = lane * 16;
        const u32x4 a0 = *(const u32x4*)(OD + (size_t)row * 1024 + c0), a1 = *(const u32x4*)(OD + (size_t)row * 1024 + c0 + 8);
        const u32x4 b0 = *(const u32x4*)(OD + ((size_t)MLAT + row) * 1024 + c0), b1 = *(const u32x4*)(OD + ((size_t)MLAT + row) * 1024 + c0 + 8);
        const u32x4 z0 = *(const u32x4*)(P2 + (size_t)row * LD2 + c0), z1 = *(const u32x4*)(P2 + (size_t)row * LD2 + c0 + 8);
        float o[16], z[16];
#pragma unroll
        for (int e = 0; e < 4; ++e) { o[2 * e] = __uint_as_float(a0[e] << 16) + __uint_as_float(b0[e] << 16); o[2 * e + 1] = __uint_as_float(a0[e] & 0xffff0000u) + __uint_as_float(b0[e] & 0xffff0000u);
            o[8 + 2 * e] = __uint_as_float(a1[e] << 16) + __uint_as_float(b1[e] << 16); o[8 + 2 * e + 1] = __uint_as_float(a1[e] & 0xffff0000u) + __uint_as_float(b1[e] & 0xffff0000u);
            z[2 * e] = __uint_as_float(z0[e] << 16); z[2 * e + 1] = __uint_as_float(z0[e] & 0xffff0000u); z[8 + 2 * e] = __uint_as_float(z1[e] << 16); z[8 + 2 * e + 1] = __uint_as_float(z1[e] & 0xffff0000u); }
        float ss = 0.f;
#pragma unroll
        for (int e = 0; e < 16; ++e) ss += o[e] * o[e];
        ss = red8(ss);
        const float rs = rsqrtf(ss * (1.f / 128.f) + 1e-6f);
        float r[16];
#pragma unroll
        for (int e = 0; e < 16; ++e) r[e] = o[e] * rs * nw[(c0 + e) & 127] * (z[e] * sigm(z[e]));
        u32x4 w0, w1;
#pragma unroll
        for (int e = 0; e < 4; ++e) { w0[e] = pk2(r[2 * e], r[2 * e + 1]); w1[e] = pk2(r[8 + 2 * e], r[8 + 2 * e + 1]); }
        *(u32x4*)(OB + (size_t)row * 1024 + c0) = w0; *(u32x4*)(OB + (size_t)row * 1024 + c0 + 8) = w1; } }
}

__global__ void __launch_bounds__(512, 2) fwd_mega(Params P) {
    extern __shared__ __attribute__((aligned(16))) unsigned char smem[];
    cg::grid_group grid = cg::this_grid();
    bf16_t* WT_IN = (bf16_t*)(P.ws + WS_A); bf16_t* WT_PA = (bf16_t*)(P.ws + WS_B); bf16_t* WT_PB = WT_PA + 2048 * 1024; bf16_t* WT_OUT = WT_PB + 2048 * 1024;
    bf16_t* P1 = (bf16_t*)(P.ws + WS_X); bf16_t* P2 = (bf16_t*)(P.ws + WS_D); bf16_t* H = (bf16_t*)P.out;
    bf16_t* OA = (bf16_t*)(P.ws + WS_A); bf16_t* OB = (bf16_t*)(P.ws + WS_F); bf16_t* MBUF = (bf16_t*)(P.ws + WS_X); bf16_t* A3 = (bf16_t*)(P.ws + WS_X);
    bf16_t* H2 = (bf16_t*)(P.ws + WS_D); bf16_t* WT_GU = (bf16_t*)(P.ws + WS_A); bf16_t* WT_DN = (bf16_t*)(P.ws + WS_F);
    const float* MOD = (const float*)(P.ws + WS_M);
#define PHASE(n) if (P.ph_lo <= (n) && (n) < P.ph_hi)
#define SEAM(n) do { if (P.coop && P.ph_lo <= (n) && (n) + 1 < P.ph_hi) grid.sync(); } while (0)
    PHASE(0) { phase_prep(P, smem); } SEAM(0);
    PHASE(1) { phase_norm1(P); } SEAM(1);
    PHASE(2) { EpiBf16Plain e1{P1, LD1}; run_gemm(smem, H, WT_IN, MALL, N1, D, e1);
               EpiBf16Plain e2{P2, LD2}; run_gemm(smem, H, WT_IN + (size_t)N1 * D, MLAT, N2, D, e2); } SEAM(2);
    PHASE(3) { phase_sg(P); phase_rwkv_chunked(P, smem); }
    PHASE(4) { phase_gdn(P, smem); } SEAM(4);
    PHASE(5) { EpiBf16Plain eg{OA, 1024}; run_gemm(smem, (const bf16_t*)(P.ws + WS_A + 32 * MiB), (const bf16_t*)(P.ws + WS_M + MiB / 2), MLAT, 1024, 256, eg); phase_readout(P, smem); } SEAM(5);
    PHASE(6) { phase_readout_rwkv(P); } SEAM(6);
    PHASE(7) { EpiGate<false> ea{MBUF, P2 + 1024}; run_gemm(smem, OA, WT_PA, MLAT, D, 1024, ea);
               EpiGate<true> eb{MBUF, P2 + 1024 + 2048}; run_gemm(smem, OB, WT_PB, MLAT, D, 1024, eb); } SEAM(7);
    PHASE(8) { EpiRes e{P.out, P.in[0], MOD + 2 * D}; run_gemm(smem, MBUF, WT_OUT, MLAT, D, D, e); } SEAM(8);
    PHASE(9) { phase_norm2(P); phase_ffn_weights(P, smem); } SEAM(9);
    PHASE(10) { EpiSwiglu e{A3}; run_gemm(smem, H2, WT_GU, MLAT, 2 * FFH, D, e); } SEAM(10);
    PHASE(11) { EpiRes e{P.out, P.out, MOD + 5 * D}; run_gemm(smem, A3, WT_DN, MLAT, D, FFH, e); } SEAM(11);
    PHASE(12) { phase_final_norm(P); }
}

#ifndef N_LAUNCH_PER_PHASE
#define N_LAUNCH_PER_PHASE 0
#endif
#ifndef PROBE_SEQ
#define PROBE_SEQ {0,1,2,3,4,5,6,7,8,9,10,11,12}
#endif
extern "C" void kernel_launch(void* const* d_in, const int* in_sizes, int n_in, void* d_out, int out_size, void* d_ws, size_t ws_size, hipStream_t stream) {
    static int grid = 0;
    if (grid == 0) {
        if (n_in != 30 || out_size != MLAT * D || ws_size < WS_END) { fprintf(stderr, "kernel_launch: unexpected shapes: n_in %d out %d ws %zu (need %zu)\n", n_in, out_size, ws_size, (size_t)WS_END); grid = -1; return; }
        int dev = 0, cus = 0, per_cu = 0;
        if (hipGetDevice(&dev) != hipSuccess || hipDeviceGetAttribute(&cus, hipDeviceAttributeMultiprocessorCount, dev) != hipSuccess) { grid = -1; return; }
        if (hipFuncSetAttribute((const void*)fwd_mega, hipFuncAttributeMaxDynamicSharedMemorySize, LDS_BYTES) != hipSuccess) { fprintf(stderr, "kernel_launch: hipFuncSetAttribute failed\n"); grid = -1; return; }
        if (hipOccupancyMaxActiveBlocksPerMultiprocessor(&per_cu, (const void*)fwd_mega, 512, LDS_BYTES) != hipSuccess || per_cu < 1) { fprintf(stderr, "kernel_launch: occupancy query gives %d\n", per_cu); grid = -1; return; }
        grid = cus * per_cu; if (grid > 256) grid = 256;
    }
    if (grid < 0) return;
    Params p{};
    for (int i = 0; i < 30; ++i) p.in[i] = (const float*)d_in[i];
    p.out = (float*)d_out; p.ws = (unsigned char*)d_ws;
#if N_LAUNCH_PER_PHASE
    { const int seq[] = PROBE_SEQ; for (int si = 0; si < (int)(sizeof(seq) / sizeof(int)); ++si) { const int ph = seq[si]; p.ph_lo = ph; p.ph_hi = ph + 1; p.coop = 0; hipLaunchKernelGGL(fwd_mega, dim3(grid), dim3(512), LDS_BYTES, stream, p); } }
#else
    p.ph_lo = 0; p.ph_hi = 13; p.coop = 1;
    void* args[] = {&p};
    hipError_t e = hipLaunchCooperativeKernel((const void*)fwd_mega, dim3(grid), dim3(512), args, LDS_BYTES, stream);
    if (e != hipSuccess) fprintf(stderr, "cooperative launch failed: %s (grid %d)\n", hipGetErrorString(e), grid);
#endif
}
```

```cpp
#include <hip/hip_runtime.h>
#include <hip/hip_cooperative_groups.h>
#include <cstdio>
#include <cstdint>
namespace cg = cooperative_groups;
namespace pg8 {
#define PG8_LAS __attribute__((address_space(3)))
typedef unsigned short bf16_t;
typedef short bf16x8 __attribute__((ext_vector_type(8)));
typedef float f32x4 __attribute__((ext_vector_type(4)));
typedef unsigned u32x4 __attribute__((ext_vector_type(4)));
constexpr int BM = 256, BK = 64, HALF = 128, HTB = HALF * BK * 2  , STAGE_BYTES = 8 * HTB, NXCD = 8, WGM = 4;

__host__ __device__ __forceinline__ int lds_byte(int r, int c) { const int st = (r >> 4) * 2 + (c >> 5), rr = r & 15, cc = c & 31, ob = rr * 64 + cc * 2; return st * 1024 + (ob ^ (((ob >> 9) & 1) << 5)); }
__host__ __device__ __forceinline__ void stage_rc(int b, int& R, int& C) { const int st = b / 1024, sb = b % 1024, swz = sb ^ (((sb >> 9) & 1) << 5); R = (st >> 1) * 16 + swz / 64; C = (st & 1) * 32 + (swz % 64) / 2; }
__host__ __device__ __forceinline__ int perm32(int rho) { const int n = rho >> 4, i = rho & 15; return 8 * (i >> 2) + 4 * n + (i & 3); }

struct Unit { int pm, pn; };
struct Gemm { const bf16_t* A; const bf16_t* Bt; int M, N, K; };

struct StaticOrder {
    int nM, nN, nwg, G, c;
    __host__ __device__ void init(int M, int N, int G_, int c_) { nM = M / BM; nN = N / BM; nwg = nM * nN; G = G_; c = c_; }
    __host__ __device__ bool next(int i, Unit& u) const {
        const long L = (long)i * G + c; if (L >= nwg) return false;
        int wgid = (int)L; { const int q = nwg / NXCD, r = nwg % NXCD, xcd = wgid % NXCD, off = wgid / NXCD; wgid = (xcd < r ? xcd * (q + 1) : r * (q + 1) + (xcd - r) * q) + off; }
        const int nig = WGM * nN, gid = wgid / nig, fm = gid * WGM, gsz = (nM - fm) < WGM ? (nM - fm) : WGM;
        u.pm = fm + ((wgid % nig) % gsz); u.pn = (wgid % nig) / gsz; return true;
    }
    __device__ __forceinline__ void a_ready(const Unit&) const {}
    __device__ __forceinline__ void done(const Unit&) const {}
};
__device__ __forceinline__ unsigned cvt_pk_bf16(float lo, float hi) { unsigned r; asm volatile("v_cvt_pk_bf16_f32 %0, %1, %2" : "=v"(r) : "v"(lo), "v"(hi)); return r; }
template <class Epi, class Sched, bool ALIGN_EPI = false, bool SP2 = false>
__device__ __forceinline__ void gemm_phase(PG8_LAS unsigned char* lds, const Gemm g, const Sched& S, const Epi& E) {
    const int tid = threadIdx.x, wid = __builtin_amdgcn_readfirstlane(tid >> 6), lane = tid & 63, wr = wid >> 2, wc = wid & 3, fr = lane & 15, fq = lane >> 4;
    const int K = g.K, nt = K / BK;
    unsigned voffA[2], voffB[2];
#pragma unroll
    for (int i = 0; i < 2; ++i) { int R, C; stage_rc(tid * 16 + i * 8192, R, C); const int Rb = Epi::PERM ? ((R & ~31) + perm32(R & 31)) : R;
        voffA[i] = (unsigned)(R * K + C) * 2u; voffB[i] = (unsigned)(Rb * K + C) * 2u; }
    const size_t kstep = (size_t)(BK * 2);
    const size_t hstep = (size_t)HALF * K * 2;
    const size_t tstep = 2 * hstep;
    const unsigned ldsw = (unsigned)wid * 1024u;
    const int aoff = lds_byte(wr * 64 + fr, fq * 8), boff = lds_byte(wc * 32 + fr, fq * 8);
#define PG8_SA(b, h) (((b) * 2 + (h)) * HTB)
#define PG8_SB(b, h) ((4 + (b) * 2 + (h)) * HTB)
#define PG8_STAGE(bufoff, gbase, voff) do { _Pragma("unroll") for (int _i = 0; _i < 2; ++_i) \
        __builtin_amdgcn_global_load_lds((const unsigned*)((const char*)(gbase) + (voff)[_i]), (PG8_LAS unsigned*)(lds + (bufoff) + ldsw + _i * 8192), 16, 0, 0); } while (0)
#define PG8_LDA(dst, b, h) do { _Pragma("unroll") for (int m = 0; m < 4; ++m) _Pragma("unroll") for (int k = 0; k < 2; ++k) dst[m][k] = *(const PG8_LAS bf16x8*)(lds + PG8_SA(b, h) + aoff + m * 2048 + k * 1024); } while (0)
#define PG8_LDB(dst, b, h) do { _Pragma("unroll") for (int n = 0; n < 2; ++n) _Pragma("unroll") for (int k = 0; k < 2; ++k) dst[n][k] = *(const PG8_LAS bf16x8*)(lds + PG8_SB(b, h) + boff + n * 2048 + k * 1024); } while (0)
#define PG8_MMA(ai, bj, At, Bt) do { __builtin_amdgcn_s_setprio(1); _Pragma("unroll") for (int m = 0; m < 4; ++m) _Pragma("unroll") for (int n = 0; n < 2; ++n) _Pragma("unroll") for (int k = 0; k < 2; ++k) \
        acc[ai][bj][m][n] = __builtin_amdgcn_mfma_f32_16x16x32_bf16(Bt[n][k], At[m][k], acc[ai][bj][m][n], 0, 0, 0); __builtin_amdgcn_s_setprio(0); } while (0)
#define PG8_WAIT_V(n) asm volatile("s_waitcnt vmcnt(" #n ")" ::: "memory")
#define PG8_WAIT_L(n) asm volatile("s_waitcnt lgkmcnt(" #n ")" ::: "memory")
#define PG8_BAR __builtin_amdgcn_s_barrier()
#define PG8_SCHED __builtin_amdgcn_sched_barrier(0)
    Unit cur, nxt; int ui = 0;
    if (!S.next(0, cur)) return;
    f32x4 acc[2][2][4][2];
#pragma unroll
    for (int a = 0; a < 2; ++a)
#pragma unroll
        for (int b = 0; b < 2; ++b)
#pragma unroll
            for (int m = 0; m < 4; ++m)
#pragma unroll
                for (int n = 0; n < 2; ++n) acc[a][b][m][n] = (f32x4){0.f, 0.f, 0.f, 0.f};
    bf16x8 At[4][2], B0[2][2], B1[2][2];
    const char* cA = (const char*)g.A + (size_t)cur.pm * tstep; const char* cB = (const char*)g.Bt + (size_t)cur.pn * tstep;
    S.a_ready(cur);
    if constexpr (SP2) {
        PG8_STAGE(PG8_SB(0, 0), cB, voffB); PG8_STAGE(PG8_SB(0, 1), cB + hstep, voffB); PG8_STAGE(PG8_SA(0, 0), cA, voffA); PG8_STAGE(PG8_SA(0, 1), cA + hstep, voffA);
        if (wr == 1) PG8_BAR;
        PG8_WAIT_V(2); PG8_BAR;
        PG8_STAGE(PG8_SB(1, 0), cB + kstep, voffB); PG8_STAGE(PG8_SA(1, 0), cA + kstep, voffA); PG8_STAGE(PG8_SB(1, 1), cB + hstep + kstep, voffB);
        PG8_WAIT_V(6); PG8_BAR;
    } else {
        PG8_STAGE(PG8_SB(0, 0), cB, voffB); PG8_STAGE(PG8_SA(0, 0), cA, voffA); PG8_STAGE(PG8_SB(0, 1), cB + hstep, voffB); PG8_STAGE(PG8_SA(0, 1), cA + hstep, voffA);
        if (wr == 1) PG8_BAR;
        PG8_WAIT_V(4); PG8_BAR;
        PG8_STAGE(PG8_SB(1, 0), cB + kstep, voffB); PG8_STAGE(PG8_SA(1, 0), cA + kstep, voffA); PG8_STAGE(PG8_SB(1, 1), cB + hstep + kstep, voffB);
        PG8_WAIT_V(6); PG8_BAR;
    }
    for (;;) {
        const bool has_next = S.next(ui + 1, nxt);
        const char* nA = has_next ? (const char*)g.A + (size_t)nxt.pm * tstep : cA; const char* nB = has_next ? (const char*)g.Bt + (size_t)nxt.pn * tstep : cB;
        for (int t = 0; t < nt; t += 2) {
            const bool last = (t == nt - 2);
            const char* a1 = cA + (size_t)(t + 1) * kstep;
            const char* a2 = last ? nA : cA + (size_t)(t + 2) * kstep; const char* b2 = last ? nB : cB + (size_t)(t + 2) * kstep;
            const char* a3 = a2 + kstep; const char* b3 = b2 + kstep;
            if (last && has_next) S.a_ready(nxt);
            if constexpr (SP2) {
            PG8_LDB(B0, 0, 0); PG8_LDB(B1, 0, 1); PG8_SCHED; PG8_LDA(At, 0, 0); PG8_STAGE(PG8_SA(1, 1), a1 + hstep, voffA);
            PG8_WAIT_V(8); PG8_WAIT_L(0); PG8_BAR; PG8_MMA(0, 0, At, B0); PG8_MMA(0, 1, At, B1); PG8_BAR; PG8_SCHED;
            PG8_LDA(At, 0, 1); PG8_STAGE(PG8_SB(0, 0), b2, voffB); PG8_STAGE(PG8_SB(0, 1), b2 + hstep, voffB); PG8_STAGE(PG8_SA(0, 0), a2, voffA);
            PG8_WAIT_V(8); PG8_WAIT_L(0); PG8_BAR; PG8_MMA(1, 0, At, B0); PG8_MMA(1, 1, At, B1); PG8_BAR; PG8_SCHED;
            PG8_LDB(B0, 1, 0); PG8_LDB(B1, 1, 1); PG8_SCHED; PG8_LDA(At, 1, 0); PG8_STAGE(PG8_SA(0, 1), a2 + hstep, voffA);
            PG8_WAIT_V(8); PG8_WAIT_L(0); PG8_BAR; PG8_MMA(0, 0, At, B0); PG8_MMA(0, 1, At, B1); PG8_BAR; PG8_SCHED;
            PG8_LDA(At, 1, 1); PG8_STAGE(PG8_SB(1, 0), b3, voffB); PG8_STAGE(PG8_SB(1, 1), b3 + hstep, voffB); PG8_STAGE(PG8_SA(1, 0), a3, voffA);
            PG8_WAIT_V(8); PG8_WAIT_L(0); PG8_BAR; PG8_MMA(1, 0, At, B0); PG8_MMA(1, 1, At, B1); PG8_BAR; PG8_SCHED;
            } else {
            PG8_LDB(B0, 0, 0); PG8_SCHED; PG8_LDA(At, 0, 0); PG8_STAGE(PG8_SA(1, 1), a1 + hstep, voffA);
            PG8_WAIT_L(8); PG8_BAR; PG8_WAIT_L(0); PG8_MMA(0, 0, At, B0); PG8_BAR; PG8_SCHED;
            PG8_LDB(B1, 0, 1); PG8_STAGE(PG8_SB(0, 0), b2, voffB);
            PG8_BAR; PG8_WAIT_L(0); PG8_MMA(0, 1, At, B1); PG8_BAR;
            PG8_LDA(At, 0, 1); PG8_STAGE(PG8_SA(0, 0), a2, voffA);
            PG8_BAR; PG8_WAIT_L(0); PG8_MMA(1, 0, At, B0); PG8_BAR; PG8_SCHED;
            PG8_STAGE(PG8_SB(0, 1), b2 + hstep, voffB);
            PG8_WAIT_V(6); PG8_BAR; PG8_MMA(1, 1, At, B1); PG8_BAR;
            PG8_LDB(B0, 1, 0); PG8_SCHED; PG8_LDA(At, 1, 0); PG8_STAGE(PG8_SA(0, 1), a2 + hstep, voffA);
            PG8_WAIT_L(8); PG8_BAR; PG8_WAIT_L(0); PG8_MMA(0, 0, At, B0); PG8_BAR; PG8_SCHED;
            PG8_LDB(B1, 1, 1); PG8_STAGE(PG8_SB(1, 0), b3, voffB);
            PG8_BAR; PG8_WAIT_L(0); PG8_MMA(0, 1, At, B1); PG8_BAR;
            PG8_LDA(At, 1, 1); PG8_STAGE(PG8_SA(1, 0), a3, voffA);
            PG8_BAR; PG8_WAIT_L(0); PG8_MMA(1, 0, At, B0); PG8_BAR; PG8_SCHED;
            PG8_STAGE(PG8_SB(1, 1), b3 + hstep, voffB);
            PG8_WAIT_V(6); PG8_BAR; PG8_MMA(1, 1, At, B1); PG8_BAR;
            }
        }
        if constexpr (ALIGN_EPI) { if (wr == 0) PG8_BAR; }
        if constexpr (!Epi::AFTER_DRAIN) { E(acc, cur, wr, wc, fr, fq); S.done(cur); }
        if (!has_next) break;
#pragma unroll
        for (int a = 0; a < 2; ++a)
#pragma unroll
            for (int b = 0; b < 2; ++b)
#pragma unroll
                for (int m = 0; m < 4; ++m)
#pragma unroll
                    for (int n = 0; n < 2; ++n) acc[a][b][m][n] = (f32x4){0.f, 0.f, 0.f, 0.f};
        cur = nxt; cA = nA; cB = nB; ++ui;
        if constexpr (ALIGN_EPI) { if (wr == 1) PG8_BAR; }
    }
    PG8_WAIT_V(0);
    if constexpr (!ALIGN_EPI) { if (wr == 0) PG8_BAR; }
    PG8_BAR;
    if constexpr (Epi::AFTER_DRAIN) { E.fused(acc, cur, wr, wc, fr, fq, lds, wid, lane); S.done(cur); }
#undef PG8_SA
#undef PG8_SB
#undef PG8_STAGE
#undef PG8_LDA
#undef PG8_LDB
#undef PG8_MMA
#undef PG8_WAIT_V
#undef PG8_WAIT_L
#undef PG8_BAR
#undef PG8_SCHED
}
}


using pg8::bf16_t; using pg8::f32x4; using pg8::u32x4; using pg8::Unit; using pg8::cvt_pk_bf16;
#define LAS __attribute__((address_space(3)))

constexpr int D = 2048, NB = 8, TL = 2048, TC = 256, MLAT = NB * TL  , MCTX = NB * TC  , MALL = MLAT + MCTX  ;
constexpr int N1 = 6656, N2 = 5120, LD1 = N1, LD2 = N2, FFH = 5632, NADA = 6 * D;
constexpr int COL_CV = 3520, COL_AB = 6592;
constexpr int LDS_BYTES = 147456;
constexpr size_t MiB = 1048576;
constexpr size_t WS_A = 0;
constexpr size_t WS_B = WS_A + 46 * MiB;
constexpr size_t WS_X = WS_B + 16 * MiB;
constexpr size_t WS_D = WS_X + 234 * MiB;
constexpr size_t WS_F = WS_D + 160 * MiB;
constexpr size_t WS_M = WS_F + 32 * MiB;
constexpr size_t WS_END = WS_M + 3 * MiB;

struct Params { const float* in[30]; float* out; unsigned char* ws; int ph_lo, ph_hi, coop, pad; };

__device__ __forceinline__ float bf2f(bf16_t b) { return __uint_as_float(((unsigned)b) << 16); }
typedef __bf16 bf16x2_t __attribute__((ext_vector_type(2)));
typedef float f32x2_t __attribute__((ext_vector_type(2)));
__device__ __forceinline__ unsigned pk2(float lo, float hi) { const f32x2_t v = {lo, hi}; return __builtin_bit_cast(unsigned, __builtin_convertvector(v, bf16x2_t)); }
__device__ __forceinline__ bf16_t f2bf(float f) { return (bf16_t)(pk2(f, 0.f) & 0xffffu); }
__device__ __forceinline__ float sigm(float x) { return __builtin_amdgcn_rcpf(1.f + __expf(-x)); }
__device__ __forceinline__ float tanh_fast(float x) { return 1.f - 2.f * __builtin_amdgcn_rcpf(1.f + __expf(2.f * x)); }
__device__ __forceinline__ float wave_sum(float v) {
#pragma unroll
    for (int o = 1; o < 64; o <<= 1) v += __shfl_xor(v, o);
    return v;
}
template <int CTRL> __device__ __forceinline__ float dppf(float x) { return __int_as_float(__builtin_amdgcn_update_dpp(0, __float_as_int(x), CTRL, 0xF, 0xF, true)); }
__device__ __forceinline__ float red8(float x) { x += dppf<0x141>(x); x += dppf<0xB1>(x); x += dppf<0x4E>(x); return x; }

struct EpiBf16Plain {
    static constexpr bool PERM = true, AFTER_DRAIN = false;
    bf16_t* O; int ldc;
    __device__ __forceinline__ void operator()(const f32x4 (&acc)[2][2][4][2], const Unit& u, int wr, int wc, int fr, int fq) const {
        const int row0 = u.pm * 256 + wr * 64 + fr, col0 = u.pn * 256 + wc * 32 + 8 * fq;
#pragma unroll
        for (int ai = 0; ai < 2; ++ai)
#pragma unroll
            for (int m = 0; m < 4; ++m) { bf16_t* rowp = O + (size_t)(row0 + ai * 128 + m * 16) * ldc + col0;
#pragma unroll
                for (int bj = 0; bj < 2; ++bj) { const f32x4 v0 = acc[ai][bj][m][0], v1 = acc[ai][bj][m][1];
                    u32x4 w; w.x = pk2(v0[0], v0[1]); w.y = pk2(v0[2], v0[3]); w.z = pk2(v1[0], v1[1]); w.w = pk2(v1[2], v1[3]);
                    *(u32x4*)(rowp + bj * 128) = w; } }
    }
};
template <bool SECOND> struct EpiGate {
    static constexpr bool PERM = true, AFTER_DRAIN = false;
    bf16_t* Mo; const bf16_t* G;
    __device__ __forceinline__ void operator()(const f32x4 (&acc)[2][2][4][2], const Unit& u, int wr, int wc, int fr, int fq) const {
        const int row0 = u.pm * 256 + wr * 64 + fr, col0 = u.pn * 256 + wc * 32 + 8 * fq;
#pragma unroll
        for (int ai = 0; ai < 2; ++ai)
#pragma unroll
            for (int m = 0; m < 4; ++m) { const size_t row = (size_t)(row0 + ai * 128 + m * 16);
#pragma unroll
                for (int bj = 0; bj < 2; ++bj) { const f32x4 v0 = acc[ai][bj][m][0], v1 = acc[ai][bj][m][1];
                    const int col = col0 + bj * 128;
                    const u32x4 g = *(const u32x4*)(G + row * LD2 + col);
                    float r[8];
                    r[0] = sigm(__uint_as_float(g.x << 16)) * v0[0]; r[1] = sigm(__uint_as_float(g.x & 0xffff0000u)) * v0[1];
                    r[2] = sigm(__uint_as_float(g.y << 16)) * v0[2]; r[3] = sigm(__uint_as_float(g.y & 0xffff0000u)) * v0[3];
                    r[4] = sigm(__uint_as_float(g.z << 16)) * v1[0]; r[5] = sigm(__uint_as_float(g.z & 0xffff0000u)) * v1[1];
                    r[6] = sigm(__uint_as_float(g.w << 16)) * v1[2]; r[7] = sigm(__uint_as_float(g.w & 0xffff0000u)) * v1[3];
                    u32x4* op = (u32x4*)(Mo + row * D + col);
                    if (SECOND) { const u32x4 o = *op;
                        r[0] += __uint_as_float(o.x << 16); r[1] += __uint_as_float(o.x & 0xffff0000u); r[2] += __uint_as_float(o.y << 16); r[3] += __uint_as_float(o.y & 0xffff0000u);
                        r[4] += __uint_as_float(o.z << 16); r[5] += __uint_as_float(o.z & 0xffff0000u); r[6] += __uint_as_float(o.w << 16); r[7] += __uint_as_float(o.w & 0xffff0000u); }
                    u32x4 w; w.x = pk2(r[0], r[1]); w.y = pk2(r[2], r[3]); w.z = pk2(r[4], r[5]); w.w = pk2(r[6], r[7]);
                    *op = w; } }
    }
};
struct EpiRes {
    static constexpr bool PERM = false, AFTER_DRAIN = false;
    float* out; const float* res; const float* gt;
    __device__ __forceinline__ void operator()(const f32x4 (&acc)[2][2][4][2], const Unit& u, int wr, int wc, int fr, int fq) const {
        const int row0 = u.pm * 256 + wr * 64 + fr, col0 = u.pn * 256 + wc * 32 + 4 * fq;
        const float* gtb = gt + (size_t)((u.pm * 256) >> 11) * NADA + col0;
        f32x4 gv[2][2];
#pragma unroll
        for (int bj = 0; bj < 2; ++bj)
#pragma unroll
            for (int n = 0; n < 2; ++n) gv[bj][n] = *(const f32x4*)(gtb + bj * 128 + n * 16);
#pragma unroll
        for (int ai = 0; ai < 2; ++ai)
#pragma unroll
            for (int m = 0; m < 4; ++m) { const size_t ro = (size_t)(row0 + ai * 128 + m * 16) * D + col0;
#pragma unroll
                for (int bj = 0; bj < 2; ++bj)
#pragma unroll
                    for (int n = 0; n < 2; ++n) { const f32x4 rv = *(const f32x4*)(res + ro + bj * 128 + n * 16);
                        *(f32x4*)(out + ro + bj * 128 + n * 16) = rv + gv[bj][n] * acc[ai][bj][m][n]; } }
    }
};
struct EpiSwiglu {
    static constexpr bool PERM = true, AFTER_DRAIN = false;
    bf16_t* O;
    __device__ __forceinline__ void operator()(const f32x4 (&acc)[2][2][4][2], const Unit& u, int wr, int wc, int fr, int fq) const {
        const int row0 = u.pm * 256 + wr * 64 + fr, col0 = u.pn * 128 + wc * 32 + 8 * fq;
#pragma unroll
        for (int ai = 0; ai < 2; ++ai)
#pragma unroll
            for (int m = 0; m < 4; ++m) { bf16_t* rowp = O + (size_t)(row0 + ai * 128 + m * 16) * FFH + col0;
                float r[8];
#pragma unroll
                for (int n = 0; n < 2; ++n)
#pragma unroll
                    for (int e = 0; e < 4; ++e) { const float g = acc[ai][0][m][n][e], up = acc[ai][1][m][n][e]; r[4 * n + e] = g * sigm(g) * up; }
                u32x4 w; w.x = pk2(r[0], r[1]); w.y = pk2(r[2], r[3]); w.z = pk2(r[4], r[5]); w.w = pk2(r[6], r[7]);
                *(u32x4*)rowp = w; }
    }
};

#ifndef GEMM_ALIGN_EPI
#define GEMM_ALIGN_EPI true
#endif
#ifndef GEMM_SP2
#define GEMM_SP2 true
#endif
template <class Epi> __device__ __forceinline__ void run_gemm(unsigned char* smem, const bf16_t* A, const bf16_t* Bt, int M, int N, int K, const Epi& E) {
    pg8::Gemm g; g.A = A; g.Bt = Bt; g.M = M; g.N = N; g.K = K;
    pg8::StaticOrder S; S.init(M, N, (int)gridDim.x, (int)blockIdx.x);
    pg8::gemm_phase<Epi, pg8::StaticOrder, GEMM_ALIGN_EPI, GEMM_SP2>((PG8_LAS unsigned char*)smem, g, S, E);
    __syncthreads();
}

__device__ __forceinline__ void transpose_item(const float* W, int K, int N, bf16_t* WT, int dst_row0, int src_col0, float* scr, int k0, int lane) {
    if (src_col0 >= 0) {
#pragma unroll 8
        for (int i = 0; i < 32; ++i) { const int kk = 2 * i + (lane >> 5); scr[kk * 33 + (lane & 31)] = W[(size_t)(k0 + kk) * N + src_col0 + (lane & 31)]; }
    } else {
#pragma unroll 8
        for (int i = 0; i < 32; ++i) { const int kk = 2 * i + (lane >> 5); scr[kk * 33 + (lane & 31)] = 0.f; }
    }
    asm volatile("s_waitcnt lgkmcnt(0)" ::: "memory");
    const int c = lane & 7;
#pragma unroll
    for (int j = 0; j < 4; ++j) { const int n = (lane >> 3) + 8 * j; const float* s = scr + (8 * c) * 33 + n;
        u32x4 o; o.x = pk2(s[0], s[33]); o.y = pk2(s[2 * 33], s[3 * 33]); o.z = pk2(s[4 * 33], s[5 * 33]); o.w = pk2(s[6 * 33], s[7 * 33]);
        *(u32x4*)(WT + (size_t)(dst_row0 + n) * K + k0 + 8 * c) = o; }
    asm volatile("s_waitcnt lgkmcnt(0)" ::: "memory");
}
__device__ __forceinline__ int win_src_col(int n0) {
    if (n0 < 6592) return n0;
    if (n0 < 6624) return 7616 + (n0 - 6592);
    if (n0 < 6656) return -1;
    const int j = n0 - 6656;
    return j < 1024 ? 6592 + j : 7648 + (j - 1024);
}

__device__ __forceinline__ void phase_prep(const Params& P, unsigned char* smem) {
    const int tid = threadIdx.x, lane = tid & 63, wave = tid >> 6;
    float* MOD = (float*)(P.ws + WS_M);
    if ((int)blockIdx.x < 192) {
        float* sT = (float*)smem;
        float* red = (float*)(smem + 98304);
        const float* c = P.in[1]; const float* cc = P.in[3];
        for (int idx = tid; idx < 9 * D; idx += 512) { const int m = idx >> 11, k = idx & 2047; const float v = m < 8 ? c[m * D + k] : cc[k]; sT[k * 12 + m] = v * sigm(v); }
        __syncthreads();
        const float* W = P.in[4]; const float* bias = P.in[5];
        for (int item = blockIdx.x; item < 192; item += gridDim.x) {
            const int n0 = item * 64, cl = tid & 15, kl = tid >> 4;
            float acc[9][4];
#pragma unroll
            for (int m = 0; m < 9; ++m)
#pragma unroll
                for (int e = 0; e < 4; ++e) acc[m][e] = 0.f;
#pragma unroll 4
            for (int kk = 0; kk < 64; ++kk) { const int k = kk * 32 + kl;
                const f32x4 w = *(const f32x4*)(W + (size_t)k * NADA + n0 + 4 * cl);
                const f32x4 s0 = *(const f32x4*)(sT + k * 12), s1 = *(const f32x4*)(sT + k * 12 + 4); const float s2 = sT[k * 12 + 8];
#pragma unroll
                for (int e = 0; e < 4; ++e) { acc[0][e] += s0[0] * w[e]; acc[1][e] += s0[1] * w[e]; acc[2][e] += s0[2] * w[e]; acc[3][e] += s0[3] * w[e];
                    acc[4][e] += s1[0] * w[e]; acc[5][e] += s1[1] * w[e]; acc[6][e] += s1[2] * w[e]; acc[7][e] += s1[3] * w[e]; acc[8][e] += s2 * w[e]; } }
#pragma unroll
            for (int m = 0; m < 9; ++m)
#pragma unroll
                for (int e = 0; e < 4; ++e) { float v = acc[m][e]; v += __shfl_xor(v, 16); v += __shfl_xor(v, 32); if ((lane >> 4) == 0) red[(wave * 9 + m) * 64 + 4 * cl + e] = v; }
            __syncthreads();
            for (int o = tid; o < 576; o += 512) { const int m = o >> 6, c2 = o & 63; float s = bias[n0 + c2];
#pragma unroll
                for (int w8 = 0; w8 < 8; ++w8) s += red[(w8 * 9 + m) * 64 + c2];
                MOD[m * NADA + n0 + c2] = s; }
            __syncthreads();
        }
    }
    __syncthreads();
    { bf16_t* G2T = (bf16_t*)(P.ws + WS_M + MiB / 2); const float* g2 = P.in[13];
      for (int s = blockIdx.x * 512 + tid; s < 1024 * 32; s += gridDim.x * 512) { const int n = s >> 5, k8 = s & 31; u32x4 w = {0u, 0u, 0u, 0u};
          if (k8 < 8) { const float* gp = g2 + (size_t)(8 * k8) * 1024 + n; w.x = pk2(gp[0], gp[1024]); w.y = pk2(gp[2048], gp[3072]); w.z = pk2(gp[4096], gp[5120]); w.w = pk2(gp[6144], gp[7168]); }
          *(u32x4*)(G2T + (size_t)n * 256 + 8 * k8) = w; } }
    float* scr = (float*)(smem + wave * 8448);
    const int gw = blockIdx.x * 8 + wave, NGW = gridDim.x * 8;
    bf16_t* WT_IN = (bf16_t*)(P.ws + WS_A); bf16_t* WT_PA = (bf16_t*)(P.ws + WS_B); bf16_t* WT_PB = WT_PA + 2048 * 1024; bf16_t* WT_OUT = WT_PB + 2048 * 1024;
    constexpr int I_IN = 368 * 32, I_PA = 64 * 16, I_OUT = 64 * 32;
    for (int it = gw; it < I_IN + 2 * I_PA + I_OUT; it += NGW) {
        int r = it;
        if (r < I_IN) { const int nb = r % 368, kb = r / 368; transpose_item(P.in[7], 2048, 11744, WT_IN, nb * 32, win_src_col(nb * 32), scr, kb * 64, lane); continue; } r -= I_IN;
        if (r < I_PA) { const int nb = r % 64, kb = r / 64; transpose_item(P.in[23], 1024, 2048, WT_PA, nb * 32, nb * 32, scr, kb * 64, lane); continue; } r -= I_PA;
        if (r < I_PA) { const int nb = r % 64, kb = r / 64; transpose_item(P.in[24], 1024, 2048, WT_PB, nb * 32, nb * 32, scr, kb * 64, lane); continue; } r -= I_PA;
        { const int nb = r % 64, kb = r / 64; transpose_item(P.in[25], 2048, 2048, WT_OUT, nb * 32, nb * 32, scr, kb * 64, lane); }
    }
}
__device__ __forceinline__ void phase_ffn_weights(const Params& P, unsigned char* smem) {
    const int tid = threadIdx.x, lane = tid & 63, wave = tid >> 6;
    float* scr = (float*)(smem + wave * 8448);
    const int gw = blockIdx.x * 8 + wave, NGW = gridDim.x * 8;
    bf16_t* WT_GU = (bf16_t*)(P.ws + WS_A); bf16_t* WT_DN = (bf16_t*)(P.ws + WS_F);
    constexpr int I_GU = 352 * 32, I_DN = 64 * 88;
    for (int it = gw; it < I_GU + I_DN; it += NGW) {
        int r = it;
        if (r < I_GU) { const int nb = r % 352, kb = r / 352; const int n0 = nb * 32, pn = n0 >> 8, cq = n0 & 255; const int src = cq < 128 ? 128 * pn + cq : FFH + 128 * pn + (cq - 128);
            transpose_item(P.in[27], 2048, 2 * FFH, WT_GU, n0, src, scr, kb * 64, lane); continue; } r -= I_GU;
        { const int nb = r % 64, kb = r / 64; transpose_item(P.in[28], FFH, 2048, WT_DN, nb * 32, nb * 32, scr, kb * 64, lane); }
    }
}

__device__ __forceinline__ void norm_mod_row(const float* src, const float* nw, const float* sh, const float* sc, bf16_t* dst, int lane) {
    f32x4 v[8]; float ss = 0.f;
#pragma unroll
    for (int j = 0; j < 8; ++j) { v[j] = *(const f32x4*)(src + (j * 64 + lane) * 4); ss += v[j][0] * v[j][0] + v[j][1] * v[j][1] + v[j][2] * v[j][2] + v[j][3] * v[j][3]; }
    const float rstd = rsqrtf(wave_sum(ss) * (1.f / D) + 1e-6f);
#pragma unroll
    for (int j = 0; j < 8; ++j) { const int c = (j * 64 + lane) * 4; const f32x4 w = *(const f32x4*)(nw + c), a = *(const f32x4*)(sh + c), b = *(const f32x4*)(sc + c);
        float o[4];
#pragma unroll
        for (int e = 0; e < 4; ++e) o[e] = (v[j][e] * rstd * w[e]) * (1.f + b[e]) + a[e];
        uint2 pk; pk.x = pk2(o[0], o[1]); pk.y = pk2(o[2], o[3]); *(uint2*)(dst + c) = pk; }
}
__device__ __forceinline__ void phase_norm1(const Params& P) {
    const int lane = threadIdx.x & 63, gw = blockIdx.x * 8 + (threadIdx.x >> 6), NGW = gridDim.x * 8;
    const float* MOD = (const float*)(P.ws + WS_M); bf16_t* H = (bf16_t*)P.out;
    for (int row = gw; row < MALL; row += NGW) {
        const float* src = row < MLAT ? P.in[0] + (size_t)row * D : P.in[2] + (size_t)(row - MLAT) * D;
        const int mr = row < MLAT ? (row >> 11) : 8;
        norm_mod_row(src, P.in[6], MOD + mr * NADA, MOD + mr * NADA + D, H + (size_t)row * D, lane);
    }
}
__device__ __forceinline__ void phase_norm2(const Params& P) {
    const int lane = threadIdx.x & 63, gw = blockIdx.x * 8 + (threadIdx.x >> 6), NGW = gridDim.x * 8;
    const float* MOD = (const float*)(P.ws + WS_M); bf16_t* H2 = (bf16_t*)(P.ws + WS_D);
    for (int row = gw; row < MLAT; row += NGW) { const int mr = row >> 11;
        norm_mod_row(P.out + (size_t)row * D, P.in[26], MOD + mr * NADA + 3 * D, MOD + mr * NADA + 4 * D, H2 + (size_t)row * D, lane); }
}
__device__ __forceinline__ void phase_final_norm(const Params& P) {
    const int lane = threadIdx.x & 63, gw = blockIdx.x * 8 + (threadIdx.x >> 6), NGW = gridDim.x * 8;
    const float* nw = P.in[29];
    for (int row = gw; row < MLAT; row += NGW) { float* src = P.out + (size_t)row * D;
        f32x4 v[8]; float ss = 0.f;
#pragma unroll
        for (int j = 0; j < 8; ++j) { v[j] = *(const f32x4*)(src + (j * 64 + lane) * 4); ss += v[j][0] * v[j][0] + v[j][1] * v[j][1] + v[j][2] * v[j][2] + v[j][3] * v[j][3]; }
        const float rstd = rsqrtf(wave_sum(ss) * (1.f / D) + 1e-6f);
#pragma unroll
        for (int j = 0; j < 8; ++j) { const int c = (j * 64 + lane) * 4; const f32x4 w = *(const f32x4*)(nw + c); *(f32x4*)(src + c) = v[j] * rstd * w; }
    }
}

__device__ __forceinline__ float mixed_load(const bf16_t* P1, int row, int t, bool isctx, int col, const float* mu) {
    const float p = bf2f(P1[(size_t)row * LD1 + col]);
    int nrow; bool valid;
    if (isctx) { if (col & 1) { valid = t < TC - 1; nrow = row + 1; } else { valid = t > 0; nrow = row - 1; } }
    else { const int m = col & 3, x = t & 63, y = t >> 6;
        if (m == 0) { valid = x > 0; nrow = row - 1; } else if (m == 1) { valid = x < 63; nrow = row + 1; }
        else if (m == 2) { valid = y > 0; nrow = row - 64; } else { valid = y < 31; nrow = row + 64; } }
    const float ps = valid ? bf2f(P1[(size_t)nrow * LD1 + col]) : 0.f;
    return p + (ps - p) * mu[col];
}


__device__ __forceinline__ void tri_inv_part1(const float* LM, bf16_t* TM, bf16_t* T11T, int blk, int lane) {
    constexpr int LDLc = 36, LDCc = 40;
    { const int c = lane & 15, o = 16 * blk; float t[16];
        const float* Lb = LM + o * LDLc + o;
#pragma unroll
        for (int i = 0; i < 16; ++i) { float a4[4] = {(i == c) ? 1.f : 0.f, 0.f, 0.f, 0.f};
#pragma unroll
            for (int j4 = 0; j4 < (i + 3) / 4; ++j4) { const f32x4 l = *(const f32x4*)(Lb + i * LDLc + 4 * j4);
#pragma unroll
                for (int x = 0; x < 4; ++x) if (4 * j4 + x < i) a4[x] -= l[x] * t[4 * j4 + x]; }
            t[i] = (a4[0] + a4[1]) + (a4[2] + a4[3]); }
        if (lane < 16) {
#pragma unroll
            for (int i = 0; i < 16; ++i) TM[(o + i) * LDCc + o + c] = f2bf(t[i]);
            if (blk == 0) { u32x4 w0, w1;
#pragma unroll
                for (int e = 0; e < 4; ++e) { w0[e] = pk2(t[2 * e], t[2 * e + 1]); w1[e] = pk2(t[8 + 2 * e], t[8 + 2 * e + 1]); }
                *(u32x4*)(T11T + c * 16) = w0; *(u32x4*)(T11T + c * 16 + 8) = w1; } }
        else if (lane < 32 && blk == 0) { const u32x4 zz = {0u, 0u, 0u, 0u}; *(u32x4*)(TM + c * LDCc + 16) = zz; *(u32x4*)(TM + c * LDCc + 24) = zz; } }
}
__device__ __forceinline__ void tri_inv_part2(const float* LM, bf16_t* TM, const bf16_t* T11T, bf16_t* XT, int lane) {
    constexpr int LDLc = 36, LDCc = 40;
    typedef short s16x8_ __attribute__((ext_vector_type(8)));
    const int fr = lane & 15, fq = lane >> 4;
    s16x8_ a = {0, 0, 0, 0, 0, 0, 0, 0}, b = {0, 0, 0, 0, 0, 0, 0, 0};
    if (fq < 2) { const f32x4 l0 = *(const f32x4*)(LM + (16 + fr) * LDLc + 8 * fq), l1 = *(const f32x4*)(LM + (16 + fr) * LDLc + 8 * fq + 4);
        u32x4 w; w.x = pk2(l0[0], l0[1]); w.y = pk2(l0[2], l0[3]); w.z = pk2(l1[0], l1[1]); w.w = pk2(l1[2], l1[3]);
        a = __builtin_bit_cast(s16x8_, w); b = *(const s16x8_*)(T11T + fr * 16 + 8 * fq); }
    const f32x4 X = __builtin_amdgcn_mfma_f32_16x16x32_bf16(a, b, ((f32x4){0.f, 0.f, 0.f, 0.f}), 0, 0, 0);
    { uint2 o; o.x = pk2(X[0], X[1]); o.y = pk2(X[2], X[3]); *(uint2*)(XT + fr * 16 + fq * 4) = o; }
    asm volatile("s_waitcnt lgkmcnt(0)" ::: "memory");
    s16x8_ a2 = {0, 0, 0, 0, 0, 0, 0, 0}, b2 = {0, 0, 0, 0, 0, 0, 0, 0};
    if (fq < 2) { a2 = *(const s16x8_*)(XT + fr * 16 + 8 * fq); b2 = *(const s16x8_*)(TM + (16 + fr) * LDCc + 16 + 8 * fq); }
    const f32x4 O = __builtin_amdgcn_mfma_f32_16x16x32_bf16(a2, b2, ((f32x4){0.f, 0.f, 0.f, 0.f}), 0, 0, 0);
    { uint2 o; o.x = pk2(-O[0], -O[1]); o.y = pk2(-O[2], -O[3]); *(uint2*)(TM + (16 + fr) * LDCc + fq * 4) = o; }
}
constexpr int CH = 32, NCHUNK = (TC + TL) / CH;
typedef short s16x8 __attribute__((ext_vector_type(8)));
__device__ __forceinline__ float red16(float x) { x += dppf<0x140>(x); x += dppf<0x141>(x); x += dppf<0xB1>(x); x += dppf<0x4E>(x); return x; }
#define TROW(r) ((r) * LDC + ((r) >> 3) * 8)
#define MFMA16(a, b, c) __builtin_amdgcn_mfma_f32_16x16x32_bf16((a), (b), (c), 0, 0, 0)

typedef short s16x4_t __attribute__((ext_vector_type(4)));
__device__ __forceinline__ __attribute__((ext_vector_type(8))) short tr_frag(const bf16_t* img, int rs, int c, int lane) {
    const int g = lane >> 4, q = (lane & 15) >> 2, p = lane & 3;
    const bf16_t* base = img + (8 * g + q) * rs + 16 * c + 4 * p;
    const s16x4_t lo = __builtin_amdgcn_ds_read_tr16_b64_v4i16((LAS s16x4_t*)base), hi = __builtin_amdgcn_ds_read_tr16_b64_v4i16((LAS s16x4_t*)(base + 4 * rs));
    return (__attribute__((ext_vector_type(8))) short){lo[0], lo[1], lo[2], lo[3], hi[0], hi[1], hi[2], hi[3]};
}
constexpr int L_WR = 0, L_KD = 8192, L_V = 16384, L_W = 24576, L_BB = 32768, L_KK = 40960, L_THW = 49152  , L_THA = 55296, L_SC = 61440  , L_PRM = 61952  ;
__device__ __forceinline__ void phase_rwkv(const Params& P, unsigned char* smem) {
    const int tid = threadIdx.x;
    const bf16_t* P1 = (const bf16_t*)(P.ws + WS_X);
    bf16_t* YD = (bf16_t*)P.out;
    float* SBON = (float*)(P.ws + WS_M + MiB);
    float* A_wr = (float*)(smem + L_WR); float* A_kd = (float*)(smem + L_KD); float* A_v = (float*)(smem + L_V); float* A_w = (float*)(smem + L_W);
    float* A_bb = (float*)(smem + L_BB); float* A_kk = (float*)(smem + L_KK); bf16_t* TH_w = (bf16_t*)(smem + L_THW); bf16_t* TH_a = (bf16_t*)(smem + L_THA); float* SC = (float*)(smem + L_SC);
    float* PRM = (float*)(smem + L_PRM);
    const float* mu = P.in[8];
    for (int it = blockIdx.x; it < 256; it += gridDim.x) {
        const int b = it >> 5, h = (it >> 1) & 15, d = it & 1;
        float S[8];
#pragma unroll
        for (int j = 0; j < 8; ++j) S[j] = 0.f;
        s16x8 Bw[3], Ba[3];
        __syncthreads();
        { const int lane = tid & 63, wave = tid >> 6; const int cB = h * 64 + 16 * (wave & 3) + (lane & 15);
#pragma unroll
          for (int ks = 0; ks < 3; ++ks)
#pragma unroll
            for (int j = 0; j < 8; ++j) { const int k = ks * 32 + (lane >> 4) * 8 + j;
                Bw[ks][j] = (short)f2bf(P.in[10][((size_t)d * 96 + k) * 1024 + cB]); Ba[ks][j] = (short)f2bf(P.in[12][((size_t)d * 96 + k) * 1024 + cB]); }
          if (tid < 64) { PRM[tid] = P.in[14][h * 64 + tid]; PRM[64 + tid] = P.in[15][h * 64 + tid]; PRM[128 + tid] = P.in[16][h * 64 + tid]; } }
        const float w0c = P.in[9][d * 1024 + h * 64 + 16 * ((tid >> 6) & 3) + (tid & 15)], a0c = P.in[11][d * 1024 + h * 64 + 16 * ((tid >> 6) & 3) + (tid & 15)];
        unsigned pre[3][12];
        auto prefetch = [&](int ch) {
            const bool isctx = ch < 8;
            const int sbase = isctx ? ch * CH : (ch - 8) * CH, Tlen = isctx ? TC : TL;
            const int rowbase = isctx ? MLAT + b * TC : b * TL;
            const int t0 = d == 0 ? sbase : Tlen - 1 - sbase, sgn = d == 0 ? 1 : -1;
            const u32x4 zz = {0u, 0u, 0u, 0u};
            int qv = tid; asm volatile("" : "+v"(qv));
#pragma unroll
            for (int n = 0; n < 3; ++n) { const int s = qv + 512 * n, i = s / 48, cv = s % 48; const int t = t0 + sgn * i;
                const int col = cv < 8 ? h * 64 + 8 * cv : (cv < 16 ? 1024 + h * 64 + 8 * (cv - 8) : (cv < 24 ? 2048 + h * 64 + 8 * (cv - 16) : (cv < 36 ? 3072 + d * 96 + 8 * (cv - 24) : 3264 + d * 96 + 8 * (cv - 36))));
                const bf16_t* pp = P1 + (size_t)(rowbase + t) * LD1 + col;
                { const u32x4 pv_ = *(const u32x4*)pp; pre[n][0] = pv_.x; pre[n][1] = pv_.y; pre[n][2] = pv_.z; pre[n][3] = pv_.w; }
                const unsigned* pw = (const unsigned*)pp; constexpr int LW = LD1 / 2;
                if (isctx) { const bool vl = t > 0, vr = t < TC - 1;
                    const u32x4 L = vl ? *(const u32x4*)(pp - LD1) : zz, R = vr ? *(const u32x4*)(pp + LD1) : zz;
                    pre[n][4] = L.x; pre[n][5] = L.y; pre[n][6] = L.z; pre[n][7] = L.w; pre[n][8] = R.x; pre[n][9] = R.y; pre[n][10] = R.z; pre[n][11] = R.w; }
                else { const int x = t & 63, y = t >> 6; const bool vl = x > 0, vr = x < 63, vu = y > 0, vd = y < 31;
                    pre[n][4] = vl ? pw[-LW + 0] : 0u; pre[n][5] = vl ? pw[-LW + 2] : 0u; pre[n][6] = vr ? pw[LW + 0] : 0u; pre[n][7] = vr ? pw[LW + 2] : 0u;
                    pre[n][8] = vu ? pw[-64 * LW + 1] : 0u; pre[n][9] = vu ? pw[-64 * LW + 3] : 0u; pre[n][10] = vd ? pw[64 * LW + 1] : 0u; pre[n][11] = vd ? pw[64 * LW + 3] : 0u; } }
        };
        prefetch(0);
        for (int ch = 0; ch < NCHUNK; ++ch) {
            int qo = tid; asm volatile("" : "+v"(qo));
            const int lane_o = qo & 63, wave_o = qo >> 6;
            const bool isctx = ch < 8;
            const int sbase = isctx ? ch * CH : (ch - 8) * CH, Tlen = isctx ? TC : TL;
            const int rowbase = isctx ? MLAT + b * TC : b * TL;
            const int t0 = d == 0 ? sbase : Tlen - 1 - sbase, sgn = d == 0 ? 1 : -1;
#pragma unroll
            for (int n = 0; n < 3; ++n) { const int s = qo + 512 * n, i = s / 48, cv = s % 48;
                const int col = cv < 8 ? h * 64 + 8 * cv : (cv < 16 ? 1024 + h * 64 + 8 * (cv - 8) : (cv < 24 ? 2048 + h * 64 + 8 * (cv - 16) : (cv < 36 ? 3072 + d * 96 + 8 * (cv - 24) : 3264 + d * 96 + 8 * (cv - 36))));
                const f32x4 m0 = *(const f32x4*)(mu + col), m1 = *(const f32x4*)(mu + col + 4);
                float xs[8];
#pragma unroll
                for (int e = 0; e < 8; ++e) { const float p = __uint_as_float((e & 1) ? (pre[n][e >> 1] & 0xffff0000u) : (pre[n][e >> 1] << 16));
                    unsigned wv_; const bool hi = (e & 1);
                    if (isctx) wv_ = (e & 1) ? pre[n][8 + (e >> 1)] : pre[n][4 + (e >> 1)];
                    else wv_ = pre[n][4 + 2 * (e & 3) + (e >> 2)];
                    const float ps = __uint_as_float(hi ? (wv_ & 0xffff0000u) : (wv_ << 16));
                    xs[e] = p + (ps - p) * (e < 4 ? m0[e & 3] : m1[e & 3]); }
                if (cv < 24) { float* dst = (cv < 8 ? A_wr + i * 64 + 8 * cv : (cv < 16 ? A_kd + i * 64 + 8 * (cv - 8) : A_v + i * 64 + 8 * (cv - 16)));
                    *(f32x4*)dst = (f32x4){xs[0], xs[1], xs[2], xs[3]}; *(f32x4*)(dst + 4) = (f32x4){xs[4], xs[5], xs[6], xs[7]}; }
                else if (cv < 36) { u32x4 w; w.x = pk2(tanhf(xs[0]), tanhf(xs[1])); w.y = pk2(tanhf(xs[2]), tanhf(xs[3])); w.z = pk2(tanhf(xs[4]), tanhf(xs[5])); w.w = pk2(tanhf(xs[6]), tanhf(xs[7]));
                    *(u32x4*)(TH_w + i * 96 + 8 * (cv - 24)) = w; }
                else { u32x4 w; w.x = pk2(xs[0], xs[1]); w.y = pk2(xs[2], xs[3]); w.z = pk2(xs[4], xs[5]); w.w = pk2(xs[6], xs[7]);
                    *(u32x4*)(TH_a + i * 96 + 8 * (cv - 36)) = w; } }
            __syncthreads();
            { const int rt = wave_o >> 2, c = 16 * (wave_o & 3) + (lane_o & 15);
              f32x4 cw = {0.f, 0.f, 0.f, 0.f}, ca = {0.f, 0.f, 0.f, 0.f};
#pragma unroll
              for (int ks = 0; ks < 3; ++ks) { const int off = (rt * 16 + (lane_o & 15)) * 96 + ks * 32 + (lane_o >> 4) * 8;
                  const s16x8 fa = *(const s16x8*)(TH_w + off), fb = *(const s16x8*)(TH_a + off);
                  cw = MFMA16(fa, Bw[ks], cw); ca = MFMA16(fb, Ba[ks], ca); }
#pragma unroll
              for (int j = 0; j < 4; ++j) { const int i = rt * 16 + (lane_o >> 4) * 4 + j;
                  A_w[i * 64 + c] = __expf(-0.6065306597126334f * sigm(w0c + cw[j])); A_bb[i * 64 + c] = sigm(a0c + ca[j]); } }
            __syncthreads();
            if (qo < 256) {
                const int i = qo >> 3, cgp = qo & 7, j0 = 8 * cgp; float xr[8], xk[8], w[8], ic[8], kkw[8], kaw[8], rkw[8];
#pragma unroll
                for (int e = 0; e < 2; ++e) { const f32x4 a = *(const f32x4*)(A_wr + i * 64 + j0 + 4 * e), b2 = *(const f32x4*)(A_kd + i * 64 + j0 + 4 * e), c2 = *(const f32x4*)(A_w + i * 64 + j0 + 4 * e),
                        d2 = *(const f32x4*)(A_bb + i * 64 + j0 + 4 * e), e2 = *(const f32x4*)(PRM + j0 + 4 * e), f2 = *(const f32x4*)(PRM + 64 + j0 + 4 * e), g2 = *(const f32x4*)(PRM + 128 + j0 + 4 * e);
#pragma unroll
                    for (int x = 0; x < 4; ++x) { xr[4 * e + x] = a[x]; xk[4 * e + x] = b2[x]; w[4 * e + x] = c2[x]; ic[4 * e + x] = d2[x]; kkw[4 * e + x] = e2[x]; kaw[4 * e + x] = f2[x]; rkw[4 * e + x] = g2[x]; } }
                float ss = 0.f;
#pragma unroll
                for (int e = 0; e < 8; ++e) { const float kr_ = xk[e] * kkw[e]; ss += kr_ * kr_; }
                ss = red8(ss); const float rn = rsqrtf(ss + 1e-6f);
                float kk[8], kd[8], bb[8], br = 0.f, kr = 0.f, sb = 0.f;
#pragma unroll
                for (int e = 0; e < 8; ++e) { kk[e] = xk[e] * kkw[e] * rn; kd[e] = xk[e] * (1.f + (ic[e] - 1.f) * kaw[e]); bb[e] = kk[e] * ic[e];
                    br += bb[e] * xr[e]; kr += kd[e] * xr[e]; sb += xr[e] * kd[e] * rkw[e]; }
                br = red8(br); kr = red8(kr); sb = 0.5f * red8(sb);
#pragma unroll
                for (int e = 0; e < 2; ++e) {
                    *(f32x4*)(A_kk + i * 64 + j0 + 4 * e) = (f32x4){kk[4 * e], kk[4 * e + 1], kk[4 * e + 2], kk[4 * e + 3]};
                    *(f32x4*)(A_wr + i * 64 + j0 + 4 * e) = (f32x4){w[4 * e] * xr[4 * e], w[4 * e + 1] * xr[4 * e + 1], w[4 * e + 2] * xr[4 * e + 2], w[4 * e + 3] * xr[4 * e + 3]};
                    *(f32x4*)(A_kd + i * 64 + j0 + 4 * e) = (f32x4){kd[4 * e], kd[4 * e + 1], kd[4 * e + 2], kd[4 * e + 3]};
                    *(f32x4*)(A_bb + i * 64 + j0 + 4 * e) = (f32x4){bb[4 * e], bb[4 * e + 1], bb[4 * e + 2], bb[4 * e + 3]}; }
                if (cgp == 0) { SC[i * 4 + 0] = br; SC[i * 4 + 1] = kr; if (!isctx) SBON[((size_t)d * MLAT + rowbase + t0 + sgn * i) * 16 + h] = sb; }
            }
            __syncthreads();
            if (ch + 1 < NCHUNK) prefetch(ch + 1);
            { const int cgp = qo & 7, row = qo >> 3, j0 = 8 * cgp;
              bf16_t* yp = YD + ((size_t)d * MLAT + rowbase + t0) * 1024 + h * 64 + row;
              for (int i = 0; i < CH; ++i) {
                  float kk8[8], wr8[8], w8[8], bb8[8], kd8[8];
#pragma unroll
                  for (int e = 0; e < 2; ++e) { const f32x4 a = *(const f32x4*)(A_kk + i * 64 + j0 + 4 * e), b2 = *(const f32x4*)(A_wr + i * 64 + j0 + 4 * e), c2 = *(const f32x4*)(A_w + i * 64 + j0 + 4 * e),
                          d2 = *(const f32x4*)(A_bb + i * 64 + j0 + 4 * e), e2 = *(const f32x4*)(A_kd + i * 64 + j0 + 4 * e);
#pragma unroll
                      for (int x = 0; x < 4; ++x) { kk8[4 * e + x] = a[x]; wr8[4 * e + x] = b2[x]; w8[4 * e + x] = c2[x]; bb8[4 * e + x] = d2[x]; kd8[4 * e + x] = e2[x]; } }
                  const float v = A_v[i * 64 + row]; const float2 sc = *(const float2*)(SC + i * 4);
                  float sa = 0.f, pp = 0.f;
#pragma unroll
                  for (int j = 0; j < 8; ++j) { sa += S[j] * kk8[j]; pp += S[j] * wr8[j]; }
                  sa = red8(sa); pp = red8(pp);
                  const float y = pp - sa * sc.x + v * sc.y;
#pragma unroll
                  for (int j = 0; j < 8; ++j) S[j] = S[j] * w8[j] - sa * bb8[j] + v * kd8[j];
                  if (!isctx && cgp == 0) yp[(ptrdiff_t)sgn * i * 1024] = f2bf(y);
              } }
            __syncthreads();
        }
    }
}

constexpr int LDK = 136, LDC = 40, LDL = 36;
constexpr int G_RAW = 0, G_CW = 23040, G_SC = 29440, G_UQ = 29952, G_WK = 29952, G_VNT = 38656, G_UK = 46336, G_TM = 46336, G_QKM = 48896, G_LM = 51456, G_UV = 62720,
              G_KA = 70912, G_QA = 79616, G_QD = 88320, G_KGT = 97024, G_KTT = 107520, G_VT = 118016, G_ST = 123264, G_GC = 140672, G_T11T = 140928, G_XT = 141440;
__device__ __forceinline__ void phase_gdn(const Params& P, unsigned char* smem) {
    const int tid = threadIdx.x;
    const bf16_t* P1 = (const bf16_t*)(P.ws + WS_X);
    bf16_t* OD = (bf16_t*)P.out + (size_t)2 * MLAT * 1024;
    bf16_t* RAW = (bf16_t*)(smem + G_RAW); float* CW = (float*)(smem + G_CW); float* GSC = (float*)(smem + G_SC); float* UQ = (float*)(smem + G_UQ); float* UK = (float*)(smem + G_UK); float* UV = (float*)(smem + G_UV);
    bf16_t* WK = (bf16_t*)(smem + G_WK); bf16_t* VNT = (bf16_t*)(smem + G_VNT); bf16_t* TM = (bf16_t*)(smem + G_TM); bf16_t* QKM = (bf16_t*)(smem + G_QKM); float* LM = (float*)(smem + G_LM);
    bf16_t* KA = (bf16_t*)(smem + G_KA); bf16_t* QA = (bf16_t*)(smem + G_QA); bf16_t* QD = (bf16_t*)(smem + G_QD); bf16_t* KGT = (bf16_t*)(smem + G_KGT); bf16_t* KTT = (bf16_t*)(smem + G_KTT);
    bf16_t* VT = (bf16_t*)(smem + G_VT); bf16_t* ST = (bf16_t*)(smem + G_ST); float* GC = (float*)(smem + G_GC);
    for (int blk_ = blockIdx.x; blk_ < 256; blk_ += gridDim.x) { const int it = ((blk_ & 7) << 5) | (blk_ >> 3);
        const int b = it >> 5, hg = (it >> 2) & 7, d = (it >> 1) & 1, half = it & 1;
        f32x4 sacc[4];
#pragma unroll
        for (int nt = 0; nt < 4; ++nt) sacc[nt] = (f32x4){0.f, 0.f, 0.f, 0.f};
        __syncthreads();
        float cwr[5][8];
        { const int cv = tid % 40; const int ccol = cv < 16 ? hg * 128 + 8 * cv : (cv < 32 ? 1024 + hg * 128 + 8 * (cv - 16) : 2048 + hg * 128 + half * 64 + 8 * (cv - 32));
#pragma unroll
          for (int j = 0; j < 5; ++j) { const f32x4 c0 = *(const f32x4*)(P.in[19] + j * 3072 + ccol), c1 = *(const f32x4*)(P.in[19] + j * 3072 + ccol + 4);
#pragma unroll
              for (int x = 0; x < 4; ++x) { cwr[j][x] = c0[x]; cwr[j][4 + x] = c1[x]; } } }
        for (int e = tid; e < 64 * LDK / 2; e += 512) ((unsigned*)ST)[e] = 0u;
        const float alog = -__expf(P.in[20][d * 8 + hg]), dtb = P.in[21][d * 8 + hg];
        unsigned pre[3][4]; unsigned pab = 0;
        auto prefetch = [&](int ch) {
            const bool isctx = ch < 8;
            const int sbase = isctx ? ch * CH : (ch - 8) * CH, Tlen = isctx ? TC : TL;
            const int rowbase = isctx ? MLAT + b * TC : b * TL;
            const int t0 = d == 0 ? sbase : Tlen - 1 - sbase, sgn = d == 0 ? 1 : -1;
            const int lo = d == 0 ? sbase : Tlen - sbase - CH;
            const u32x4 zz = {0u, 0u, 0u, 0u};
            int qv = tid; asm volatile("" : "+v"(qv));
#pragma unroll
            for (int n = 0; n < 3; ++n) { const int s = qv + 512 * n, wt = s / 40, cv = s % 40; const int t = lo - 2 + wt;
                const int col = COL_CV + (cv < 16 ? hg * 128 + 8 * cv : (cv < 32 ? 1024 + hg * 128 + 8 * (cv - 16) : 2048 + hg * 128 + half * 64 + 8 * (cv - 32)));
                const u32x4 gv_ = (s < 1440 && t >= 0 && t < Tlen) ? *(const u32x4*)(P1 + (size_t)(rowbase + t) * LD1 + col) : zz; pre[n][0] = gv_.x; pre[n][1] = gv_.y; pre[n][2] = gv_.z; pre[n][3] = gv_.w; }
            if (qv < CH) { const int t = t0 + sgn * qv; const bf16_t* ro = P1 + (size_t)(rowbase + t) * LD1 + COL_AB;
                pab = (unsigned)ro[d * 8 + hg] | ((unsigned)ro[16 + d * 8 + hg] << 16); }
        };
        auto consumeA = [&]() {
            int qa = tid; asm volatile("" : "+v"(qa));
#pragma unroll
            for (int n = 0; n < 3; ++n) { const int s = qa + 512 * n; if (s < 1440) *(u32x4*)(RAW + s * 8) = (u32x4){pre[n][0], pre[n][1], pre[n][2], pre[n][3]}; }
            if (qa < CH) { const float a_raw = __uint_as_float(pab << 16), b_raw = __uint_as_float(pab & 0xffff0000u);
                const float xx = a_raw + dtb; const float sp = xx > 20.f ? xx : __logf(1.f + __expf(xx));
                GSC[qa * 4 + 0] = alog * sp; GSC[qa * 4 + 1] = sigm(b_raw); }
        };
        prefetch(0);
        consumeA();
        __syncthreads();
        for (int ch = 0; ch < NCHUNK; ++ch) {
            int qo = tid; asm volatile("" : "+v"(qo));
            const int lane = qo & 63, wave = qo >> 6, fr = lane & 15, fq = lane >> 4;
            const bool isctx = ch < 8;
            const int sbase = isctx ? ch * CH : (ch - 8) * CH, Tlen = isctx ? TC : TL;
            const int rowbase = isctx ? MLAT + b * TC : b * TL;
            const int t0 = d == 0 ? sbase : Tlen - 1 - sbase, sgn = d == 0 ? 1 : -1;
            if (ch + 1 < NCHUNK) prefetch(ch + 1);
            if (qo < 480) { const int cv = qo % 40, tg = qo / 40; const int ntok = tg < 8 ? 3 : 2, tok0 = tg < 8 ? 3 * tg : 24 + 2 * (tg - 8);
                u32x4 raw[7];
#pragma unroll
                for (int r = 0; r < 7; ++r) { const int rr = tok0 + r < 36 ? tok0 + r : 35; raw[r] = *(const u32x4*)(RAW + rr * 320 + 8 * cv); }
#pragma unroll
                for (int o = 0; o < 3; ++o) if (o < ntok) { float acc[8];
#pragma unroll
                    for (int e = 0; e < 8; ++e) { float a_ = 0.f;
#pragma unroll
                        for (int j = 0; j < 5; ++j) { const unsigned w_ = raw[o + j][e >> 1]; a_ += cwr[j][e] * __uint_as_float((e & 1) ? (w_ & 0xffff0000u) : (w_ << 16)); }
                        acc[e] = a_ * sigm(a_); }
                    const int wt_ = tok0 + o, i = (d == 0 ? wt_ : CH - 1 - wt_);
                    float* dst = cv < 16 ? UQ + i * 128 + 8 * cv : (cv < 32 ? UK + i * 128 + 8 * (cv - 16) : UV + i * 64 + 8 * (cv - 32));
                    *(f32x4*)dst = (f32x4){acc[0], acc[1], acc[2], acc[3]}; *(f32x4*)(dst + 4) = (f32x4){acc[4], acc[5], acc[6], acc[7]}; } }
            if (wave == 7) { float g = lane < CH ? GSC[lane * 4] : 0.f;
#pragma unroll
                for (int o = 1; o < 32; o <<= 1) { const float t = __shfl_up(g, o); if (lane >= o) g += t; }
                if (lane < CH) GC[lane] = g; }
            __syncthreads();
            { const int i = qo >> 4, cg = qo & 15, j0 = 8 * cg;
              float qv8[8], kv8[8];
#pragma unroll
              for (int e = 0; e < 2; ++e) { const f32x4 a = *(const f32x4*)(UQ + i * 128 + j0 + 4 * e), b2 = *(const f32x4*)(UK + i * 128 + j0 + 4 * e);
#pragma unroll
                  for (int x = 0; x < 4; ++x) { qv8[4 * e + x] = a[x]; kv8[4 * e + x] = b2[x]; } }
              float sq = 0.f, sk = 0.f;
#pragma unroll
              for (int e = 0; e < 8; ++e) { sq += qv8[e] * qv8[e]; sk += kv8[e] * kv8[e]; }
              sq = red16(sq); sk = red16(sk);
              const float rq = rsqrtf(sq + 1e-6f) * 0.08838834764831845f, rk = rsqrtf(sk + 1e-6f);
              const float gci = GC[i], gcl = GC[CH - 1], beta = GSC[i * 4 + 1];
              const float eg = __expf(gci), et = __expf(gcl - gci), bg = beta * eg;
              float vv[8];
              if (cg < 8) { const f32x4 a = *(const f32x4*)(UV + i * 64 + j0), b2 = *(const f32x4*)(UV + i * 64 + j0 + 4);
#pragma unroll
                  for (int x = 0; x < 4; ++x) { vv[x] = a[x]; vv[4 + x] = b2[x]; } }
#pragma unroll
              for (int e = 0; e < 8; ++e) { qv8[e] *= rq; kv8[e] *= rk; }
              u32x4 w;
              w.x = pk2(kv8[0], kv8[1]); w.y = pk2(kv8[2], kv8[3]); w.z = pk2(kv8[4], kv8[5]); w.w = pk2(kv8[6], kv8[7]); *(u32x4*)(KA + i * LDK + j0) = w;
              w.x = pk2(qv8[0], qv8[1]); w.y = pk2(qv8[2], qv8[3]); w.z = pk2(qv8[4], qv8[5]); w.w = pk2(qv8[6], qv8[7]); *(u32x4*)(QA + i * LDK + j0) = w;
              w.x = pk2(qv8[0] * eg, qv8[1] * eg); w.y = pk2(qv8[2] * eg, qv8[3] * eg); w.z = pk2(qv8[4] * eg, qv8[5] * eg); w.w = pk2(qv8[6] * eg, qv8[7] * eg); *(u32x4*)(QD + i * LDK + j0) = w;
              w.x = pk2(kv8[0] * bg, kv8[1] * bg); w.y = pk2(kv8[2] * bg, kv8[3] * bg); w.z = pk2(kv8[4] * bg, kv8[5] * bg); w.w = pk2(kv8[6] * bg, kv8[7] * bg); *(u32x4*)(KGT + i * 144 + j0) = w;
              w.x = pk2(kv8[0] * et, kv8[1] * et); w.y = pk2(kv8[2] * et, kv8[3] * et); w.z = pk2(kv8[4] * et, kv8[5] * et); w.w = pk2(kv8[6] * et, kv8[7] * et); *(u32x4*)(KTT + i * 144 + j0) = w;
              if (cg < 8) { w.x = pk2(vv[0] * beta, vv[1] * beta); w.y = pk2(vv[2] * beta, vv[3] * beta); w.z = pk2(vv[4] * beta, vv[5] * beta); w.w = pk2(vv[6] * beta, vv[7] * beta); *(u32x4*)(VT + i * 72 + j0) = w; } }
            __syncthreads();
            { const int mt = (wave >> 1) & 1, nt = wave & 1; const bf16_t* Am = wave < 4 ? KA : QA;
              f32x4 acc = {0.f, 0.f, 0.f, 0.f};
#pragma unroll
              for (int ks = 0; ks < 4; ++ks) { const s16x8 a = *(const s16x8*)(KA + (nt * 16 + fr) * LDK + ks * 32 + fq * 8), bb = *(const s16x8*)(Am + (mt * 16 + fr) * LDK + ks * 32 + fq * 8);
                  acc = MFMA16(a, bb, acc); }
              const int i = mt * 16 + fr; const float gci = GC[i], bi = GSC[i * 4 + 1];
              const f32x4 gcj = *(const f32x4*)(GC + nt * 16 + fq * 4);
              float lv[4];
#pragma unroll
              for (int r = 0; r < 4; ++r) { const int j = nt * 16 + fq * 4 + r; const float dec = __expf(fminf(gci - gcj[r], 0.f));
                  lv[r] = wave < 4 ? ((i > j) ? bi * acc[r] * dec : 0.f) : ((i >= j) ? acc[r] * dec : 0.f); }
              if (wave < 4) *(f32x4*)(LM + i * LDL + nt * 16 + fq * 4) = (f32x4){lv[0], lv[1], lv[2], lv[3]};
              else { uint2 o; o.x = pk2(lv[0], lv[1]); o.y = pk2(lv[2], lv[3]); *(uint2*)(QKM + i * LDC + nt * 16 + fq * 4) = o; } }
            if (wave == 0 || wave == 3) { asm volatile("s_waitcnt lgkmcnt(0)" ::: "memory"); tri_inv_part1(LM, TM, (bf16_t*)(smem + G_T11T), wave == 0 ? 0 : 1, lane); }
            __syncthreads();
            if (wave == 0) tri_inv_part2(LM, TM, (const bf16_t*)(smem + G_T11T), (bf16_t*)(smem + G_XT), lane);
            __syncthreads();
            const int mtu = wave >> 2, ntu = wave & 3;
            f32x4 vacc;
            { const s16x8 a = *(const s16x8*)(TM + (mtu * 16 + fr) * LDC + fq * 8), bb = tr_frag(VT, 72, ntu, lane);
              vacc = MFMA16(a, bb, ((f32x4){0.f, 0.f, 0.f, 0.f}));
#pragma unroll
              for (int x = 0; x < 2; ++x) { const int tt = 2 * wave + x, mtk = tt >> 1, ntk = tt & 1;
                  const s16x8 a2 = tr_frag(KGT, 144, mtk, lane), b2 = *(const s16x8*)(TM + (ntk * 16 + fr) * LDC + fq * 8);
                  const f32x4 r = MFMA16(a2, b2, ((f32x4){0.f, 0.f, 0.f, 0.f}));
                  uint2 o; o.x = pk2(-r[0], -r[1]); o.y = pk2(-r[2], -r[3]);
                  *(uint2*)(WK + (ntk * 16 + fr) * LDK + mtk * 16 + fq * 4) = o; } }
            __syncthreads();
            f32x4 oacc = {0.f, 0.f, 0.f, 0.f};
#pragma unroll
            for (int ks = 0; ks < 4; ++ks) { const s16x8 bs = *(const s16x8*)(ST + (ntu * 16 + fr) * LDK + ks * 32 + fq * 8);
                const s16x8 aw = *(const s16x8*)(WK + (mtu * 16 + fr) * LDK + ks * 32 + fq * 8), aq = *(const s16x8*)(QD + (mtu * 16 + fr) * LDK + ks * 32 + fq * 8);
                vacc = MFMA16(aw, bs, vacc); oacc = MFMA16(aq, bs, oacc); }
            { uint2 o; o.x = pk2(vacc[0], vacc[1]); o.y = pk2(vacc[2], vacc[3]); *(uint2*)(VNT + (ntu * 16 + fr) * LDC + mtu * 16 + fq * 4) = o; }
            __syncthreads();
            { const s16x8 a = *(const s16x8*)(QKM + (mtu * 16 + fr) * LDC + fq * 8), bb = *(const s16x8*)(VNT + (ntu * 16 + fr) * LDC + fq * 8);
              oacc = MFMA16(a, bb, oacc);
              if (!isctx) { bf16_t* op = OD + ((size_t)d * MLAT + rowbase + t0) * 1024 + hg * 128 + half * 64 + ntu * 16 + fr;
#pragma unroll
                  for (int r = 0; r < 4; ++r) op[(ptrdiff_t)sgn * (mtu * 16 + fq * 4 + r) * 1024] = f2bf(oacc[r]); }
              const float gl = __expf(GC[CH - 1]);
              const s16x8 ak = tr_frag(KTT, 144, wave, lane);
#pragma unroll
              for (int nt = 0; nt < 4; ++nt) { const s16x8 bv = *(const s16x8*)(VNT + (nt * 16 + fr) * LDC + fq * 8);
                  sacc[nt] = MFMA16(ak, bv, sacc[nt] * gl);
                  uint2 o; o.x = pk2(sacc[nt][0], sacc[nt][1]); o.y = pk2(sacc[nt][2], sacc[nt][3]);
                  *(uint2*)(ST + (nt * 16 + fr) * LDK + wave * 16 + fq * 4) = o; } }
            if (ch + 1 < NCHUNK) consumeA();
            __syncthreads();
        }
    }
}

constexpr int LK2 = 72;
constexpr int R_WR = 0, R_KD = 8192, R_W = 16384, R_BB = 24576, R_LM = 0, R_TM = 4608, R_AKM = 7168, R_RKM = 9728, R_RBM = 12288, R_WM = 14848, R_X1T = 19456, R_NUT = 24576,
              R_V = 32768, R_THW = 40960, R_THA = 47104, R_GAM = 53248, R_PRM = 61440, R_AT = 62464, R_RT = 67072, R_KT = 71680, R_BT = 76288,
              R_ATT = 80896, R_KTT = 86144, R_BTT = 91392, R_VT = 96640, R_ST = 101888, R_T11T = 111104, R_XT = 111616;
__device__ __forceinline__ void phase_rwkv_chunked(const Params& P, unsigned char* smem) {
    const int tid = threadIdx.x;
    const bf16_t* P1 = (const bf16_t*)(P.ws + WS_X);
    bf16_t* YD = (bf16_t*)P.out;
    float* SBON = (float*)(P.ws + WS_M + MiB);
    float* A_wr = (float*)(smem + R_WR); float* A_kd = (float*)(smem + R_KD); float* A_w = (float*)(smem + R_W); float* A_bb = (float*)(smem + R_BB); float* A_v = (float*)(smem + R_V);
    bf16_t* TH_w = (bf16_t*)(smem + R_THW); bf16_t* TH_a = (bf16_t*)(smem + R_THA); float* GAM = (float*)(smem + R_GAM); float* PRM = (float*)(smem + R_PRM);
    float* LM = (float*)(smem + R_LM); bf16_t* TM = (bf16_t*)(smem + R_TM); bf16_t* AKM = (bf16_t*)(smem + R_AKM); bf16_t* RKM = (bf16_t*)(smem + R_RKM); bf16_t* RBM = (bf16_t*)(smem + R_RBM);
    bf16_t* WM = (bf16_t*)(smem + R_WM); bf16_t* X1T = (bf16_t*)(smem + R_X1T); bf16_t* NUT = (bf16_t*)(smem + R_NUT);
    bf16_t* AT = (bf16_t*)(smem + R_AT); bf16_t* RT = (bf16_t*)(smem + R_RT); bf16_t* KT = (bf16_t*)(smem + R_KT); bf16_t* BT = (bf16_t*)(smem + R_BT);
    bf16_t* ATT = (bf16_t*)(smem + R_ATT); bf16_t* KTT = (bf16_t*)(smem + R_KTT); bf16_t* BTT = (bf16_t*)(smem + R_BTT); bf16_t* VT = (bf16_t*)(smem + R_VT); bf16_t* ST = (bf16_t*)(smem + R_ST);
    const float* mu = P.in[8];
    for (int blk_ = blockIdx.x; blk_ < 256; blk_ += gridDim.x) { const int it = ((blk_ & 7) << 5) | (blk_ >> 3);
        const int b = it >> 5, h = (it >> 1) & 15, d = it & 1;
        f32x4 sacc[2];
        sacc[0] = (f32x4){0.f, 0.f, 0.f, 0.f}; sacc[1] = (f32x4){0.f, 0.f, 0.f, 0.f};
        s16x8 Bw[3], Ba[3];
        __syncthreads();
        { const int lane = tid & 63, wave = tid >> 6; const int cB = h * 64 + 16 * (wave & 3) + (lane & 15);
#pragma unroll
          for (int ks = 0; ks < 3; ++ks)
#pragma unroll
            for (int j = 0; j < 8; ++j) { const int k = ks * 32 + (lane >> 4) * 8 + j;
                Bw[ks][j] = (short)f2bf(P.in[10][((size_t)d * 96 + k) * 1024 + cB]); Ba[ks][j] = (short)f2bf(P.in[12][((size_t)d * 96 + k) * 1024 + cB]); }
          if (tid < 64) { PRM[tid] = P.in[14][h * 64 + tid]; PRM[64 + tid] = P.in[15][h * 64 + tid]; PRM[128 + tid] = P.in[16][h * 64 + tid]; }
          for (int e = tid; e < 64 * LK2 / 2; e += 512) ((unsigned*)ST)[e] = 0u; }
        const float w0c = P.in[9][d * 1024 + h * 64 + 16 * ((tid >> 6) & 3) + (tid & 15)], a0c = P.in[11][d * 1024 + h * 64 + 16 * ((tid >> 6) & 3) + (tid & 15)];
        unsigned pre[3][12];
        auto prefetch = [&](int ch) {
            const bool isctx = ch < 8;
            const int sbase = isctx ? ch * CH : (ch - 8) * CH, Tlen = isctx ? TC : TL;
            const int rowbase = isctx ? MLAT + b * TC : b * TL;
            const int t0 = d == 0 ? sbase : Tlen - 1 - sbase, sgn = d == 0 ? 1 : -1;
            const u32x4 zz = {0u, 0u, 0u, 0u};
            int qv = tid; asm volatile("" : "+v"(qv));
#pragma unroll
            for (int n = 0; n < 3; ++n) { const int ws = n * 8 + (qv >> 6), ln_ = qv & 63; const int L_ = (ws < 12 ? ws : (ws < 18 ? ws - 12 : ws - 18)) * 64 + ln_;
                const int i = ws < 12 ? L_ / 24 : L_ / 12, cv = ws < 12 ? L_ % 24 : (ws < 18 ? 24 + L_ % 12 : 36 + L_ % 12); const int t = t0 + sgn * i;
                const int col = cv < 8 ? h * 64 + 8 * cv : (cv < 16 ? 1024 + h * 64 + 8 * (cv - 8) : (cv < 24 ? 2048 + h * 64 + 8 * (cv - 16) : (cv < 36 ? 3072 + d * 96 + 8 * (cv - 24) : 3264 + d * 96 + 8 * (cv - 36))));
                const bf16_t* pp = P1 + (size_t)(rowbase + t) * LD1 + col;
                { const u32x4 pv_ = *(const u32x4*)pp; pre[n][0] = pv_.x; pre[n][1] = pv_.y; pre[n][2] = pv_.z; pre[n][3] = pv_.w; }
                const unsigned* pw = (const unsigned*)pp; constexpr int LW = LD1 / 2;
                if (isctx) { const bool vl = t > 0, vr = t < TC - 1;
                    const u32x4 L = vl ? *(const u32x4*)(pp - LD1) : zz, R = vr ? *(const u32x4*)(pp + LD1) : zz;
                    pre[n][4] = L.x; pre[n][5] = L.y; pre[n][6] = L.z; pre[n][7] = L.w; pre[n][8] = R.x; pre[n][9] = R.y; pre[n][10] = R.z; pre[n][11] = R.w; }
                else { const int x = t & 63, y = t >> 6; const bool vl = x > 0, vr = x < 63, vu = y > 0, vd = y < 31;
                    pre[n][4] = vl ? pw[-LW + 0] : 0u; pre[n][5] = vl ? pw[-LW + 2] : 0u; pre[n][6] = vr ? pw[LW + 0] : 0u; pre[n][7] = vr ? pw[LW + 2] : 0u;
                    pre[n][8] = vu ? pw[-64 * LW + 1] : 0u; pre[n][9] = vu ? pw[-64 * LW + 3] : 0u; pre[n][10] = vd ? pw[64 * LW + 1] : 0u; pre[n][11] = vd ? pw[64 * LW + 3] : 0u; } }
        };
        prefetch(0);
        for (int ch = 0; ch < NCHUNK; ++ch) {
            int qo = tid; asm volatile("" : "+v"(qo));
            const int lane = qo & 63, wave = qo >> 6, fr = lane & 15, fq = lane >> 4;
            const bool isctx = ch < 8;
            const int sbase = isctx ? ch * CH : (ch - 8) * CH, Tlen = isctx ? TC : TL;
            const int rowbase = isctx ? MLAT + b * TC : b * TL;
            const int t0 = d == 0 ? sbase : Tlen - 1 - sbase, sgn = d == 0 ? 1 : -1;
#pragma unroll
            for (int n = 0; n < 3; ++n) { const int ws = n * 8 + wave; const int L_ = (ws < 12 ? ws : (ws < 18 ? ws - 12 : ws - 18)) * 64 + lane;
                const int i = ws < 12 ? L_ / 24 : L_ / 12, cv = ws < 12 ? L_ % 24 : (ws < 18 ? 24 + L_ % 12 : 36 + L_ % 12);
                const int col = cv < 8 ? h * 64 + 8 * cv : (cv < 16 ? 1024 + h * 64 + 8 * (cv - 8) : (cv < 24 ? 2048 + h * 64 + 8 * (cv - 16) : (cv < 36 ? 3072 + d * 96 + 8 * (cv - 24) : 3264 + d * 96 + 8 * (cv - 36))));
                const f32x4 m0 = *(const f32x4*)(mu + col), m1 = *(const f32x4*)(mu + col + 4);
                float xs[8];
#pragma unroll
                for (int e = 0; e < 8; ++e) { const float p = __uint_as_float((e & 1) ? (pre[n][e >> 1] & 0xffff0000u) : (pre[n][e >> 1] << 16));
                    unsigned wv_; const bool hi = (e & 1);
                    if (isctx) wv_ = (e & 1) ? pre[n][8 + (e >> 1)] : pre[n][4 + (e >> 1)];
                    else wv_ = pre[n][4 + 2 * (e & 3) + (e >> 2)];
                    const float ps = __uint_as_float(hi ? (wv_ & 0xffff0000u) : (wv_ << 16));
                    xs[e] = p + (ps - p) * (e < 4 ? m0[e & 3] : m1[e & 3]); }
                if (cv < 24) { float* dst = (cv < 8 ? A_wr + i * 64 + 8 * cv : (cv < 16 ? A_kd + i * 64 + 8 * (cv - 8) : A_v + i * 64 + 8 * (cv - 16)));
                    *(f32x4*)dst = (f32x4){xs[0], xs[1], xs[2], xs[3]}; *(f32x4*)(dst + 4) = (f32x4){xs[4], xs[5], xs[6], xs[7]}; }
                else if (cv < 36) { u32x4 w; w.x = pk2(tanh_fast(xs[0]), tanh_fast(xs[1])); w.y = pk2(tanh_fast(xs[2]), tanh_fast(xs[3])); w.z = pk2(tanh_fast(xs[4]), tanh_fast(xs[5])); w.w = pk2(tanh_fast(xs[6]), tanh_fast(xs[7]));
                    *(u32x4*)(TH_w + i * 96 + 8 * (cv - 24)) = w; }
                else { u32x4 w; w.x = pk2(xs[0], xs[1]); w.y = pk2(xs[2], xs[3]); w.z = pk2(xs[4], xs[5]); w.w = pk2(xs[6], xs[7]);
                    *(u32x4*)(TH_a + i * 96 + 8 * (cv - 36)) = w; } }
            __syncthreads();
            if (ch + 1 < NCHUNK) prefetch(ch + 1);
            if (wave < 4) { const int c = 16 * wave + fr;
              float wv[2][4];
#pragma unroll
              for (int rt = 0; rt < 2; ++rt) { f32x4 cw = {0.f, 0.f, 0.f, 0.f}, ca = {0.f, 0.f, 0.f, 0.f};
#pragma unroll
                  for (int ks = 0; ks < 3; ++ks) { const int off = (rt * 16 + fr) * 96 + ks * 32 + fq * 8;
                      const s16x8 fa = *(const s16x8*)(TH_w + off), fb = *(const s16x8*)(TH_a + off);
                      cw = MFMA16(fa, Bw[ks], cw); ca = MFMA16(fb, Ba[ks], ca); }
#pragma unroll
                  for (int j = 0; j < 4; ++j) { const int i = rt * 16 + fq * 4 + j;
                      wv[rt][j] = __expf(-0.6065306597126334f * sigm(w0c + cw[j])); A_bb[i * 64 + c] = sigm(a0c + ca[j]); } }
              float tot[2];
#pragma unroll
              for (int rt = 0; rt < 2; ++rt) { wv[rt][1] *= wv[rt][0]; wv[rt][2] *= wv[rt][1]; wv[rt][3] *= wv[rt][2];
                  float sx = wv[rt][3]; float u1 = __shfl_up(sx, 16); if (fq >= 1) sx *= u1; float u2 = __shfl_up(sx, 32); if (fq >= 2) sx *= u2;
                  float ex = __shfl_up(sx, 16); if (fq == 0) ex = 1.f;
                  tot[rt] = __shfl(sx, 48 + fr);
                  const float base = ex * (rt == 1 ? tot[0] : 1.f);
#pragma unroll
                  for (int j = 0; j < 4; ++j) GAM[(rt * 16 + fq * 4 + j) * 64 + c] = base * wv[rt][j]; } }
            __syncthreads();
            { const int i = qo >> 4, cg = qo & 15, j0 = 4 * cg;
              const f32x4 xr = *(const f32x4*)(A_wr + i * 64 + j0), xk = *(const f32x4*)(A_kd + i * 64 + j0), ic = *(const f32x4*)(A_bb + i * 64 + j0), xv = *(const f32x4*)(A_v + i * 64 + j0);
              const f32x4 kkw = *(const f32x4*)(PRM + j0), kaw = *(const f32x4*)(PRM + 64 + j0), rkw = *(const f32x4*)(PRM + 128 + j0);
              const f32x4 gi = *(const f32x4*)(GAM + i * 64 + j0), gl = *(const f32x4*)(GAM + 31 * 64 + j0);
              f32x4 gp = {1.f, 1.f, 1.f, 1.f}; if (i > 0) gp = *(const f32x4*)(GAM + (i - 1) * 64 + j0);
              const f32x4 kkr = xk * kkw;
              const float ss = red16(kkr[0] * kkr[0] + kkr[1] * kkr[1] + kkr[2] * kkr[2] + kkr[3] * kkr[3]);
              const f32x4 kk = kkr * rsqrtf(ss + 1e-6f);
              f32x4 kd, bb, at, rt_, kt, bt, ktl, btl; float sbp = 0.f;
#pragma unroll
              for (int e = 0; e < 4; ++e) { kd[e] = xk[e] * (1.f + (ic[e] - 1.f) * kaw[e]); bb[e] = kk[e] * ic[e]; sbp += xr[e] * kd[e] * rkw[e];
                  const float ig = __builtin_amdgcn_rcpf(gi[e]); at[e] = kk[e] * gp[e]; rt_[e] = xr[e] * gi[e]; kt[e] = kd[e] * ig; bt[e] = bb[e] * ig; ktl[e] = kt[e] * gl[e]; btl[e] = bt[e] * gl[e]; }
              const float sb = 0.5f * red16(sbp);
              if (cg == 0 && !isctx) SBON[((size_t)d * MLAT + rowbase + t0 + sgn * i) * 16 + h] = sb;
              uint2 o;
              o.x = pk2(at[0], at[1]); o.y = pk2(at[2], at[3]); *(uint2*)(AT + i * LK2 + j0) = o;
              o.x = pk2(rt_[0], rt_[1]); o.y = pk2(rt_[2], rt_[3]); *(uint2*)(RT + i * LK2 + j0) = o;
              o.x = pk2(kt[0], kt[1]); o.y = pk2(kt[2], kt[3]); *(uint2*)(KT + i * LK2 + j0) = o;
              o.x = pk2(bt[0], bt[1]); o.y = pk2(bt[2], bt[3]); *(uint2*)(BT + i * LK2 + j0) = o;
              o.x = pk2(ktl[0], ktl[1]); o.y = pk2(ktl[2], ktl[3]); *(uint2*)(KTT + i * LK2 + j0) = o;
              o.x = pk2(btl[0], btl[1]); o.y = pk2(btl[2], btl[3]); *(uint2*)(BTT + i * LK2 + j0) = o;
              o.x = pk2(xv[0], xv[1]); o.y = pk2(xv[2], xv[3]); *(uint2*)(VT + i * LK2 + j0) = o; }
            __syncthreads();
#pragma unroll
            for (int x = 0; x < 2; ++x) { const int t = 2 * wave + x, m = t >> 2, mt = (t >> 1) & 1, nt = t & 1;
                const bf16_t* Am = m < 2 ? AT : RT; const bf16_t* Bm = (m == 0 || m == 3) ? BT : KT;
                f32x4 acc = {0.f, 0.f, 0.f, 0.f};
#pragma unroll
                for (int ks = 0; ks < 2; ++ks) { const s16x8 a = *(const s16x8*)(Bm + (nt * 16 + fr) * LK2 + ks * 32 + fq * 8), bb2 = *(const s16x8*)(Am + (mt * 16 + fr) * LK2 + ks * 32 + fq * 8);
                    acc = MFMA16(a, bb2, acc); }
                const int i = mt * 16 + fr; float lv[4];
#pragma unroll
                for (int r = 0; r < 4; ++r) { const int j = nt * 16 + fq * 4 + r; lv[r] = (m < 2 ? (i > j) : (i >= j)) ? acc[r] : 0.f; }
                if (m == 0) *(f32x4*)(LM + i * LDL + nt * 16 + fq * 4) = (f32x4){lv[0], lv[1], lv[2], lv[3]};
                else { bf16_t* dstm = m == 1 ? AKM : (m == 2 ? RKM : RBM); uint2 o; o.x = pk2(lv[0], lv[1]); o.y = pk2(lv[2], lv[3]); *(uint2*)(dstm + i * LDC + nt * 16 + fq * 4) = o; } }
            if (wave < 2) { asm volatile("s_waitcnt lgkmcnt(0)" ::: "memory"); tri_inv_part1(LM, TM, (bf16_t*)(smem + R_T11T), wave, lane); }
            __syncthreads();
            if (wave == 0) tri_inv_part2(LM, TM, (const bf16_t*)(smem + R_T11T), (bf16_t*)(smem + R_XT), lane);
            else {
                const int ntile = (wave == 1) ? 2 : 1;
                for (int q2 = 0; q2 < ntile; ++q2) { const int tl = (q2 == 0) ? wave : 0; const int mt = tl >> 2, nt = tl & 3;
                    const s16x8 a = *(const s16x8*)(AKM + (mt * 16 + fr) * LDC + fq * 8), bb2 = tr_frag(VT, LK2, nt, lane);
                    const f32x4 r = MFMA16(a, bb2, ((f32x4){0.f, 0.f, 0.f, 0.f}));
                    uint2 o; o.x = pk2(r[0], r[1]); o.y = pk2(r[2], r[3]); *(uint2*)(X1T + (nt * 16 + fr) * LDC + mt * 16 + fq * 4) = o; }
            }
            __syncthreads();
            const int mtu = wave >> 2, ntu = wave & 3;
            f32x4 uacc;
            { const s16x8 a = *(const s16x8*)(TM + (mtu * 16 + fr) * LDC + fq * 8), bb2 = *(const s16x8*)(X1T + (ntu * 16 + fr) * LDC + fq * 8);
              uacc = MFMA16(a, bb2, ((f32x4){0.f, 0.f, 0.f, 0.f}));
              const int kt_ = wave >> 1, it_ = wave & 1;
              const s16x8 a2 = tr_frag(AT, LK2, kt_, lane), b2 = *(const s16x8*)(TM + (it_ * 16 + fr) * LDC + fq * 8);
              const f32x4 r = MFMA16(a2, b2, ((f32x4){0.f, 0.f, 0.f, 0.f}));
              uint2 o; o.x = pk2(r[0], r[1]); o.y = pk2(r[2], r[3]); *(uint2*)(WM + (it_ * 16 + fr) * LK2 + kt_ * 16 + fq * 4) = o; }
            __syncthreads();
            f32x4 yacc = {0.f, 0.f, 0.f, 0.f};
#pragma unroll
            for (int ks = 0; ks < 2; ++ks) { const s16x8 bs = *(const s16x8*)(ST + (ntu * 16 + fr) * LK2 + ks * 32 + fq * 8);
                const s16x8 aw = *(const s16x8*)(WM + (mtu * 16 + fr) * LK2 + ks * 32 + fq * 8), ar = *(const s16x8*)(RT + (mtu * 16 + fr) * LK2 + ks * 32 + fq * 8);
                uacc = MFMA16(aw, bs, uacc); yacc = MFMA16(ar, bs, yacc); }
            { const s16x8 a = *(const s16x8*)(RKM + (mtu * 16 + fr) * LDC + fq * 8), bb2 = tr_frag(VT, LK2, ntu, lane);
              yacc = MFMA16(a, bb2, yacc);
              uint2 o; o.x = pk2(-uacc[0], -uacc[1]); o.y = pk2(-uacc[2], -uacc[3]); *(uint2*)(NUT + (ntu * 16 + fr) * LDC + mtu * 16 + fq * 4) = o; }
            __syncthreads();
            { const s16x8 a = *(const s16x8*)(RBM + (mtu * 16 + fr) * LDC + fq * 8), bb2 = *(const s16x8*)(NUT + (ntu * 16 + fr) * LDC + fq * 8);
              yacc = MFMA16(a, bb2, yacc);
              if (!isctx) { bf16_t* yp = YD + ((size_t)d * MLAT + rowbase + t0) * 1024 + h * 64 + ntu * 16 + fr;
#pragma unroll
                  for (int r = 0; r < 4; ++r) yp[(ptrdiff_t)sgn * (mtu * 16 + fq * 4 + r) * 1024] = f2bf(yacc[r]); }
              const int kt_ = wave >> 1;
              const f32x4 gl = *(const f32x4*)(GAM + 31 * 64 + kt_ * 16 + fq * 4);
              const s16x8 ak = tr_frag(KTT, LK2, kt_, lane), ab = tr_frag(BTT, LK2, kt_, lane);
#pragma unroll
              for (int x = 0; x < 2; ++x) { const int vt = 2 * (wave & 1) + x;
                  const s16x8 bv = tr_frag(VT, LK2, vt, lane), bu = *(const s16x8*)(NUT + (vt * 16 + fr) * LDC + fq * 8);
                  sacc[x] = MFMA16(ak, bv, sacc[x] * gl); sacc[x] = MFMA16(ab, bu, sacc[x]);
                  uint2 o; o.x = pk2(sacc[x][0], sacc[x][1]); o.y = pk2(sacc[x][2], sacc[x][3]);
                  *(uint2*)(ST + (vt * 16 + fr) * LK2 + kt_ * 16 + fq * 4) = o; } }
            __syncthreads();
        }
    }
}


__device__ __forceinline__ void mix8_lat(const bf16_t* P1, int row, int col0, const float* mu, float (&xs)[8]) {
    const int t = row & (TL - 1), x = t & 63, y = t >> 6; const bool vl = x > 0, vr = x < 63, vu = y > 0, vd = y < 31;
    const bf16_t* pp = P1 + (size_t)row * LD1 + col0; const unsigned* pw = (const unsigned*)pp; constexpr int LW = LD1 / 2;
    const u32x4 pv = *(const u32x4*)pp;
    unsigned nb[8];
    nb[0] = vl ? pw[-LW + 0] : 0u; nb[1] = vl ? pw[-LW + 2] : 0u; nb[2] = vr ? pw[LW + 0] : 0u; nb[3] = vr ? pw[LW + 2] : 0u;
    nb[4] = vu ? pw[-64 * LW + 1] : 0u; nb[5] = vu ? pw[-64 * LW + 3] : 0u; nb[6] = vd ? pw[64 * LW + 1] : 0u; nb[7] = vd ? pw[64 * LW + 3] : 0u;
    const f32x4 m0 = *(const f32x4*)(mu + col0), m1 = *(const f32x4*)(mu + col0 + 4);
#pragma unroll
    for (int e = 0; e < 8; ++e) { const float p = __uint_as_float((e & 1) ? (pv[e >> 1] & 0xffff0000u) : (pv[e >> 1] << 16));
        const unsigned w_ = nb[2 * (e & 3) + (e >> 2)]; const float ps = __uint_as_float((e & 1) ? (w_ & 0xffff0000u) : (w_ << 16));
        xs[e] = p + (ps - p) * (e < 4 ? m0[e & 3] : m1[e & 3]); }
}
__device__ __forceinline__ void phase_sg(const Params& P) {
    const bf16_t* P1 = (const bf16_t*)(P.ws + WS_X); bf16_t* SG = (bf16_t*)(P.ws + WS_A + 32 * MiB);
    const int gt = blockIdx.x * 512 + threadIdx.x, NT = gridDim.x * 512;
    for (int s = gt; s < MLAT * 32; s += NT) { const int row = s >> 5, k8 = s & 31;
        u32x4 w = {0u, 0u, 0u, 0u};
        if (k8 < 8) { float xs[8]; mix8_lat(P1, row, 3456 + 8 * k8, P.in[8], xs);
            w.x = pk2(sigm(xs[0]), sigm(xs[1])); w.y = pk2(sigm(xs[2]), sigm(xs[3])); w.z = pk2(sigm(xs[4]), sigm(xs[5])); w.w = pk2(sigm(xs[6]), sigm(xs[7])); }
        *(u32x4*)(SG + (size_t)row * 256 + 8 * k8) = w; }
}
__device__ __forceinline__ void phase_readout_rwkv(const Params& P) {
    const bf16_t* P1 = (const bf16_t*)(P.ws + WS_X); const bf16_t* YD = (const bf16_t*)P.out; const float* SBON = (const float*)(P.ws + WS_M + MiB);
    bf16_t* OA = (bf16_t*)(P.ws + WS_A);
    const float* lnw = P.in[17]; const float* lnb = P.in[18];
    const int gt = blockIdx.x * 512 + threadIdx.x, NT = gridDim.x * 512;
    for (int s = gt; s < MLAT * 128; s += NT) { const int row = s >> 7, cv = s & 127, c0 = 8 * cv, hd = cv >> 3;
        const u32x4 y0 = *(const u32x4*)(YD + (size_t)row * 1024 + c0), y1 = *(const u32x4*)(YD + ((size_t)MLAT + row) * 1024 + c0), gg = *(const u32x4*)(OA + (size_t)row * 1024 + c0);
        float xv[8]; mix8_lat(P1, row, 2048 + c0, P.in[8], xv);
        const float sb = SBON[(size_t)row * 16 + hd] + SBON[((size_t)MLAT + row) * 16 + hd];
        const f32x4 w0 = *(const f32x4*)(lnw + c0), w1 = *(const f32x4*)(lnw + c0 + 4), b0 = *(const f32x4*)(lnb + c0), b1 = *(const f32x4*)(lnb + c0 + 4);
        float y[8], sum = 0.f;
#pragma unroll
        for (int e = 0; e < 8; ++e) { const unsigned a_ = y0[e >> 1], b_ = y1[e >> 1];
            y[e] = __uint_as_float((e & 1) ? (a_ & 0xffff0000u) : (a_ << 16)) + __uint_as_float((e & 1) ? (b_ & 0xffff0000u) : (b_ << 16)); sum += y[e]; }
        const float m = red8(sum) * (1.f / 64.f); float vs = 0.f;
#pragma unroll
        for (int e = 0; e < 8; ++e) { y[e] -= m; vs += y[e] * y[e]; }
        const float rs = rsqrtf(red8(vs) * (1.f / 64.f) + 64e-5f);
        float o[8];
#pragma unroll
        for (int e = 0; e < 8; ++e) { const unsigned g_ = gg[e >> 1]; const float gate = __uint_as_float((e & 1) ? (g_ & 0xffff0000u) : (g_ << 16));
            o[e] = (y[e] * rs * (e < 4 ? w0[e & 3] : w1[e & 3]) + (e < 4 ? b0[e & 3] : b1[e & 3]) + sb * xv[e]) * gate; }
        u32x4 w; w.x = pk2(o[0], o[1]); w.y = pk2(o[2], o[3]); w.z = pk2(o[4], o[5]); w.w = pk2(o[6], o[7]);
        *(u32x4*)(OA + (size_t)row * 1024 + c0) = w; }
}
__device__ __forceinline__ void phase_readout(const Params& P, unsigned char* smem) {
    const int tid = threadIdx.x, lane = tid & 63, wave = tid >> 6;
    const bf16_t* P1 = (const bf16_t*)(P.ws + WS_X); const bf16_t* P2 = (const bf16_t*)(P.ws + WS_D);
    const bf16_t* YD = (const bf16_t*)P.out; const bf16_t* OD = YD + (size_t)2 * MLAT * 1024;
    const float* SBON = (const float*)(P.ws + WS_M + MiB);
    bf16_t* OA = (bf16_t*)(P.ws + WS_A); bf16_t* OB = (bf16_t*)(P.ws + WS_F);
    const float* mu = P.in[8];
    { const int gw = blockIdx.x * 8 + wave, NGW = gridDim.x * 8; const float* nw = P.in[22];
      for (int row = gw; row < MLAT; row += NGW) { const int c0 = lane * 16;
        const u32x4 a0 = *(const u32x4*)(OD + (size_t)row * 1024 + c0), a1 = *(const u32x4*)(OD + (size_t)row * 1024 + c0 + 8);
        const u32x4 b0 = *(const u32x4*)(OD + ((size_t)MLAT + row) * 1024 + c0), b1 = *(const u32x4*)(OD + ((size_t)MLAT + row) * 1024 + c0 + 8);
        const u32x4 z0 = *(const u32x4*)(P2 + (size_t)row * LD2 + c0), z1 = *(const u32x4*)(P2 + (size_t)row * LD2 + c0 + 8);
        float o[16], z[16];
#pragma unroll
        for (int e = 0; e < 4; ++e) { o[2 * e] = __uint_as_float(a0[e] << 16) + __uint_as_float(b0[e] << 16); o[2 * e + 1] = __uint_as_float(a0[e] & 0xffff0000u) + __uint_as_float(b0[e] & 0xffff0000u);
            o[8 + 2 * e] = __uint_as_float(a1[e] << 16) + __uint_as_float(b1[e] << 16); o[8 + 2 * e + 1] = __uint_as_float(a1[e] & 0xffff0000u) + __uint_as_float(b1[e] & 0xffff0000u);
            z[2 * e] = __uint_as_float(z0[e] << 16); z[2 * e + 1] = __uint_as_float(z0[e] & 0xffff0000u); z[8 + 2 * e] = __uint_as_float(z1[e] << 16); z[8 + 2 * e + 1] = __uint_as_float(z1[e] & 0xffff0000u); }
        float ss = 0.f;
#pragma unroll
        for (int e = 0; e < 16; ++e) ss += o[e] * o[e];
        ss = red8(ss);
        const float rs = rsqrtf(ss * (1.f / 128.f) + 1e-6f);
        float r[16];
#pragma unroll
        for (int e = 0; e < 16; ++e) r[e] = o[e] * rs * nw[(c0 + e) & 127] * (z[e] * sigm(z[e]));
        u32x4 w0, w1;
#pragma unroll
        for (int e = 0; e < 4; ++e) { w0[e] = pk2(r[2 * e], r[2 * e + 1]); w1[e] = pk2(r[8 + 2 * e], r[8 + 2 * e + 1]); }
        *(u32x4*)(OB + (size_t)row * 1024 + c0) = w0; *(u32x4*)(OB + (size_t)row * 1024 + c0 + 8) = w1; } }
}

__global__ void __launch_bounds__(512, 2) fwd_mega(Params P) {
    extern __shared__ __attribute__((aligned(16))) unsigned char smem[];
    cg::grid_group grid = cg::this_grid();
    bf16_t* WT_IN = (bf16_t*)(P.ws + WS_A); bf16_t* WT_PA = (bf16_t*)(P.ws + WS_B); bf16_t* WT_PB = WT_PA + 2048 * 1024; bf16_t* WT_OUT = WT_PB + 2048 * 1024;
    bf16_t* P1 = (bf16_t*)(P.ws + WS_X); bf16_t* P2 = (bf16_t*)(P.ws + WS_D); bf16_t* H = (bf16_t*)P.out;
    bf16_t* OA = (bf16_t*)(P.ws + WS_A); bf16_t* OB = (bf16_t*)(P.ws + WS_F); bf16_t* MBUF = (bf16_t*)(P.ws + WS_X); bf16_t* A3 = (bf16_t*)(P.ws + WS_X);
    bf16_t* H2 = (bf16_t*)(P.ws + WS_D); bf16_t* WT_GU = (bf16_t*)(P.ws + WS_A); bf16_t* WT_DN = (bf16_t*)(P.ws + WS_F);
    const float* MOD = (const float*)(P.ws + WS_M);
#define PHASE(n) if (P.ph_lo <= (n) && (n) < P.ph_hi)
#define SEAM(n) do { if (P.coop && P.ph_lo <= (n) && (n) + 1 < P.ph_hi) grid.sync(); } while (0)
    PHASE(0) { phase_prep(P, smem); } SEAM(0);
    PHASE(1) { phase_norm1(P); } SEAM(1);
    PHASE(2) { EpiBf16Plain e1{P1, LD1}; run_gemm(smem, H, WT_IN, MALL, N1, D, e1);
               EpiBf16Plain e2{P2, LD2}; run_gemm(smem, H, WT_IN + (size_t)N1 * D, MLAT, N2, D, e2); } SEAM(2);
    PHASE(3) { phase_sg(P); phase_rwkv_chunked(P, smem); }
    PHASE(4) { phase_gdn(P, smem); } SEAM(4);
    PHASE(5) { EpiBf16Plain eg{OA, 1024}; run_gemm(smem, (const bf16_t*)(P.ws + WS_A + 32 * MiB), (const bf16_t*)(P.ws + WS_M + MiB / 2), MLAT, 1024, 256, eg); phase_readout(P, smem); } SEAM(5);
    PHASE(6) { phase_readout_rwkv(P); } SEAM(6);
    PHASE(7) { EpiGate<false> ea{MBUF, P2 + 1024}; run_gemm(smem, OA, WT_PA, MLAT, D, 1024, ea);
               EpiGate<true> eb{MBUF, P2 + 1024 + 2048}; run_gemm(smem, OB, WT_PB, MLAT, D, 1024, eb); } SEAM(7);
    PHASE(8) { EpiRes e{P.out, P.in[0], MOD + 2 * D}; run_gemm(smem, MBUF, WT_OUT, MLAT, D, D, e); } SEAM(8);
    PHASE(9) { phase_norm2(P); phase_ffn_weights(P, smem); } SEAM(9);
    PHASE(10) { EpiSwiglu e{A3}; run_gemm(smem, H2, WT_GU, MLAT, 2 * FFH, D, e); } SEAM(10);
    PHASE(11) { EpiRes e{P.out, P.out, MOD + 5 * D}; run_gemm(smem, A3, WT_DN, MLAT, D, FFH, e); } SEAM(11);
    PHASE(12) { phase_final_norm(P); }
}

#ifndef N_LAUNCH_PER_PHASE
#define N_LAUNCH_PER_PHASE 0
#endif
#ifndef PROBE_SEQ
#define PROBE_SEQ {0,1,2,3,4,5,6,7,8,9,10,11,12}
#endif
extern "C" void kernel_launch(void* const* d_in, const int* in_sizes, int n_in, void* d_out, int out_size, void* d_ws, size_t ws_size, hipStream_t stream) {
    static int grid = 0;
    if (grid == 0) {
        if (n_in != 30 || out_size != MLAT * D || ws_size < WS_END) { fprintf(stderr, "kernel_launch: unexpected shapes: n_in %d out %d ws %zu (need %zu)\n", n_in, out_size, ws_size, (size_t)WS_END); grid = -1; return; }
        int dev = 0, cus = 0, per_cu = 0;
        if (hipGetDevice(&dev) != hipSuccess || hipDeviceGetAttribute(&cus, hipDeviceAttributeMultiprocessorCount, dev) != hipSuccess) { grid = -1; return; }
        if (hipFuncSetAttribute((const void*)fwd_mega, hipFuncAttributeMaxDynamicSharedMemorySize, LDS_BYTES) != hipSuccess) { fprintf(stderr, "kernel_launch: hipFuncSetAttribute failed\n"); grid = -1; return; }
        if (hipOccupancyMaxActiveBlocksPerMultiprocessor(&per_cu, (const void*)fwd_mega, 512, LDS_BYTES) != hipSuccess || per_cu < 1) { fprintf(stderr, "kernel_launch: occupancy query gives %d\n", per_cu); grid = -1; return; }
        grid = cus * per_cu; if (grid > 256) grid = 256;
    }
    if (grid < 0) return;
    Params p{};
    for (int i = 0; i < 30; ++i) p.in[i] = (const float*)d_in[i];
    p.out = (float*)d_out; p.ws = (unsigned char*)d_ws;
#if N_LAUNCH_PER_PHASE
    { const int seq[] = PROBE_SEQ; for (int si = 0; si < (int)(sizeof(seq) / sizeof(int)); ++si) { const int ph = seq[si]; p.ph_lo = ph; p.ph_hi = ph + 1; p.coop = 0; hipLaunchKernelGGL(fwd_mega, dim3(grid), dim3(512), LDS_BYTES, stream, p); } }
#else
    p.ph_lo = 0; p.ph_hi = 13; p.coop = 1;
    void* args[] = {&p};
    hipError_t e = hipLaunchCooperativeKernel((const void*)fwd_mega, dim3(grid), dim3(512), args, LDS_BYTES, stream);
    if (e != hipSuccess) fprintf(stderr, "cooperative launch failed: %s (grid %d)\n", hipGetErrorString(e), grid);
#endif
}
```
